# Optimizing an MI355X kernel written in HIP

```python
import math
import jax, jax.numpy as jnp
from jax import lax
import numpy as np

D_MODEL = 1024
BATCH = 8
SEQ = 4096
DEPTH = 2

GLA_HEADS = 4
GLA_DK = D_MODEL // 2
GLA_DV = D_MODEL
GLA_DKH = GLA_DK // GLA_HEADS
GLA_DVH = GLA_DV // GLA_HEADS
GATE_RANK = 16
GATE_TAU = 16.0
CHUNK = 64
CONV_DIM = D_MODEL
CONV_WIDTH = 3
IN_SIZES = (GLA_DK, GLA_DK, GLA_DV, GATE_RANK, GLA_DV, CONV_DIM, CONV_DIM, CONV_DIM, D_MODEL, D_MODEL)
IN_COLS = sum(IN_SIZES)
IN_SPLITS = tuple(int(s) for s in np.cumsum(IN_SIZES)[:-1])
N_GROUPS = 8
EXPERTS_PER_GROUP = 8
N_EXPERTS = N_GROUPS * EXPERTS_PER_GROUP
TOP_K = 2
D_EXPERT = D_MODEL // 2
MOE_BLOCK = 256
EPS = 1e-6

kernel_name = "hybrid_gla_shortconv_hiermoe_adaln"


def rmsnorm(x, g):
    xf = x.astype(jnp.float32)
    y = xf * lax.rsqrt(jnp.mean(xf * xf, axis=-1, keepdims=True) + EPS)
    return (y * g.astype(jnp.float32)).astype(x.dtype)


def gla_chunked(q, k, v, log_a):
    Bsz, S, H, dk = q.shape
    dv = v.shape[-1]
    n = S // CHUNK

    def to_chunks(t):
        return t.reshape(Bsz, n, CHUNK, H, t.shape[-1]).transpose(1, 0, 3, 2, 4)

    qc, kc, vc, gc = to_chunks(q), to_chunks(k), to_chunks(v), to_chunks(log_a)
    b = jnp.cumsum(gc, axis=3)
    b_last = b[:, :, :, -1:, :]
    q_t = qc * jnp.exp(b)
    k_t = kc * jnp.exp(-b)
    k_s = kc * jnp.exp(b_last - b)
    causal = jnp.tril(jnp.ones((CHUNK, CHUNK), dtype=bool))
    attn = jnp.einsum('nbhid,nbhjd->nbhij', q_t, k_t)
    attn = jnp.where(causal, attn, 0.0)
    o_intra = jnp.einsum('nbhij,nbhjv->nbhiv', attn, vc)
    decay = jnp.exp(b_last)[:, :, :, 0, :]

    def step(state, inp):
        q_i, k_i, v_i, d_i = inp
        o_i = jnp.einsum('bhid,bhdv->bhiv', q_i, state)
        state = d_i[..., None] * state + jnp.einsum('bhid,bhiv->bhdv', k_i, v_i)
        return state, o_i

    s0 = jnp.zeros((Bsz, H, dk, dv), jnp.float32)
    _, o_inter = lax.scan(step, s0, (q_t, k_s, vc, decay))
    o = o_intra + o_inter
    return o.transpose(1, 0, 3, 2, 4).reshape(Bsz, S, H, dv)


def causal_short_conv(u, w):
    S = u.shape[1]
    up = jnp.pad(u, ((0, 0), (CONV_WIDTH - 1, 0), (0, 0)))
    return sum(w[i] * up[:, i:i + S] for i in range(CONV_WIDTH))


def token_mixer(h, w_in, gate_w2, gate_b, gla_norm_g, conv_w, w_gla_out, w_conv_out, w_out):
    Bsz, S, _ = h.shape
    z = h @ w_in
    q, k, v, g_dn, r, conv_b, conv_c, conv_h, gate_a, gate_c = jnp.split(z, IN_SPLITS, axis=-1)
    f32 = jnp.float32
    q = q.astype(f32).reshape(Bsz, S, GLA_HEADS, GLA_DKH) * (GLA_DKH ** -0.5)
    k = k.astype(f32).reshape(Bsz, S, GLA_HEADS, GLA_DKH)
    v = v.astype(f32).reshape(Bsz, S, GLA_HEADS, GLA_DVH)
    log_a = jax.nn.log_sigmoid((g_dn @ gate_w2 + gate_b).astype(f32)) / GATE_TAU
    log_a = log_a.reshape(Bsz, S, GLA_HEADS, GLA_DKH)
    o = gla_chunked(q, k, v, log_a)
    o = rmsnorm(o, gla_norm_g.reshape(GLA_HEADS, GLA_DVH)).reshape(Bsz, S, GLA_DV)
    o = o.astype(h.dtype) * jax.nn.silu(r)
    y_gla = o @ w_gla_out
    conv_out = causal_short_conv(conv_c * conv_h, conv_w)
    y_conv = (conv_b * conv_out) @ w_conv_out
    y = jax.nn.sigmoid(gate_a) * y_gla + jax.nn.sigmoid(gate_c) * y_conv
    return y @ w_out


def hier_moe(h, rg_w, rg_b, re_w, re_b, w1, w3, w2):
    Bsz, S, D = h.shape
    N = Bsz * S
    NK = N * TOP_K
    t = h.reshape(N, D)
    p_group = jax.nn.softmax((t @ rg_w + rg_b).astype(jnp.float32), axis=-1)
    g_w, g_idx = lax.top_k(p_group, 1)
    e_logits = (t @ re_w + re_b).astype(jnp.float32).reshape(N, N_GROUPS, EXPERTS_PER_GROUP)
    e_logits = jnp.take_along_axis(e_logits, g_idx[:, :, None], axis=1)[:, 0]
    p_exp = jax.nn.softmax(e_logits, axis=-1)
    e_w, e_loc = lax.top_k(p_exp, TOP_K)
    e_w = e_w / jnp.sum(e_w, axis=-1, keepdims=True) * g_w
    e_id = g_idx * EXPERTS_PER_GROUP + e_loc
    flat_e = e_id.reshape(NK)
    flat_w = e_w.reshape(NK)
    flat_tok = jnp.repeat(jnp.arange(N, dtype=jnp.int32), TOP_K)
    order = jnp.argsort(flat_e)
    se = flat_e[order]
    counts = jnp.bincount(flat_e, length=N_EXPERTS).astype(jnp.int32)
    padded = ((counts + MOE_BLOCK - 1) // MOE_BLOCK) * MOE_BLOCK
    pad_end = jnp.cumsum(padded)
    pad_start = pad_end - padded
    start = jnp.cumsum(counts) - counts
    dest = pad_start[se] + (jnp.arange(NK, dtype=jnp.int32) - start[se])
    n_blocks = (NK + MOE_BLOCK - 1) // MOE_BLOCK + N_EXPERTS
    P = n_blocks * MOE_BLOCK
    buf_tok = jnp.full((P,), N, jnp.int32).at[dest].set(flat_tok[order])
    buf_w = jnp.zeros((P,), h.dtype).at[dest].set(flat_w[order].astype(h.dtype))
    blk_e = jnp.searchsorted(pad_end, jnp.arange(n_blocks, dtype=jnp.int32) * MOE_BLOCK, side='right')
    blk_e = jnp.minimum(blk_e, N_EXPERTS - 1)
    t_pad = jnp.concatenate([t, jnp.zeros((1, D), t.dtype)], axis=0)
    xb = t_pad[buf_tok].reshape(n_blocks, MOE_BLOCK, D)

    def expert_block(args):
        xblk, e = args
        return (jax.nn.silu(xblk @ w1[e]) * (xblk @ w3[e])) @ w2[e]

    yb = lax.map(expert_block, (xb, blk_e)).reshape(P, D)
    out = jnp.zeros((N + 1, D), h.dtype).at[buf_tok].add(yb * buf_w[:, None])[:N]
    return out.reshape(Bsz, S, D)


def setup_inputs(seed: int = 0) -> dict:
    key = jax.random.key(seed)
    ks = jax.random.split(key, 24)
    D, L = D_MODEL, DEPTH

    def nrm(k, shape, scale):
        return jax.random.normal(k, shape, jnp.float32) * scale

    return {
        "x": nrm(ks[0], (BATCH, SEQ, D), 1.0),
        "c": nrm(ks[1], (BATCH, D), 1.0),
        "mod_w": nrm(ks[2], (L, D, 6 * D), 0.5 * D ** -0.5),
        "mod_b": nrm(ks[3], (L, 6 * D), 0.02),
        "norm1_g": 1.0 + nrm(ks[4], (L, D), 0.02),
        "w_in": nrm(ks[5], (L, D, IN_COLS), D ** -0.5),
        "gate_w2": nrm(ks[6], (L, GATE_RANK, GLA_DK), GATE_RANK ** -0.5),
        "gate_b": nrm(ks[7], (L, GLA_DK), 0.1),
        "gla_norm_g": 1.0 + nrm(ks[8], (L, GLA_DV), 0.02),
        "conv_w": nrm(ks[9], (L, CONV_WIDTH, CONV_DIM), CONV_WIDTH ** -0.5),
        "w_gla_out": nrm(ks[10], (L, GLA_DV, D), GLA_DV ** -0.5),
        "w_conv_out": nrm(ks[11], (L, CONV_DIM, D), CONV_DIM ** -0.5),
        "w_out": nrm(ks[12], (L, D, D), D ** -0.5),
        "norm2_g": 1.0 + nrm(ks[13], (L, D), 0.02),
        "router_group_w": nrm(ks[14], (L, D, N_GROUPS), D ** -0.5),
        "router_group_b": nrm(ks[15], (L, N_GROUPS), 0.01),
        "router_expert_w": nrm(ks[16], (L, D, N_EXPERTS), D ** -0.5),
        "router_expert_b": nrm(ks[17], (L, N_EXPERTS), 0.01),
        "expert_w1": nrm(ks[18], (L, N_EXPERTS, D, D_EXPERT), D ** -0.5),
        "expert_w3": nrm(ks[19], (L, N_EXPERTS, D, D_EXPERT), D ** -0.5),
        "expert_w2": nrm(ks[20], (L, N_EXPERTS, D_EXPERT, D), D_EXPERT ** -0.5),
        "final_norm_g": 1.0 + nrm(ks[21], (D,), 0.02),
    }


def reference(x, c, mod_w, mod_b, norm1_g, w_in, gate_w2, gate_b, gla_norm_g, conv_w,
              w_gla_out, w_conv_out, w_out, norm2_g, router_group_w, router_group_b,
              router_expert_w, router_expert_b, expert_w1, expert_w3, expert_w2, final_norm_g):
    for l in range(DEPTH):
        mod = jax.nn.silu(c) @ mod_w[l] + mod_b[l]
        sh1, sc1, g1, sh2, sc2, g2 = jnp.split(mod, 6, axis=-1)
        h = rmsnorm(x, norm1_g[l]) * (1.0 + sc1[:, None]) + sh1[:, None]
        y = token_mixer(h, w_in[l], gate_w2[l], gate_b[l], gla_norm_g[l], conv_w[l],
                        w_gla_out[l], w_conv_out[l], w_out[l])
        x = x + g1[:, None] * y
        h = rmsnorm(x, norm2_g[l]) * (1.0 + sc2[:, None]) + sh2[:, None]
        y = hier_moe(h, router_group_w[l], router_group_b[l], router_expert_w[l],
                     router_expert_b[l], expert_w1[l], expert_w3[l], expert_w2[l])
        x = x + g2[:, None] * y
    return rmsnorm(x, final_norm_g)
```

```cpp
#include <hip/hip_runtime.h>
#include <cstdio>
#include <cstdint>

#ifndef MK_N_LAUNCHES
#define MK_N_LAUNCHES 1
#endif

#define GAS __attribute__((address_space(1)))
#define LAS __attribute__((address_space(3)))
typedef unsigned short bf16;
typedef short bf16x8 __attribute__((ext_vector_type(8)));
typedef short s16x4 __attribute__((ext_vector_type(4)));
typedef float f32x4 __attribute__((ext_vector_type(4)));
typedef float f32x2 __attribute__((ext_vector_type(2)));
typedef float f32x16 __attribute__((ext_vector_type(16)));
typedef unsigned u32x4 __attribute__((ext_vector_type(4)));
typedef unsigned u32x2 __attribute__((ext_vector_type(2)));
typedef __bf16 bf16x2_t __attribute__((ext_vector_type(2)));

constexpr int BATCH = 8, SEQ = 4096, D = 1024, NTOK = BATCH * SEQ, DEPTH = 2;
constexpr int ZLD = 5120 + 128;
constexpr int ZCB = 0, ZCC = 1024, ZCH = 2048, ZGA = 3072, ZGC = 4096;
constexpr int INCOLS = 8208, GDN_COL = 2048;
constexpr int NEXP = 64, DEXP = 512, CAP = 32768, MAXROWS = 81920;
constexpr int MODW = 6144;
constexpr float EPS = 1e-6f;
constexpr int NWAVES = 8, NTHR = 512;

constexpr size_t MiB = 1u << 20;
constexpr size_t WS_CTL = 0, CTL_ZERO_BYTES = 1 * MiB;
constexpr size_t WS_MOD = 1 * MiB;
constexpr size_t WS_ROUTE = 2 * MiB;
constexpr size_t WS_GDN = 4 * MiB;
constexpr size_t WS_LTOK = 8 * MiB;
constexpr size_t WS_LW = 16 * MiB;
constexpr size_t WS_WR = 24 * MiB;
constexpr size_t WS_WG = 25 * MiB;
constexpr size_t WS_WIN = 26 * MiB;
constexpr int WOEP = 2048 + 64;
constexpr size_t WO_L = 7 * MiB, WO_OUT = 5 * MiB;
constexpr size_t WS_WO3 = 58 * MiB;
constexpr size_t WS_SLOC = 72 * MiB;
constexpr size_t WS_DSEG = 104 * MiB;
constexpr int AEP = 2048 + 128;
constexpr size_t WS_AE = 106 * MiB;
constexpr size_t WS_W13 = 106 * MiB;
constexpr size_t WS_W2 = 234 * MiB;
constexpr size_t WS_H = 298 * MiB;
constexpr size_t WS_Z = 362 * MiB;
constexpr size_t WS_QH = 690 * MiB, WS_KH = 722 * MiB;
constexpr size_t WS_VH = 754 * MiB, WS_RH = 818 * MiB;
constexpr size_t WS_LOGITS = WS_Z;
constexpr size_t WS_H1 = WS_Z + 16 * MiB;
constexpr size_t WS_YB = WS_Z + 96 * MiB;
constexpr size_t WS_MODP = 884 * MiB;
constexpr size_t WS_EB = 888 * MiB;
constexpr size_t WS_CDEC = 920 * MiB;
constexpr size_t WS_XB = 922 * MiB;
constexpr size_t WS_END = 986 * MiB;
constexpr int CW_BAR = 4096, CW_CNT = 16384;

constexpr int RING_BYTES = 131072;
constexpr int LDSCTL_OFF = RING_BYTES;
constexpr int L_BARW = LDSCTL_OFF + 32;
constexpr int L_TB = LDSCTL_OFF + 64;
constexpr int L_CNT = LDSCTL_OFF + 256;
constexpr int L_PRE = LDSCTL_OFF + 512;
constexpr int L_LCNT = LDSCTL_OFF + 768;
constexpr int L_LBASE = LDSCTL_OFF + 1024;
constexpr int L_MBEI = LDSCTL_OFF + 2048;
constexpr int L_TOKT = LDSCTL_OFF + 4096;
constexpr int LDS_BYTES = 147456;

#define RLX_AGENT __ATOMIC_RELAXED, __HIP_MEMORY_SCOPE_AGENT
#define LDS_WAIT() asm volatile("s_waitcnt lgkmcnt(0)" ::: "memory")
#define VM_WAIT() asm volatile("s_waitcnt vmcnt(0)" ::: "memory")

__device__ __forceinline__ unsigned pk2(float lo, float hi) { bf16x2_t v; v[0] = (__bf16)lo; v[1] = (__bf16)hi; return __builtin_bit_cast(unsigned, v); }
__device__ __forceinline__ float bflo(unsigned u) { return __builtin_bit_cast(float, u << 16); }
__device__ __forceinline__ float bfhi(unsigned u) { return __builtin_bit_cast(float, u & 0xffff0000u); }
__device__ __forceinline__ float fsigmoid(float x) { return __builtin_amdgcn_rcpf(1.0f + __expf(-x)); }
__device__ __forceinline__ float wave_sum(float v) {
#pragma unroll
    for (int o = 1; o < 64; o <<= 1) v += __shfl_xor(v, o);
    return v;
}

#define XB_TMO      128
#define XB_XCNT(j)  (256  + 64 * (j))
#define XB_XSUB(j)  (1280 + 64 * (j))
#define XB_XGEN(j)  (2304 + 64 * (j))
#define XB_TOP      3328
#define XB_TOPGEN   3392
#define XCD_BAR_WORDS 3456
#define XB_SPIN_CAP (1u << 18)

__device__ __forceinline__ unsigned xb_ld(unsigned* p)              { return __hip_atomic_load(p, __ATOMIC_RELAXED, __HIP_MEMORY_SCOPE_AGENT); }
__device__ __forceinline__ unsigned xb_add(unsigned* p, unsigned v) { return __hip_atomic_fetch_add(p, v, __ATOMIC_RELAXED, __HIP_MEMORY_SCOPE_AGENT); }
__device__ __forceinline__ unsigned xb_xcc_id() { return (unsigned)__builtin_amdgcn_s_getreg((3 << 11) | 20) & 0xFu; }
#define XB_SPIN(cond, bar) do { unsigned _sp = 0; while (cond) { __builtin_amdgcn_s_sleep(1); \
    if ((++_sp & 255u) == 0u) { if (xb_ld(&(bar)[XB_TMO])) break; if (_sp > XB_SPIN_CAP) { atomicAdd(&(bar)[XB_TMO], 1u); break; } } } } while (0)

struct XcdBarrier { unsigned* bar; unsigned x; volatile LAS unsigned* st; };

__device__ __forceinline__ XcdBarrier xcd_barrier_post(unsigned* bar, volatile LAS unsigned* st) {
    XcdBarrier b; b.bar = bar; b.x = xb_xcc_id(); b.st = st;
    if (threadIdx.x == 0) (void)xb_add(&bar[XB_XCNT(b.x)], 1u);
    return b;
}
__device__ __forceinline__ void xcd_barrier_complete(unsigned* bar, unsigned x, unsigned& nloc, unsigned& nx) {
    const unsigned G = gridDim.x * gridDim.y * gridDim.z;
    unsigned sum, cnt, mine, sp = 0u;
    for (;;) {
        sum = 0u; cnt = 0u; mine = 0u;
#pragma unroll
        for (unsigned j = 0; j < 16; ++j) { const unsigned c = xb_ld(&bar[XB_XCNT(j)]); sum += c; cnt += (c > 0u) ? 1u : 0u; mine = (j == x) ? c : mine; }
        if (sum == G) break;
        __builtin_amdgcn_s_sleep(1);
        if ((++sp & 255u) == 0u) { if (xb_ld(&bar[XB_TMO])) break; if (sp > XB_SPIN_CAP) { atomicAdd(&bar[XB_TMO], 1u); break; } }
    }
    nloc = mine > 0u ? mine : 1u; nx = cnt > 0u ? cnt : 1u;
}
__device__ __forceinline__ void xcd_barrier(const XcdBarrier& b) {
    asm volatile("s_waitcnt vmcnt(0)" ::: "memory");
    __syncthreads();
    if (threadIdx.x == 0) {
        unsigned* bar = b.bar;
        __builtin_amdgcn_s_waitcnt(0);
        unsigned nloc = b.st[0], nx = b.st[1];
        if (nloc == 0u) { xcd_barrier_complete(bar, b.x, nloc, nx); b.st[0] = nloc; b.st[1] = nx; }
        const unsigned old = xb_add(&bar[XB_XSUB(b.x)], 1u);
        const unsigned gen = old / nloc;
        if (old + 1u == (gen + 1u) * nloc) {
            __builtin_amdgcn_fence(__ATOMIC_RELEASE, "agent");
            asm volatile("s_waitcnt vmcnt(0)" ::: "memory");
            const unsigned og = xb_add(&bar[XB_TOP], 1u);
            const unsigned tg = og / nx;
            if (og + 1u == (tg + 1u) * nx) xb_add(&bar[XB_TOPGEN], 1u);
            else XB_SPIN(xb_ld(&bar[XB_TOPGEN]) == tg, bar);
            __builtin_amdgcn_fence(__ATOMIC_ACQUIRE, "agent");
            xb_add(&bar[XB_XGEN(b.x)], 1u);
            asm volatile("s_waitcnt vmcnt(0)" ::: "memory");
        } else {
            XB_SPIN(xb_ld(&bar[XB_XGEN(b.x)]) == gen, bar);
            __builtin_amdgcn_fence(__ATOMIC_ACQUIRE, "agent");
            asm volatile("s_waitcnt vmcnt(0)" ::: "memory");
        }
    }
    __syncthreads();
}

namespace pg8 {
constexpr int BM = 256, BK = 64, HALF = 128, HTB = HALF * BK * 2, STAGE_BYTES = 8 * HTB, NXCD = 8, WGM = 4;
__host__ __device__ __forceinline__ int lds_byte(int r, int c) { const int st = (r >> 4) * 2 + (c >> 5), rr = r & 15, cc = c & 31, ob = rr * 64 + cc * 2; return st * 1024 + (ob ^ (((ob >> 9) & 1) << 5)); }
__host__ __device__ __forceinline__ void stage_rc(int b, int& R, int& C) { const int st = b / 1024, sb = b % 1024, swz = sb ^ (((sb >> 9) & 1) << 5); R = (st >> 1) * 16 + swz / 64; C = (st & 1) * 32 + (swz % 64) / 2; }
__host__ __device__ __forceinline__ int perm32(int rho) { const int n = rho >> 4, i = rho & 15; return 8 * (i >> 2) + 4 * n + (i & 3); }

struct Unit { int pm, pn, e, mi, slot; };

struct StaticOrder {
    int nM, nN, nwg, G, c; unsigned lda2; unsigned ldb2;
    int wgm = WGM;
    int i0 = 0, i1 = 1 << 30;
    int kshift = 30; size_t kjump = 0; bool headA = false;
    __device__ void init(int M, int N, int G_, int c_, int lda, int ldb) { nM = M / BM; nN = N / BM; nwg = nM * nN; G = G_; c = c_; lda2 = (unsigned)lda * 2u; ldb2 = (unsigned)ldb * 2u; }
    __device__ void init_head(int M, int N, int G_, int c_, int ldb) { init(M, N, G_, c_, 256, ldb); kshift = 2; kjump = (size_t)SEQ * 512; headA = true; }
    __device__ __forceinline__ size_t kbyte(int kt) const { return (size_t)(kt & ((1 << kshift) - 1)) * 128 + (size_t)(kt >> kshift) * kjump; }
    __device__ bool next(int i, Unit& u) const {
        if (i0 + i >= i1) return false;
        const long L = (long)(i0 + i) * G + c; if (L >= nwg) return false;
        int wgid = (int)L; { const int q = nwg / NXCD, r = nwg % NXCD, xcd = wgid % NXCD, off = wgid / NXCD; wgid = (xcd < r ? xcd * (q + 1) : r * (q + 1) + (xcd - r) * q) + off; }
        const int nig = wgm * nN, gid = wgid / nig, fm = gid * wgm, gsz = (nM - fm) < wgm ? (nM - fm) : wgm;
        u.pm = fm + ((wgid % nig) % gsz); u.pn = (wgid % nig) / gsz; u.e = 0; u.mi = 0; u.slot = 0; return true;
    }
    static constexpr bool GATHER_A = false;
    __device__ __forceinline__ void a_off(const Unit& u, int ui, const int (&R)[2], const int (&C)[2], unsigned (&vo)[2][2]) const {}
    __device__ __forceinline__ size_t a_base(const Unit& u) const { return headA ? ((size_t)(u.pm >> 4) * 4 * SEQ + (size_t)(u.pm & 15) * BM) * 512 : (size_t)u.pm * BM * lda2; }
    __device__ __forceinline__ size_t b_off(const Unit& u) const { return (size_t)u.pn * BM * ldb2; }
    __device__ __forceinline__ unsigned ldb_bytes() const { return ldb2; }
    __device__ __forceinline__ unsigned lda_bytes() const { return lda2; }
};

template <bool GATHER> struct MoeOrder {
    LAS unsigned char* lds; int G, c; unsigned ldb2;
    __device__ bool next(int i, Unit& u) const {
        const int TB = *(const LAS int*)(lds + L_TB);
        const int mb = i * 64 + (c & 7) * 8 + (c >> 5);
        if (mb >= TB) return false;
        const int ei = ((const LAS int*)(lds + L_MBEI))[mb];
        u.pm = mb; u.pn = (c >> 3) & 3; u.e = ei >> 16; u.mi = ei & 0xffff; u.slot = i & 7; return true;
    }
    static constexpr bool GATHER_A = GATHER;
    __device__ __forceinline__ void a_off(const Unit& u, int ui, const int (&R)[2], const int (&C)[2], unsigned (&vo)[2][2]) const {
#pragma unroll
        for (int h = 0; h < 2; ++h)
#pragma unroll
            for (int i = 0; i < 2; ++i) { const int tok = ((const LAS int*)(lds + L_TOKT))[(ui & 7) * 256 + h * HALF + R[i]]; vo[h][i] = (unsigned)tok * 2048u + (unsigned)C[i] * 2u; }
    }
    __device__ __forceinline__ size_t a_base(const Unit& u) const { return (size_t)u.pm * BM * 1024u; }
    __device__ __forceinline__ size_t b_off(const Unit& u) const { return ((size_t)u.e * 1024 + (size_t)u.pn * BM) * ldb2; }
    __device__ __forceinline__ unsigned ldb_bytes() const { return ldb2; }
    __device__ __forceinline__ unsigned lda_bytes() const { return GATHER ? 2048u : 1024u; }
    __device__ __forceinline__ size_t kbyte(int kt) const { return (size_t)kt * 128; }
};

template <class Epi, class Sched, bool ALIGN_EPI, bool DEFER = false, bool RESC = false>
__device__ __forceinline__ void gemm_phase(LAS unsigned char* lds, int tid, const char* Abase, const char* Bbase, int K, const Sched& S, const Epi& E) {
    constexpr bool GATHER = Sched::GATHER_A;
    const int wid = __builtin_amdgcn_readfirstlane(tid >> 6), lane = tid & 63, wr = wid >> 2, wc = wid & 3, fr = lane & 15, fq = lane >> 4;
    const int nt = K / BK;
    int Rs[2], Cs[2]; unsigned voffB[2], voffA[2];
    const unsigned ldb2 = S.ldb_bytes(), lda2 = S.lda_bytes();
#pragma unroll
    for (int i = 0; i < 2; ++i) { int R, C; stage_rc(tid * 16 + i * 8192, R, C); Rs[i] = R; Cs[i] = C; const int Rb = Epi::PERM ? ((R & ~31) + perm32(R & 31)) : R;
        voffB[i] = (unsigned)Rb * ldb2 + (unsigned)C * 2u; voffA[i] = (unsigned)R * lda2 + (unsigned)C * 2u; }
    const size_t kstep = (size_t)(BK * 2);
    const size_t hstepB = (size_t)HALF * ldb2, hstepA = (size_t)HALF * lda2;
    const unsigned ldsw = (unsigned)wid * 1024u;
    const int aoff = lds_byte(wr * 64 + fr, fq * 8), boff = lds_byte(wc * 32 + fr, fq * 8);
#define PG8_SA(b, h) (((b) * 2 + (h)) * HTB)
#define PG8_SB(b, h) ((4 + (b) * 2 + (h)) * HTB)
#define PG8_STAGE(bufoff, gbase, v0, v1) do { \
        __builtin_amdgcn_global_load_lds((const unsigned*)((const char*)(gbase) + (v0)), (LAS unsigned*)(lds + (bufoff) + ldsw), 16, 0, 0); \
        __builtin_amdgcn_global_load_lds((const unsigned*)((const char*)(gbase) + (v1)), (LAS unsigned*)(lds + (bufoff) + ldsw + 8192), 16, 0, 0); } while (0)
#define PG8_STAGEB(bufoff, gbase) PG8_STAGE(bufoff, gbase, voffB[0], voffB[1])
#define PG8_STAGEA(bufoff, kb, h, nx) do { if constexpr (GATHER) { const unsigned o0_ = (nx) ? vN[h][0] : vA[h][0], o1_ = (nx) ? vN[h][1] : vA[h][1]; PG8_STAGE(bufoff, Abase + (kb), o0_, o1_); } \
        else { const char* p_ = Abase + ((nx) ? uN : uA) + (kb) + (h) * hstepA; PG8_STAGE(bufoff, p_, voffA[0], voffA[1]); } } while (0)
#define PG8_LDA(dst, b, h) do { _Pragma("unroll") for (int m = 0; m < 4; ++m) _Pragma("unroll") for (int k = 0; k < 2; ++k) dst[m][k] = *(const LAS bf16x8*)(lds + PG8_SA(b, h) + aoff + m * 2048 + k * 1024); } while (0)
#define PG8_LDB(dst, b, h) do { _Pragma("unroll") for (int n = 0; n < 2; ++n) _Pragma("unroll") for (int k = 0; k < 2; ++k) dst[n][k] = *(const LAS bf16x8*)(lds + PG8_SB(b, h) + boff + n * 2048 + k * 1024); } while (0)
#define PG8_MMA(ai, bj, At, Bt) do { __builtin_amdgcn_s_setprio(1); _Pragma("unroll") for (int m = 0; m < 4; ++m) _Pragma("unroll") for (int n = 0; n < 2; ++n) _Pragma("unroll") for (int k = 0; k < 2; ++k) \
        acc[ai][bj][m][n] = __builtin_amdgcn_mfma_f32_16x16x32_bf16(Bt[n][k], At[m][k], acc[ai][bj][m][n], 0, 0, 0); __builtin_amdgcn_s_setprio(0); } while (0)
#define PG8_WAIT_V(n) asm volatile("s_waitcnt vmcnt(" #n ")" ::: "memory")
#define PG8_WAIT_L(n) asm volatile("s_waitcnt lgkmcnt(" #n ")" ::: "memory")
#define PG8_BAR __builtin_amdgcn_s_barrier()
#define PG8_SCHED __builtin_amdgcn_sched_barrier(0)
    Unit cur, nxt, prv; int ui = 0;
    if (!S.next(0, cur)) return;
    prv = cur;
    f32x4 acc[2][2][4][2];
#pragma unroll
    for (int a = 0; a < 2; ++a)
#pragma unroll
        for (int b = 0; b < 2; ++b)
#pragma unroll
            for (int m = 0; m < 4; ++m)
#pragma unroll
                for (int n = 0; n < 2; ++n) acc[a][b][m][n] = (f32x4){0.f, 0.f, 0.f, 0.f};
    bf16x8 At[4][2], B0[2][2], B1[2][2];
    unsigned vA[2][2], vN[2][2]; size_t uA = 0, uN = 0;
    if constexpr (GATHER) S.a_off(cur, 0, Rs, Cs, vA); else uA = S.a_base(cur);
    const char* cB = Bbase + S.b_off(cur);
    PG8_STAGEB(PG8_SB(0, 0), cB); PG8_STAGEB(PG8_SB(0, 1), cB + hstepB); PG8_STAGEA(PG8_SA(0, 0), 0, 0, false); PG8_STAGEA(PG8_SA(0, 1), 0, 1, false);
    if (wr == 1) PG8_BAR;
    PG8_WAIT_V(2); PG8_BAR;
    PG8_STAGEB(PG8_SB(1, 0), cB + kstep); PG8_STAGEA(PG8_SA(1, 0), kstep, 0, false); PG8_STAGEB(PG8_SB(1, 1), cB + hstepB + kstep);
    PG8_WAIT_V(6); PG8_BAR;
    for (;;) {
        const bool has_next = S.next(ui + 1, nxt);
        if constexpr (GATHER) {
            if (has_next) S.a_off(nxt, ui + 1, Rs, Cs, vN);
            else {
#pragma unroll
                for (int h = 0; h < 2; ++h)
#pragma unroll
                    for (int i = 0; i < 2; ++i) vN[h][i] = vA[h][i];
            }
        } else uN = has_next ? S.a_base(nxt) : uA;
        const char* nB = has_next ? Bbase + S.b_off(nxt) : cB;
#define PG8_WAITX(n16, n32) do { if constexpr (Epi::NST == 16) PG8_WAIT_V(n16); else PG8_WAIT_V(n32); } while (0)
#define PG8_ZERO(ai) do { _Pragma("unroll") for (int b_ = 0; b_ < 2; ++b_) _Pragma("unroll") for (int m_ = 0; m_ < 4; ++m_) _Pragma("unroll") for (int n_ = 0; n_ < 2; ++n_) acc[ai][b_][m_][n_] = (f32x4){0.f, 0.f, 0.f, 0.f}; } while (0)
#define PG8_BODY(EPI) do { \
            asm volatile("" : "+v"(voffB[0]), "+v"(voffB[1]), "+v"(voffA[0]), "+v"(voffA[1]));     \
            const bool last = (t == nt - 2); \
            const size_t k1 = S.kbyte(t + 1), k2 = last ? 0 : S.kbyte(t + 2), k3 = last ? kstep : S.kbyte(t + 3); \
            const char* b2 = last ? nB : cB + (size_t)(t + 2) * kstep; const char* b3 = b2 + kstep; \
              \
            PG8_LDB(B0, 0, 0); PG8_LDB(B1, 0, 1); PG8_SCHED; PG8_LDA(At, 0, 0); PG8_STAGEA(PG8_SA(1, 1), k1, 1, false); \
            if constexpr (EPI) { PG8_SCHED; int fr_ = fr, fq_ = fq; asm volatile("" : "+v"(fr_), "+v"(fq_)); E.template run<0, 1>(acc, prv, wr, wc, fr_, fq_); PG8_ZERO(0); PG8_SCHED; PG8_WAITX(16, 24); } else PG8_WAIT_V(8); \
            PG8_WAIT_L(0); PG8_BAR; PG8_MMA(0, 0, At, B0); PG8_MMA(0, 1, At, B1); PG8_BAR; PG8_SCHED; \
              \
            PG8_LDA(At, 0, 1); PG8_STAGEB(PG8_SB(0, 0), b2); PG8_STAGEB(PG8_SB(0, 1), b2 + hstepB); PG8_STAGEA(PG8_SA(0, 0), k2, 0, last); \
            if constexpr (EPI) { PG8_SCHED; int fr_ = fr, fq_ = fq; asm volatile("" : "+v"(fr_), "+v"(fq_)); E.template run<1, 2>(acc, prv, wr, wc, fr_, fq_); PG8_ZERO(1); PG8_SCHED; PG8_WAITX(24, 40); } else PG8_WAIT_V(8); \
            PG8_WAIT_L(0); PG8_BAR; PG8_MMA(1, 0, At, B0); PG8_MMA(1, 1, At, B1); PG8_BAR; PG8_SCHED; \
              \
            PG8_LDB(B0, 1, 0); PG8_LDB(B1, 1, 1); PG8_SCHED; PG8_LDA(At, 1, 0); PG8_STAGEA(PG8_SA(0, 1), k2, 1, last); \
            if constexpr (EPI) PG8_WAITX(24, 40); else PG8_WAIT_V(8); \
            PG8_WAIT_L(0); PG8_BAR; PG8_MMA(0, 0, At, B0); PG8_MMA(0, 1, At, B1); PG8_BAR; PG8_SCHED; \
              \
            PG8_LDA(At, 1, 1); PG8_STAGEB(PG8_SB(1, 0), b3); PG8_STAGEB(PG8_SB(1, 1), b3 + hstepB); PG8_STAGEA(PG8_SA(1, 0), k3, 0, last); \
            if constexpr (EPI) PG8_WAITX(16, 24); else PG8_WAIT_V(8); \
            PG8_WAIT_L(0); PG8_BAR; PG8_MMA(1, 0, At, B0); PG8_MMA(1, 1, At, B1); PG8_BAR; PG8_SCHED; \
        } while (0)
        if constexpr (DEFER) {
            int t = 0;
            PG8_BODY(true);
            for (t = 2; t < nt; t += 2) PG8_BODY(false);
        } else if constexpr (RESC) {
            for (int t = 0; t < nt / 2; t += 2) PG8_BODY(false);
            { int fr_ = fr, fq_ = fq; asm volatile("" : "+v"(fr_), "+v"(fq_)); E.rescale(acc, cur, wr, wc, fr_, fq_); }
            for (int t = nt / 2; t < nt; t += 2) PG8_BODY(false);
        } else {
            for (int t = 0; t < nt; t += 2) PG8_BODY(false);
        }
        if (!DEFER || !has_next) {
            if constexpr (ALIGN_EPI) { if (wr == 0) PG8_BAR; }
            { int fr_ = fr, fq_ = fq; asm volatile("" : "+v"(fr_), "+v"(fq_)); E.template run<0, 2>(acc, cur, wr, wc, fr_, fq_); }
            if (!has_next) break;
            PG8_ZERO(0); PG8_ZERO(1);
            if constexpr (ALIGN_EPI) { if (wr == 1) PG8_BAR; }
        }
        prv = cur;
        cur = nxt; cB = nB; ++ui; uA = uN;
        if constexpr (GATHER) {
#pragma unroll
            for (int h = 0; h < 2; ++h)
#pragma unroll
                for (int i = 0; i < 2; ++i) vA[h][i] = vN[h][i];
        }
    }
    PG8_WAIT_V(0);
    if constexpr (!ALIGN_EPI) { if (wr == 0) PG8_BAR; }
    PG8_BAR;
#undef PG8_SA
#undef PG8_SB
#undef PG8_STAGE
#undef PG8_STAGEA
#undef PG8_STAGEB
#undef PG8_LDA
#undef PG8_LDB
#undef PG8_MMA
#undef PG8_WAIT_V
#undef PG8_WAITX
#undef PG8_ZERO
#undef PG8_BODY
#undef PG8_WAIT_L
#undef PG8_BAR
#undef PG8_SCHED
}

typedef const f32x4 (&AccRef)[2][2][4][2];

struct EpiZ {
    static constexpr bool PERM = true; static constexpr int NST = 16;
    unsigned char* ws;
    template <int A0, int A1> __device__ __forceinline__ void run(AccRef acc, const Unit& u, int wr, int wc, int fr, int fq) const {
        const int b = u.pm >> 4, tl = (u.pm & 15) * BM + wr * 64 + fr;
        char* base; unsigned off0, rowp, bjs;
        if (u.pn < 4) { base = (char*)ws + (u.pn < 2 ? WS_QH : WS_KH);
            off0 = ((unsigned)((b * 4 + (u.pn & 1) * 2) * SEQ + tl) * 128u + (unsigned)(wc * 32 + 8 * fq)) * 2u; rowp = 256u; bjs = (unsigned)SEQ * 256u; }
        else if (u.pn < 12) { base = (char*)ws + (u.pn < 8 ? WS_VH : WS_RH);
            off0 = ((unsigned)((b * 4 + ((u.pn - 4) & 3)) * SEQ + tl) * 256u + (unsigned)(wc * 32 + 8 * fq)) * 2u; rowp = 512u; bjs = 256u; }
        else if (u.pn >= 16 && u.pn < 24) {
            const unsigned o0 = ((unsigned)(u.pm * BM + wr * 64 + fr) * (unsigned)ZLD + (unsigned)(ZCC + (u.pn - 16) * 128 + wc * 16 + 4 * fq)) * 2u; char* zb = (char*)ws + WS_Z;
#pragma unroll
            for (int ai = A0; ai < A1; ++ai)
#pragma unroll
                for (int m = 0; m < 4; ++m)
#pragma unroll
                    for (int bj = 0; bj < 2; ++bj) { const f32x4 a = acc[ai][bj][m][0], b2 = acc[ai][bj][m][1];
                        u32x2 w; w.x = pk2(a[0] * b2[0], a[1] * b2[1]); w.y = pk2(a[2] * b2[2], a[3] * b2[3]);
                        *(u32x2*)(zb + (o0 + (unsigned)(ai * HALF + m * 16) * (unsigned)(ZLD * 2) + (unsigned)(bj * 128))) = w; }
            return; }
        else { base = (char*)ws + WS_Z;
            const int zc = u.pn < 16 ? ZCB + (u.pn - 12) * BM : ZGA + (u.pn - 24) * BM;
            off0 = ((unsigned)(u.pm * BM + wr * 64 + fr) * (unsigned)ZLD + (unsigned)(zc + wc * 32 + 8 * fq)) * 2u; rowp = (unsigned)ZLD * 2u; bjs = 256u; }
#pragma unroll
        for (int ai = A0; ai < A1; ++ai)
#pragma unroll
            for (int m = 0; m < 4; ++m) { const unsigned ro = off0 + (unsigned)(ai * HALF + m * 16) * rowp;
#pragma unroll
                for (int bj = 0; bj < 2; ++bj) { f32x4 v0 = acc[ai][bj][m][0], v1 = acc[ai][bj][m][1];
                    if (u.pn >= 24) {
#pragma unroll
                        for (int j = 0; j < 4; ++j) { v0[j] = fsigmoid(v0[j]); v1[j] = fsigmoid(v1[j]); } }
                    else if (u.pn >= 8 && u.pn < 12) {
#pragma unroll
                        for (int j = 0; j < 4; ++j) { v0[j] = v0[j] * fsigmoid(v0[j]); v1[j] = v1[j] * fsigmoid(v1[j]); } }
                    u32x4 w; w.x = pk2(v0[0], v0[1]); w.y = pk2(v0[2], v0[3]); w.z = pk2(v1[0], v1[1]); w.w = pk2(v1[2], v1[3]);
                    *(u32x4*)(base + (ro + (unsigned)bj * bjs)) = w; } }
    }
};
template <bool FIRST> struct EpiGate {
    static constexpr bool PERM = true; static constexpr int NST = 16;
    const bf16* Gt; bf16* Y; int ldc;
    template <int A0, int A1> __device__ __forceinline__ void run(AccRef acc, const Unit& u, int wr, int wc, int fr, int fq) const {
        const unsigned off0 = ((unsigned)(u.pm * BM + wr * 64 + fr) * (unsigned)ldc + (unsigned)(u.pn * BM + wc * 32 + 8 * fq)) * 2u;
        const char* gb = (const char*)Gt; char* yb = (char*)Y;
#pragma unroll
        for (int ai = A0; ai < A1; ++ai)
#pragma unroll
            for (int mp = 0; mp < 2; ++mp) {
                u32x4 g[2][2], p[2][2];
#pragma unroll
                for (int mm = 0; mm < 2; ++mm)
#pragma unroll
                    for (int bj = 0; bj < 2; ++bj) { const unsigned ro = off0 + (unsigned)(ai * HALF + (2 * mp + mm) * 16) * (unsigned)ldc * 2u + (unsigned)(bj * 256);
                        g[mm][bj] = *(const u32x4*)(gb + ro); if (!FIRST) p[mm][bj] = *(const u32x4*)(yb + ro); }
#pragma unroll
                for (int mm = 0; mm < 2; ++mm)
#pragma unroll
                    for (int bj = 0; bj < 2; ++bj) { const int m = 2 * mp + mm; const f32x4 v0 = acc[ai][bj][m][0], v1 = acc[ai][bj][m][1]; const u32x4 gg = g[mm][bj];
                        float y[8];
                        y[0] = bflo(gg.x) * v0[0]; y[1] = bfhi(gg.x) * v0[1]; y[2] = bflo(gg.y) * v0[2]; y[3] = bfhi(gg.y) * v0[3];
                        y[4] = bflo(gg.z) * v1[0]; y[5] = bfhi(gg.z) * v1[1]; y[6] = bflo(gg.w) * v1[2]; y[7] = bfhi(gg.w) * v1[3];
                        if (!FIRST) { const u32x4 pp = p[mm][bj];
                            y[0] += bflo(pp.x); y[1] += bfhi(pp.x); y[2] += bflo(pp.y); y[3] += bfhi(pp.y); y[4] += bflo(pp.z); y[5] += bfhi(pp.z); y[6] += bflo(pp.w); y[7] += bfhi(pp.w); }
                        u32x4 w; w.x = pk2(y[0], y[1]); w.y = pk2(y[2], y[3]); w.z = pk2(y[4], y[5]); w.w = pk2(y[6], y[7]);
                        const unsigned ro = off0 + (unsigned)(ai * HALF + m * 16) * (unsigned)ldc * 2u + (unsigned)(bj * 256);
                        *(u32x4*)(yb + ro) = w; }
                asm volatile("" ::: "memory");
            }
    }
};
struct EpiGate2 {
    static constexpr bool PERM = true; static constexpr int NST = 16;
    const bf16* SA; const bf16* SC; bf16* Y; int ldc;
    typedef f32x4 (&AccMut)[2][2][4][2];
    __device__ __forceinline__ void rescale(AccMut acc, const Unit& u, int wr, int wc, int fr, int fq) const {
        const unsigned off0 = ((unsigned)(u.pm * BM + wr * 64 + fr) * (unsigned)ldc + (unsigned)(u.pn * BM + wc * 32 + 8 * fq)) * 2u;
        const char* ab = (const char*)SA; const char* cb = (const char*)SC;
#pragma unroll
        for (int ai = 0; ai < 2; ++ai)
#pragma unroll
            for (int mp = 0; mp < 2; ++mp) {
                u32x4 ga[2][2], gc[2][2];
#pragma unroll
                for (int mm = 0; mm < 2; ++mm)
#pragma unroll
                    for (int bj = 0; bj < 2; ++bj) { const unsigned ro = off0 + (unsigned)(ai * HALF + (2 * mp + mm) * 16) * (unsigned)ldc * 2u + (unsigned)(bj * 256);
                        ga[mm][bj] = *(const u32x4*)(ab + ro); gc[mm][bj] = *(const u32x4*)(cb + ro); }
#pragma unroll
                for (int mm = 0; mm < 2; ++mm)
#pragma unroll
                    for (int bj = 0; bj < 2; ++bj) { const int m = 2 * mp + mm; const u32x4 a = ga[mm][bj], c = gc[mm][bj];
                        f32x4 r0, r1;
#define RC_(x) __builtin_amdgcn_rcpf(fmaxf((x), 1e-30f))
                        r0[0] = bflo(a.x) * RC_(bflo(c.x)); r0[1] = bfhi(a.x) * RC_(bfhi(c.x)); r0[2] = bflo(a.y) * RC_(bflo(c.y)); r0[3] = bfhi(a.y) * RC_(bfhi(c.y));
                        r1[0] = bflo(a.z) * RC_(bflo(c.z)); r1[1] = bfhi(a.z) * RC_(bfhi(c.z)); r1[2] = bflo(a.w) * RC_(bflo(c.w)); r1[3] = bfhi(a.w) * RC_(bfhi(c.w));
#undef RC_
                        acc[ai][bj][m][0] = acc[ai][bj][m][0] * r0; acc[ai][bj][m][1] = acc[ai][bj][m][1] * r1; }
                asm volatile("" ::: "memory");
            }
    }
    template <int A0, int A1> __device__ __forceinline__ void run(AccRef acc, const Unit& u, int wr, int wc, int fr, int fq) const {
        const unsigned off0 = ((unsigned)(u.pm * BM + wr * 64 + fr) * (unsigned)ldc + (unsigned)(u.pn * BM + wc * 32 + 8 * fq)) * 2u;
        const char* cb = (const char*)SC; char* yb = (char*)Y;
#pragma unroll
        for (int ai = A0; ai < A1; ++ai) {
            u32x4 gc[4][2];
#pragma unroll
            for (int m = 0; m < 4; ++m)
#pragma unroll
                for (int bj = 0; bj < 2; ++bj) gc[m][bj] = *(const u32x4*)(cb + (off0 + (unsigned)(ai * HALF + m * 16) * (unsigned)ldc * 2u + (unsigned)(bj * 256)));
#pragma unroll
            for (int m = 0; m < 4; ++m)
#pragma unroll
                for (int bj = 0; bj < 2; ++bj) { const f32x4 v0 = acc[ai][bj][m][0], v1 = acc[ai][bj][m][1]; const u32x4 c = gc[m][bj];
                    u32x4 w; w.x = pk2(bflo(c.x) * v0[0], bfhi(c.x) * v0[1]); w.y = pk2(bflo(c.y) * v0[2], bfhi(c.y) * v0[3]); w.z = pk2(bflo(c.z) * v1[0], bfhi(c.z) * v1[1]); w.w = pk2(bflo(c.w) * v1[2], bfhi(c.w) * v1[3]);
                    *(u32x4*)(yb + (off0 + (unsigned)(ai * HALF + m * 16) * (unsigned)ldc * 2u + (unsigned)(bj * 256))) = w; }
            asm volatile("" ::: "memory");
        }
    }
};
template <bool XF32> struct EpiResid {
    static constexpr bool PERM = true; static constexpr int NST = 16;
    const float* xin32; const bf16* xin16; bf16* xout; const float* g1;
    template <int A0, int A1> __device__ __forceinline__ void run(AccRef acc, const Unit& u, int wr, int wc, int fr, int fq) const {
        const unsigned e0 = (unsigned)(u.pm * BM + wr * 64 + fr) * (unsigned)D + (unsigned)(u.pn * BM + wc * 32 + 8 * fq);
        const float* gp = g1 + (size_t)(u.pm >> 4) * MODW + (u.pn * BM + wc * 32 + 8 * fq);
        f32x4 gv[2][2];
#pragma unroll
        for (int bj = 0; bj < 2; ++bj)
#pragma unroll
            for (int n = 0; n < 2; ++n) gv[bj][n] = *(const f32x4*)(gp + bj * HALF + n * 4);
        if constexpr (!XF32) {
            constexpr int NB = (A1 - A0) * 2;
            u32x4 xr[2][2][2];
#define ER_LD(buf, q) do { _Pragma("unroll") for (int mm = 0; mm < 2; ++mm) _Pragma("unroll") for (int bj = 0; bj < 2; ++bj) \
                xr[buf][mm][bj] = *(const u32x4*)((const char*)xin16 + (e0 + (unsigned)((A0 + ((q) >> 1)) * HALF + (2 * ((q) & 1) + mm) * 16) * (unsigned)D + (unsigned)(bj * HALF)) * 2u); } while (0)
            ER_LD(0, 0);
#pragma unroll
            for (int q = 0; q < NB; ++q) {
                if (q + 1 < NB) { if ((q & 1) == 0) ER_LD(1, q + 1); else ER_LD(0, q + 1); }
                const int ai = A0 + (q >> 1), mp = q & 1;
#pragma unroll
                for (int mm = 0; mm < 2; ++mm)
#pragma unroll
                    for (int bj = 0; bj < 2; ++bj) { const int m = 2 * mp + mm; const unsigned eo = e0 + (unsigned)(ai * HALF + m * 16) * (unsigned)D + (unsigned)(bj * HALF); const u32x4 t = xr[q & 1][mm][bj];
                        const f32x4 x0 = (f32x4){bflo(t.x), bfhi(t.x), bflo(t.y), bfhi(t.y)}, x1 = (f32x4){bflo(t.z), bfhi(t.z), bflo(t.w), bfhi(t.w)};
                        const f32x4 y0 = x0 + gv[bj][0] * acc[ai][bj][m][0], y1 = x1 + gv[bj][1] * acc[ai][bj][m][1];
                        u32x4 w; w.x = pk2(y0[0], y0[1]); w.y = pk2(y0[2], y0[3]); w.z = pk2(y1[0], y1[1]); w.w = pk2(y1[2], y1[3]);
                        *(u32x4*)((char*)xout + eo * 2u) = w; }
                asm volatile("" ::: "memory");
            }
#undef ER_LD
            return;
        }
#pragma unroll
        for (int ai = A0; ai < A1; ++ai)
#pragma unroll
            for (int mp = 0; mp < 2; ++mp) {
                f32x4 xv[2][2][2];
#pragma unroll
                for (int mm = 0; mm < 2; ++mm)
#pragma unroll
                    for (int bj = 0; bj < 2; ++bj) { const unsigned eo = e0 + (unsigned)(ai * HALF + (2 * mp + mm) * 16) * (unsigned)D + (unsigned)(bj * HALF);
                        if (XF32) { xv[mm][bj][0] = *(const f32x4*)((const char*)xin32 + eo * 4u); xv[mm][bj][1] = *(const f32x4*)((const char*)xin32 + (eo * 4u + 16u)); }
                        else { const u32x4 t = *(const u32x4*)((const char*)xin16 + eo * 2u);
                            xv[mm][bj][0] = (f32x4){bflo(t.x), bfhi(t.x), bflo(t.y), bfhi(t.y)}; xv[mm][bj][1] = (f32x4){bflo(t.z), bfhi(t.z), bflo(t.w), bfhi(t.w)}; } }
#pragma unroll
                for (int mm = 0; mm < 2; ++mm)
#pragma unroll
                    for (int bj = 0; bj < 2; ++bj) { const int m = 2 * mp + mm; const unsigned eo = e0 + (unsigned)(ai * HALF + m * 16) * (unsigned)D + (unsigned)(bj * HALF);
                        const f32x4 y0 = xv[mm][bj][0] + gv[bj][0] * acc[ai][bj][m][0], y1 = xv[mm][bj][1] + gv[bj][1] * acc[ai][bj][m][1];
                        u32x4 w; w.x = pk2(y0[0], y0[1]); w.y = pk2(y0[2], y0[3]); w.z = pk2(y1[0], y1[1]); w.w = pk2(y1[2], y1[3]);
                        *(u32x4*)((char*)xout + eo * 2u) = w; }
                asm volatile("" ::: "memory");
            }
    }
};
struct EpiLogits {
    static constexpr bool PERM = false; static constexpr int NST = 16;
    float* L;
    template <int A0, int A1> __device__ __forceinline__ void run(AccRef acc, const Unit& u, int wr, int wc, int fr, int fq) const {
        const int row0 = u.pm * BM + wr * 64 + fr, col0 = wc * 32 + 4 * fq;
#pragma unroll
        for (int ai = A0; ai < A1; ++ai)
#pragma unroll
            for (int m = 0; m < 4; ++m) { float* rowp = L + (size_t)(row0 + ai * HALF + m * 16) * 128 + col0;
#pragma unroll
                for (int n = 0; n < 2; ++n) *(f32x4*)(rowp + n * 16) = acc[ai][0][m][n]; }
    }
};
struct EpiAct {
    static constexpr bool PERM = true; static constexpr int NST = 16;
    bf16* H1;
    template <int A0, int A1> __device__ __forceinline__ void run(AccRef acc, const Unit& u, int wr, int wc, int fr, int fq) const {
        const int row0 = u.pm * BM + wr * 64 + fr, col0 = u.pn * 128 + wc * 16 + 4 * fq;
#pragma unroll
        for (int ai = A0; ai < A1; ++ai)
#pragma unroll
            for (int m = 0; m < 4; ++m) { bf16* rowp = H1 + (size_t)(row0 + ai * HALF + m * 16) * DEXP + col0;
#pragma unroll
                for (int bj = 0; bj < 2; ++bj) { const f32x4 a = acc[ai][bj][m][0], b = acc[ai][bj][m][1];
                    float y[4];
#pragma unroll
                    for (int j = 0; j < 4; ++j) y[j] = a[j] * fsigmoid(a[j]) * b[j];
                    u32x2 w; w.x = pk2(y[0], y[1]); w.y = pk2(y[2], y[3]);
                    *(u32x2*)(rowp + bj * 64) = w; } }
    }
};
struct EpiYb {
    static constexpr bool PERM = true; static constexpr int NST = 16;
    bf16* YB; const float* lw; LAS unsigned char* lds;
    template <int A0, int A1> __device__ __forceinline__ void run(AccRef acc, const Unit& u, int wr, int wc, int fr, int fq) const {
        const int rl0 = wr * 64 + fr;
        const unsigned off0 = ((unsigned)(u.pm * BM + rl0) * (unsigned)D + (unsigned)(u.pn * BM + wc * 32 + 8 * fq)) * 2u;
        char* base = (char*)YB; const LAS float* wt = (const LAS float*)(lds + L_TOKT) + u.slot * 256 + rl0;
        float wgt[2][4];
#pragma unroll
        for (int ai = A0; ai < A1; ++ai)
#pragma unroll
            for (int m = 0; m < 4; ++m) wgt[ai][m] = wt[ai * HALF + m * 16];
#pragma unroll
        for (int ai = A0; ai < A1; ++ai)
#pragma unroll
            for (int m = 0; m < 4; ++m) { const unsigned ro = off0 + (unsigned)(ai * HALF + m * 16) * (unsigned)(D * 2);
#pragma unroll
                for (int bj = 0; bj < 2; ++bj) { const f32x4 v0 = acc[ai][bj][m][0] * wgt[ai][m], v1 = acc[ai][bj][m][1] * wgt[ai][m];
                    u32x4 w; w.x = pk2(v0[0], v0[1]); w.y = pk2(v0[2], v0[3]); w.z = pk2(v1[0], v1[1]); w.w = pk2(v1[2], v1[3]);
                    *(u32x4*)(base + (ro + (unsigned)(bj * 256))) = w; } }
    }
};
}

struct Args { const float* in[22]; float* out; unsigned char* ws; int ph_lo, ph_hi; };
struct Frame {
    LAS unsigned char* lds;
    unsigned* ctl;
    unsigned char* ws;
    int tid, lane, wave, G, bx;
    float* out;
};

__device__ __forceinline__ void tr_item(const float* W, int ldw, int k0, int scol0, bf16* WT, int ldt, int drow0, int ilv, float scale, LAS float* scr, int lane) {
#pragma unroll 8
    for (int i = 0; i < 32; ++i) { const int kk = 2 * i + (lane >> 5); scr[kk * 33 + (lane & 31)] = W[(size_t)(k0 + kk) * ldw + scol0 + (lane & 31)] * scale; }
    LDS_WAIT(); asm volatile("" ::: "memory");
    const int c = lane & 7;
#pragma unroll
    for (int j = 0; j < 4; ++j) { const int n = (lane >> 3) + 8 * j; const LAS float* s = scr + (8 * c) * 33 + n;
        u32x4 o; o.x = pk2(s[0 * 33], s[1 * 33]); o.y = pk2(s[2 * 33], s[3 * 33]); o.z = pk2(s[4 * 33], s[5 * 33]); o.w = pk2(s[6 * 33], s[7 * 33]);
        const int drow = ilv ? drow0 + 8 * (n >> 2) + (n & 3) + 4 * (ilv - 1) : drow0 + n;
        *(u32x4*)(WT + (size_t)drow * ldt + k0 + 8 * c) = o; }
    LDS_WAIT(); asm volatile("" ::: "memory");
}

__device__ __forceinline__ void p0_prologue(Frame& F, const Args& A) {
    const int gw = F.bx * NWAVES + F.wave, NGW = F.G * NWAVES;
    {
        LAS float* sc = (LAS float*)(F.lds + 69632);
        bool have = false;
        for (int it = F.bx; it < 192; it += F.G) {
            if (!have) { for (int i = F.tid; i < 8192; i += NTHR) { const float v = A.in[1][i]; sc[i] = v * fsigmoid(v); } __syncthreads(); have = true; }
            const int l = it / 96, cc = (it % 96) >> 3, kc = it & 7, col = cc * 512 + F.tid;
            const float* w = A.in[2] + ((size_t)l * D + kc * 128) * MODW + col;
            float a[8];
#pragma unroll
            for (int b = 0; b < 8; ++b) a[b] = 0.f;
#pragma unroll 32
            for (int k = 0; k < 128; ++k) { const float wv = w[(size_t)k * MODW];
#pragma unroll
                for (int b = 0; b < 8; ++b) a[b] += sc[b * 1024 + kc * 128 + k] * wv; }
            float* mo = (float*)(F.ws + WS_MODP) + ((size_t)(kc * 2 + l) * 8) * MODW + col;
#pragma unroll
            for (int b = 0; b < 8; ++b) mo[(size_t)b * MODW] = a[b];
        }
        __syncthreads();
    }
    LAS float* scr = (LAS float*)(F.lds + F.wave * 8448);
    constexpr int I_IN = 16 * 256, I_SQ = 16 * 32, I_L = I_IN + 3 * I_SQ;
    for (int it = gw; it < 2 * I_L; it += NGW) {
        const int l = it / I_L; int r = it % I_L;
        if (r < I_IN) { const int kb = r / 256, nb = r % 256, n0 = nb * 32; const int scol = n0 < 2048 ? n0 : n0 + 16;
            bf16* wt = (bf16*)(F.ws + WS_WIN) + (size_t)l * 8192 * 1024;
            if (nb >= 128 && nb < 192) {
                const int sh = (nb - 128) >> 5, nq = (nb - 128) & 31;
                tr_item(A.in[5] + (size_t)l * D * INCOLS, INCOLS, kb * 64, (sh ? 5136 : 4112) + 32 * nq, wt, 1024, 4096 + 64 * nq, 1 + sh, 1.0f, scr, F.lane); }
            else tr_item(A.in[5] + (size_t)l * D * INCOLS, INCOLS, kb * 64, scol, wt, 1024, n0, 0, n0 < 512 ? 0.08838834764831845f : 1.0f, scr, F.lane);
            continue; }
        r -= I_IN; const int which = r / I_SQ; r %= I_SQ; const int kb = r / 32, nb = r % 32;
        bf16* dst = (bf16*)(F.ws + WS_WO3 + (size_t)l * WO_L);
        if (which == 0) tr_item(A.in[10] + (size_t)l * D * D, D, kb * 64, nb * 32, dst + 1024, WOEP, nb * 32, 0, 1.0f, scr, F.lane);
        else if (which == 1) tr_item(A.in[11] + (size_t)l * D * D, D, kb * 64, nb * 32, dst, WOEP, nb * 32, 0, 1.0f, scr, F.lane);
        else tr_item(A.in[12] + (size_t)l * D * D, D, kb * 64, nb * 32, (bf16*)(F.ws + WS_WO3 + (size_t)l * WO_L + WO_OUT), 1024, nb * 32, 0, 1.0f, scr, F.lane);
    }
    {
        const int gt = F.bx * NTHR + F.tid, NGT = F.G * NTHR;
        bf16* wr = (bf16*)(F.ws + WS_WR);
        for (int i = gt; i < 2 * 256 * 1024; i += NGT) { const int l = i >> 18, n = (i >> 10) & 255, k = i & 1023;
            float v = 0.f; if (n < 8) v = A.in[14][((size_t)l * D + k) * 8 + n]; else if (n < 72) v = A.in[16][((size_t)l * D + k) * 64 + (n - 8)];
            wr[i] = (bf16)(pk2(v, 0.f) & 0xffffu); }
        float* wg = (float*)(F.ws + WS_WG);
        for (int i = gt; i < 2 * 16 * 1024; i += NGT) { const int l = i >> 14, c = (i >> 10) & 15, k = i & 1023;
            wg[i] = A.in[5][((size_t)l * D + k) * INCOLS + GDN_COL + c]; }
    }
}

struct TrItem { const float* wp; int ldw; bf16* wt; int ldt; int drow0, ilv, k0; };
__device__ __forceinline__ void tr_load(const TrItem& t, float (&v)[32], int lane) {
    const float* wp = t.wp + (size_t)(t.k0 + (lane >> 5)) * t.ldw + (lane & 31);
#pragma unroll
    for (int i = 0; i < 32; ++i) v[i] = __builtin_nontemporal_load(wp + (size_t)(2 * i) * t.ldw);
}
__device__ __forceinline__ void tr_store(const TrItem& t, const float (&v)[32], LAS float* scr, int lane) {
#pragma unroll
    for (int i = 0; i < 32; ++i) scr[(2 * i + (lane >> 5)) * 33 + (lane & 31)] = v[i];
    LDS_WAIT(); asm volatile("" ::: "memory");
    const int c = lane & 7;
#pragma unroll
    for (int j = 0; j < 4; ++j) { const int n = (lane >> 3) + 8 * j; const LAS float* s = scr + (8 * c) * 33 + n;
        u32x4 o; o.x = pk2(s[0 * 33], s[1 * 33]); o.y = pk2(s[2 * 33], s[3 * 33]); o.z = pk2(s[4 * 33], s[5 * 33]); o.w = pk2(s[6 * 33], s[7 * 33]);
        const int drow = t.ilv ? t.drow0 + 8 * (n >> 2) + (n & 3) + 4 * (t.ilv - 1) : t.drow0 + n;
        __builtin_nontemporal_store(o, (u32x4*)(t.wt + (size_t)drow * t.ldt + t.k0 + 8 * c)); }
    LDS_WAIT(); asm volatile("" ::: "memory");
}
__device__ __forceinline__ TrItem expert_item(Frame& F, const Args& A, int l, int it) {
    constexpr int I13 = 16 * 16, I2 = 8 * 32, IE = 2 * I13 + I2;
    const int e = it / IE; int r = it % IE; TrItem t;
    if (r < 2 * I13) { const int s = r / I13; r %= I13; const int kb = r / 16, nb = r % 16;
        t.wp = (s == 0 ? A.in[18] : A.in[19]) + ((size_t)l * NEXP + e) * D * DEXP + nb * 32; t.ldw = DEXP;
        t.wt = (bf16*)(F.ws + WS_W13) + (size_t)e * 1024 * 1024; t.ldt = 1024; t.drow0 = 2 * nb * 32; t.ilv = 1 + s; t.k0 = kb * 64; }
    else { r -= 2 * I13; const int kb = r / 32, nb = r % 32;
        t.wp = A.in[20] + ((size_t)l * NEXP + e) * DEXP * D + nb * 32; t.ldw = D;
        t.wt = (bf16*)(F.ws + WS_W2) + (size_t)e * 1024 * 512; t.ldt = 512; t.drow0 = nb * 32; t.ilv = 0; t.k0 = kb * 64; }
    return t;
}
__device__ __forceinline__ void convert_experts(Frame& F, const Args& A, int l) {
    const int gw = F.bx * NWAVES + F.wave, NGW = F.G * NWAVES;
    LAS float* scr = (LAS float*)(F.lds + F.wave * 8448);
    constexpr int NIT = NEXP * (2 * 16 * 16 + 8 * 32);
    TrItem ta, tb, tc, td; float va[32], vb[32], vc[32], vd[32];
    int it = gw;
    if (it >= NIT) return;
    ta = expert_item(F, A, l, it); tr_load(ta, va, F.lane);
    if (it + NGW < NIT) { tb = expert_item(F, A, l, it + NGW); tr_load(tb, vb, F.lane); }
    if (it + 2 * NGW < NIT) { tc = expert_item(F, A, l, it + 2 * NGW); tr_load(tc, vc, F.lane); }
#define CV_STEP(TL, VL, TS, VS) do { if (it + 3 * NGW < NIT) { TL = expert_item(F, A, l, it + 3 * NGW); tr_load(TL, VL, F.lane); } \
        tr_store(TS, VS, scr, F.lane); it += NGW; } while (0)
#pragma unroll 1
    for (;;) {
        CV_STEP(td, vd, ta, va); if (it >= NIT) break;
        CV_STEP(ta, va, tb, vb); if (it >= NIT) break;
        CV_STEP(tb, vb, tc, vc); if (it >= NIT) break;
        CV_STEP(tc, vc, td, vd); if (it >= NIT) break;
    }
#undef CV_STEP
}

__device__ __forceinline__ void moe_tables(Frame& F, int l) {
    LAS int* CNT = (LAS int*)(F.lds + L_CNT); LAS int* PRE = (LAS int*)(F.lds + L_PRE); LAS int* MBEI = (LAS int*)(F.lds + L_MBEI);
    __syncthreads();
    if (F.tid < NEXP) CNT[F.tid] = (int)__hip_atomic_load(F.ctl + CW_CNT + (l * 64 + F.tid) * 64, RLX_AGENT);
    __syncthreads();
    if (F.tid < NEXP) {
        const int nb = (CNT[F.tid] + 255) >> 8; int inc = nb;
#pragma unroll
        for (int o = 1; o < 64; o <<= 1) { const int v = __shfl_up(inc, o); if (F.tid >= o) inc += v; }
        const int pre = inc - nb; PRE[F.tid] = pre;
        for (int i = 0; i < nb; ++i) MBEI[pre + i] = (F.tid << 16) | i;
        if (F.tid == NEXP - 1) *(LAS int*)(F.lds + L_TB) = inc; }
    __syncthreads();
}
__device__ __forceinline__ void moe_toktab(Frame& F) {
    const int TB = *(const LAS int*)(F.lds + L_TB);
    const LAS int* CNT = (const LAS int*)(F.lds + L_CNT); const LAS int* MBEI = (const LAS int*)(F.lds + L_MBEI);
    LAS int* TOKT = (LAS int*)(F.lds + L_TOKT);
    const int* ltok = (const int*)(F.ws + WS_LTOK);
    for (int i = 0; i < 8; ++i) { const int mb = i * 64 + (F.bx & 7) * 8 + (F.bx >> 5); if (mb >= TB) break;
        if (F.tid < 256) { const int ei = MBEI[mb], e = ei >> 16, rank = (ei & 0xffff) * 256 + F.tid;
            TOKT[i * 256 + F.tid] = rank < CNT[e] ? ltok[(size_t)e * CAP + rank] : 0; } }
    __syncthreads();
}

__device__ __forceinline__ void moe_wtab(Frame& F) {
    const int TB = *(const LAS int*)(F.lds + L_TB);
    const LAS int* CNT = (const LAS int*)(F.lds + L_CNT); const LAS int* MBEI = (const LAS int*)(F.lds + L_MBEI);
    LAS float* WT = (LAS float*)(F.lds + L_TOKT);
    const float* lw = (const float*)(F.ws + WS_LW);
    for (int i = 0; i < 8; ++i) { const int mb = i * 64 + (F.bx & 7) * 8 + (F.bx >> 5); if (mb >= TB) break;
        if (F.tid < 256) { const int ei = MBEI[mb], e = ei >> 16, rank = (ei & 0xffff) * 256 + F.tid;
            WT[i * 256 + F.tid] = rank < CNT[e] ? lw[(size_t)e * CAP + rank] : 0.f; } }
    __syncthreads();
}
template <bool COMBINE, bool WRITE_X, bool GDN, bool FINAL, bool MODPART = false, bool XBF = true>
__device__ __forceinline__ void row_phase(Frame& F, const float* xin, float* xout, bf16* hout, const float* gain, const float* modl, int sc_off, int sh_off,
                                          const float* modprev, const float* wg, float* gdn_out, const float* modbias = nullptr) {
    LAS float* GV = (LAS float*)(F.lds); LAS float* SHV = (LAS float*)(F.lds + 4096); LAS float* G2P = (LAS float*)(F.lds + 8192); LAS float* WG = (LAS float*)(F.lds + 16384);
    const LAS int* PRE = (const LAS int*)(F.lds + L_PRE);
    if (GDN) { for (int i = F.tid; i < 16 * 1024; i += NTHR) WG[i] = wg[i]; }
    for (int ch = F.bx; ch < NTOK / 128; ch += F.G) {
        const int b = ch >> 5;
        __syncthreads();
        for (int k = F.tid; k < D; k += NTHR) {
            if (FINAL) { GV[k] = gain[k]; SHV[k] = 0.f; }
            else if (MODPART) {
                float a = modbias[sc_off + k], c2 = modbias[sh_off + k];
#pragma unroll
                for (int kc = 0; kc < 8; ++kc) { a += modl[(size_t)kc * 16 * MODW + (size_t)b * MODW + sc_off + k]; c2 += modl[(size_t)kc * 16 * MODW + (size_t)b * MODW + sh_off + k]; }
                GV[k] = gain[k] * (1.0f + a); SHV[k] = c2; }
            else { GV[k] = gain[k] * (1.0f + modl[(size_t)b * MODW + sc_off + k]); SHV[k] = modl[(size_t)b * MODW + sh_off + k]; }
            if (COMBINE) G2P[k] = modprev[(size_t)b * MODW + 5120 + k];
        }
        __syncthreads();
#pragma unroll 1
        for (int g = 0; g < 8; ++g) {
            const int r0 = ch * 128 + F.wave * 16 + g * 2;
            f32x4 v[2][4];
#pragma unroll
            for (int r = 0; r < 2; ++r)
#pragma unroll
                for (int j = 0; j < 4; ++j) {
                    if (XBF) { const u32x2 t = *(const u32x2*)((const bf16*)xin + (size_t)(r0 + r) * D + 256 * j + 4 * F.lane); v[r][j] = (f32x4){bflo(t.x), bfhi(t.x), bflo(t.y), bfhi(t.y)}; }
                    else v[r][j] = *(const f32x4*)(xin + (size_t)(r0 + r) * D + 256 * j + 4 * F.lane); }
            if (COMBINE) {
                const int* route = (const int*)(F.ws + WS_ROUTE); const bf16* yb = (const bf16*)(F.ws + WS_YB);
#pragma unroll
                for (int r = 0; r < 2; ++r) {
                    const int er0 = route[2 * (r0 + r)], er1 = route[2 * (r0 + r) + 1];
                    const int row_a = (PRE[er0 >> 16] + ((er0 & 0xffff) >> 8)) * 256 + (er0 & 255);
                    const int row_b = (PRE[er1 >> 16] + ((er1 & 0xffff) >> 8)) * 256 + (er1 & 255);
#pragma unroll
                    for (int j = 0; j < 4; ++j) {
                        const u32x2 ya = *(const u32x2*)(yb + (size_t)row_a * D + 256 * j + 4 * F.lane), yc = *(const u32x2*)(yb + (size_t)row_b * D + 256 * j + 4 * F.lane);
                        const f32x4 gg = *(const LAS f32x4*)(G2P + 256 * j + 4 * F.lane);
                        f32x4 s; s[0] = bflo(ya.x) + bflo(yc.x); s[1] = bfhi(ya.x) + bfhi(yc.x); s[2] = bflo(ya.y) + bflo(yc.y); s[3] = bfhi(ya.y) + bfhi(yc.y);
                        v[r][j] = v[r][j] + gg * s;
                    }
                }
            }
            float rstd[2];
#pragma unroll
            for (int r = 0; r < 2; ++r) { float s = 0.f;
#pragma unroll
                for (int j = 0; j < 4; ++j) s += (v[r][j][0] * v[r][j][0] + v[r][j][1] * v[r][j][1]) + (v[r][j][2] * v[r][j][2] + v[r][j][3] * v[r][j][3]);
                rstd[r] = rsqrtf(wave_sum(s) * (1.0f / D) + EPS); }
            if (WRITE_X) {
#pragma unroll
                for (int r = 0; r < 2; ++r)
#pragma unroll
                    for (int j = 0; j < 4; ++j) { u32x2 w; w.x = pk2(v[r][j][0], v[r][j][1]); w.y = pk2(v[r][j][2], v[r][j][3]); *(u32x2*)((bf16*)xout + (size_t)(r0 + r) * D + 256 * j + 4 * F.lane) = w; }
            }
#pragma unroll
            for (int j = 0; j < 4; ++j) { const f32x4 gg = *(const LAS f32x4*)(GV + 256 * j + 4 * F.lane), ss = *(const LAS f32x4*)(SHV + 256 * j + 4 * F.lane);
#pragma unroll
                for (int r = 0; r < 2; ++r) v[r][j] = v[r][j] * rstd[r] * gg + ss; }
            if (FINAL) {
#pragma unroll
                for (int r = 0; r < 2; ++r)
#pragma unroll
                    for (int j = 0; j < 4; ++j) *(f32x4*)(xout + (size_t)(r0 + r) * D + 256 * j + 4 * F.lane) = v[r][j];
            } else {
#pragma unroll
                for (int r = 0; r < 2; ++r)
#pragma unroll
                    for (int j = 0; j < 4; ++j) { u32x2 w; w.x = pk2(v[r][j][0], v[r][j][1]); w.y = pk2(v[r][j][2], v[r][j][3]);
                        *(u32x2*)(hout + (size_t)(r0 + r) * D + 256 * j + 4 * F.lane) = w; }
            }
            if (GDN) {
                float p[32];
#pragma unroll
                for (int c = 0; c < 16; ++c) {
                    f32x4 wv[4];
#pragma unroll
                    for (int j = 0; j < 4; ++j) wv[j] = *(const LAS f32x4*)(WG + c * 1024 + 256 * j + 4 * F.lane);
#pragma unroll
                    for (int r = 0; r < 2; ++r) { float s = 0.f;
#pragma unroll
                        for (int j = 0; j < 4; ++j) s += (v[r][j][0] * wv[j][0] + v[r][j][1] * wv[j][1]) + (v[r][j][2] * wv[j][2] + v[r][j][3] * wv[j][3]);
                        p[r * 16 + c] = s; }
                    asm volatile("" ::: "memory");
                }
#define SWZX(x, o) __builtin_bit_cast(float, __builtin_amdgcn_ds_swizzle(__builtin_bit_cast(int, (x)), ((o) << 10) | 0x1f))
#define BFLY(o) do { const bool up = (F.lane & (o)) != 0; _Pragma("unroll") for (int i = 0; i < (o); ++i) { const float a_ = p[i], b_ = p[i + (o)]; const float t_ = SWZX(up ? a_ : b_, (o)); p[i] = (up ? b_ : a_) + t_; } } while (0)
                BFLY(16); BFLY(8); BFLY(4); BFLY(2); BFLY(1);
#undef BFLY
#undef SWZX
                const float tot = p[0] + __shfl_xor(p[0], 32);
                if (F.lane < 32) gdn_out[(size_t)r0 * 16 + F.lane] = tot;
            }
        }
    }
    __syncthreads();
}

__device__ __forceinline__ void conv_phase(Frame& F, const Args& A, int l) {
    bf16* z = (bf16*)(F.ws + WS_Z);
    const float* cw = A.in[9] + (size_t)l * 3 * D;
    const int cg = F.tid & 127, run = F.tid >> 7;
    float w0[8], w1[8], w2[8];
#pragma unroll
    for (int j = 0; j < 8; ++j) { w0[j] = cw[cg * 8 + j]; w1[j] = cw[D + cg * 8 + j]; w2[j] = cw[2 * D + cg * 8 + j]; }
    for (int ch = F.bx; ch < NTOK / 128; ch += F.G) {
        const int t0 = ch * 128 + run * 32;
        float um2[8], um1[8];
#pragma unroll
        for (int j = 0; j < 8; ++j) { um2[j] = 0.f; um1[j] = 0.f; }
        if ((t0 & (SEQ - 1)) != 0) {
            const u32x4 c2 = *(const u32x4*)(z + (size_t)(t0 - 2) * ZLD + ZCC + cg * 8), c1 = *(const u32x4*)(z + (size_t)(t0 - 1) * ZLD + ZCC + cg * 8);
            um2[0] = bflo(c2.x); um2[1] = bfhi(c2.x); um2[2] = bflo(c2.y); um2[3] = bfhi(c2.y); um2[4] = bflo(c2.z); um2[5] = bfhi(c2.z); um2[6] = bflo(c2.w); um2[7] = bfhi(c2.w);
            um1[0] = bflo(c1.x); um1[1] = bfhi(c1.x); um1[2] = bflo(c1.y); um1[3] = bfhi(c1.y); um1[4] = bflo(c1.z); um1[5] = bfhi(c1.z); um1[6] = bflo(c1.w); um1[7] = bfhi(c1.w);
        }
        u32x4 ca[8], ba[8], cb2[8], bb2[8];
#define CV_LD(cc_, bb_, i0_) do { _Pragma("unroll") for (int r = 0; r < 8; ++r) { const size_t ro_ = (size_t)(t0 + (i0_) + r) * ZLD + cg * 8; \
            cc_[r] = __builtin_nontemporal_load((const u32x4*)(z + ro_ + ZCC)); bb_[r] = __builtin_nontemporal_load((const u32x4*)(z + ro_ + ZCB)); } } while (0)
#define CV_DO(cc_, bb_, i0_) do { _Pragma("unroll") for (int r = 0; r < 8; ++r) { const size_t ro_ = (size_t)(t0 + (i0_) + r) * ZLD + cg * 8; const u32x4 cc = cc_[r], bb = bb_[r]; \
            float u[8], bv[8], o[8]; \
            u[0] = bflo(cc.x); u[1] = bfhi(cc.x); u[2] = bflo(cc.y); u[3] = bfhi(cc.y); u[4] = bflo(cc.z); u[5] = bfhi(cc.z); u[6] = bflo(cc.w); u[7] = bfhi(cc.w); \
            bv[0] = bflo(bb.x); bv[1] = bfhi(bb.x); bv[2] = bflo(bb.y); bv[3] = bfhi(bb.y); bv[4] = bflo(bb.z); bv[5] = bfhi(bb.z); bv[6] = bflo(bb.w); bv[7] = bfhi(bb.w); \
            _Pragma("unroll") for (int j = 0; j < 8; ++j) { o[j] = bv[j] * (w0[j] * um2[j] + w1[j] * um1[j] + w2[j] * u[j]); um2[j] = um1[j]; um1[j] = u[j]; } \
            u32x4 w; w.x = pk2(o[0], o[1]); w.y = pk2(o[2], o[3]); w.z = pk2(o[4], o[5]); w.w = pk2(o[6], o[7]); \
            *(u32x4*)(z + ro_ + ZCB) = w; } } while (0)
        CV_LD(ca, ba, 0);
        CV_LD(cb2, bb2, 8);  CV_DO(ca, ba, 0);
        CV_LD(ca, ba, 16);   CV_DO(cb2, bb2, 8);
        CV_LD(cb2, bb2, 24); CV_DO(ca, ba, 16);
        CV_DO(cb2, bb2, 24);
#undef CV_LD
#undef CV_DO
    }
}

constexpr int GL_QS = 272, GL_VS = 528, GL_AS = 144, GL_OS = 528;
constexpr int GL_QT = 0, GL_KT = 17408, GL_VV = 34816, GL_ATT = 68608, GL_OB = 77824, GL_GD = 111616, GL_SEGT = 115712, GL_DEC = 119808, GL_W2 = L_TOKT;
static_assert(GL_DEC + 512 <= RING_BYTES, "GLA LDS map");
#define MFMA32(a, b, c) __builtin_amdgcn_mfma_f32_32x32x16_bf16((a), (b), (c), 0, 0, 0)
#define TR16(p) __builtin_amdgcn_ds_read_tr16_b64_v4i16((LAS s16x4*)(p))

__device__ __forceinline__ float log_sigmoid_f(float x) { return fminf(x, 0.f) - __logf(1.0f + __expf(-fabsf(x))); }

template <bool PASS2>
__device__ __forceinline__ void gla_pass(Frame& F, const Args& A, int l) {
    LAS unsigned char* lds = F.lds;
    char* qh = (char*)(F.ws + WS_QH); char* kh = (char*)(F.ws + WS_KH); char* vh = (char*)(F.ws + WS_VH); const char* rh = (const char*)(F.ws + WS_RH);
    const float* gdn = (const float*)(F.ws + WS_GDN);
    float* dseg = (float*)(F.ws + WS_DSEG);
    char* ebuf = (char*)(F.ws + WS_EB); float* cdec = (float*)(F.ws + WS_CDEC);
#pragma unroll 1
    for (int unit = F.bx; unit < 256; unit += F.G) {
        const int b = unit >> 5, head = (unit >> 3) & 3, seg = unit & 7;
        const int t0 = b * SEQ + seg * 512;
        const int hr0 = (b * 4 + head) * SEQ + seg * 512;
        const bool state = PASS2 || seg < 7;
        f32x2 gb;
        {
            const int tid = F.tid, lane = F.lane, d0 = 2 * lane;
            __syncthreads();
            if (!PASS2) {
#pragma unroll
                for (int j = 0; j < 4; ++j) { const int i = tid + 512 * j; *(LAS float*)(lds + GL_W2 + i * 4) = A.in[6][((size_t)l * 16 + (i >> 7)) * 512 + head * 128 + (i & 127)]; }
                gb = *(const f32x2*)(A.in[7] + (size_t)l * 512 + head * 128 + d0);
            }
        }
        f32x16 S[4];
#pragma unroll
        for (int db = 0; db < 4; ++db)
#pragma unroll
            for (int i = 0; i < 16; ++i) S[db][i] = 0.f;
        if (PASS2 && seg > 0) {
            const int w = F.wave, lane = F.lane, hh = lane >> 5;
            const u32x4* sb = (const u32x4*)(F.ws + WS_SLOC) + ((size_t)((unit - seg) * 8 + w) * 8) * 64 + lane;
            u32x4 b0[8], b1[8], b2[8];
            for (int i = F.tid; i < seg * 128; i += NTHR) *(LAS float*)(lds + GL_OB + i * 4) = dseg[(size_t)(unit - seg) * 128 + i];
#define PF_LD(buf, j_) do { const int jc_ = (j_) < seg ? (j_) : seg - 1; _Pragma("unroll") for (int i = 0; i < 8; ++i) buf[i] = sb[(size_t)jc_ * 4096 + i * 64]; } while (0)
#define PF_FOLD(buf, j_) do { const LAS float* dp = (const LAS float*)(lds + GL_OB) + (j_) * 128 + 4 * hh; \
                _Pragma("unroll") for (int i = 0; i < 8; ++i) _Pragma("unroll") for (int hf = 0; hf < 2; ++hf) { \
                    const int db = (2 * i + hf) >> 2, rg = (2 * i + hf) & 3; const f32x4 dv = *(const LAS f32x4*)(dp + 32 * db + 8 * rg); \
                    const unsigned lo = hf ? buf[i].z : buf[i].x, hi = hf ? buf[i].w : buf[i].y; \
                    S[db][4 * rg] = S[db][4 * rg] * dv[0] + bflo(lo); S[db][4 * rg + 1] = S[db][4 * rg + 1] * dv[1] + bfhi(lo); \
                    S[db][4 * rg + 2] = S[db][4 * rg + 2] * dv[2] + bflo(hi); S[db][4 * rg + 3] = S[db][4 * rg + 3] * dv[3] + bfhi(hi); } } while (0)
            PF_LD(b0, 0); PF_LD(b1, 1);
            __syncthreads();
#pragma unroll 1
            for (int j = 0; j < seg; j += 3) {
                PF_LD(b2, j + 2);
                PF_FOLD(b0, j);
                PF_LD(b0, j + 3);
                if (j + 1 < seg) PF_FOLD(b1, j + 1);
                PF_LD(b1, j + 4);
                if (j + 2 < seg) PF_FOLD(b2, j + 2);
            }
#undef PF_LD
#undef PF_FOLD
        }
        float dsum0 = 0.f, dsum1 = 0.f;
        unsigned kraw[8], qraw[8], eraw[8]; u32x4 vraw[4]; f32x4 gdr = (f32x4){0.f, 0.f, 0.f, 0.f}; u32x4 rraw[4]; f32x2 dcr = (f32x2){0.f, 0.f};
#define GLA_LOADS(co_) do { const size_t hr_ = (size_t)(hr0 + (co_)); const char* kb_ = kh + hr_ * 256; const char* qb_ = qh + hr_ * 256; const char* eb_ = ebuf + hr_ * 256; const char* vb_ = vh + hr_ * 512; \
            if (!PASS2) { if (tid < 256) gdr = *(const f32x4*)(gdn + (size_t)(t0 + (co_)) * 16 + tid * 4); } \
            else if (w == 0) dcr = *(const f32x2*)(cdec + (size_t)((t0 + (co_)) >> 6) * 512 + head * 128 + d0); \
            _Pragma("unroll") for (int ii = 0; ii < 8; ++ii) { \
                kraw[ii] = *(const unsigned*)(kb_ + (offk + (unsigned)(ii * 256))); \
                if (PASS2) { qraw[ii] = *(const unsigned*)(qb_ + (offk + (unsigned)(ii * 256))); eraw[ii] = *(const unsigned*)(eb_ + (offk + (unsigned)(ii * 256))); } } \
            if (state) { _Pragma("unroll") for (int j = 0; j < 4; ++j) vraw[j] = *(const u32x4*)(vb_ + (offv + (unsigned)(j * 16 * 512))); } \
        } while (0)
        {
            const int tid = F.tid, lane = F.lane, w = F.wave, d0 = 2 * lane;
            const unsigned offk = (unsigned)((8 * w) * 128 + d0) * 2u;
            const unsigned offv = (unsigned)((tid >> 5) * 256 + (tid & 31) * 8) * 2u;
            GLA_LOADS(0);
        }
#pragma unroll 1
        for (int c = 0; c < 8; ++c) {
            const int tc = t0 + 64 * c;
            int tq_ = F.tid; asm volatile("" : "+v"(tq_));
            const int tid = tq_, lane = tq_ & 63, w = __builtin_amdgcn_readfirstlane(tq_ >> 6);
            const int r31 = lane & 31, hh = lane >> 5, blk = (lane >> 4) & 1, q4 = (lane & 15) >> 2, p4 = lane & 3;
            const int erow = tid >> 3, ejj = tid & 7, d0 = 2 * lane;
            const unsigned offk = (unsigned)((8 * w) * 128 + d0) * 2u;
            const unsigned offv = (unsigned)((tid >> 5) * 256 + (tid & 31) * 8) * 2u;
            unsigned kn[8]; u32x4 vn[4]; f32x4 gn = (f32x4){0.f, 0.f, 0.f, 0.f};
            if (!PASS2) {
                const int cn_ = 64 * (c < 7 ? c + 1 : c); const size_t hr_ = (size_t)(hr0 + cn_); const char* kb_ = kh + hr_ * 256; const char* vb_ = vh + hr_ * 512;
                if (tid < 256) gn = *(const f32x4*)(gdn + (size_t)(t0 + cn_) * 16 + tid * 4);
#pragma unroll
                for (int ii = 0; ii < 8; ++ii) kn[ii] = *(const unsigned*)(kb_ + (offk + (unsigned)(ii * 256)));
                if (state) {
#pragma unroll
                    for (int j = 0; j < 4; ++j) vn[j] = *(const u32x4*)(vb_ + (offv + (unsigned)(j * 16 * 512))); }
            }
            if (!PASS2) {
                if (tid < 256) *(LAS f32x4*)(lds + GL_GD + tid * 16) = gdr;
                __syncthreads();
                float bl[8][2]; float run0 = 0.f, run1 = 0.f;
#pragma unroll
                for (int ii = 0; ii < 8; ++ii) { bl[ii][0] = gb[0]; bl[ii][1] = gb[1]; }
#pragma unroll
                for (int r4 = 0; r4 < 4; ++r4) {
                    f32x2 wv[4];
#pragma unroll
                    for (int e = 0; e < 4; ++e) wv[e] = *(const LAS f32x2*)(lds + GL_W2 + ((4 * r4 + e) * 128 + d0) * 4);
#pragma unroll
                    for (int ii = 0; ii < 8; ++ii) { const f32x4 g = *(const LAS f32x4*)(lds + GL_GD + (8 * w + ii) * 64 + r4 * 16);
#pragma unroll
                        for (int e = 0; e < 4; ++e) { bl[ii][0] += g[e] * wv[e][0]; bl[ii][1] += g[e] * wv[e][1]; } }
                }
#pragma unroll
                for (int ii = 0; ii < 8; ++ii) { run0 += log_sigmoid_f(bl[ii][0]) * 0.0625f; run1 += log_sigmoid_f(bl[ii][1]) * 0.0625f; bl[ii][0] = run0; bl[ii][1] = run1; }
                *(LAS f32x2*)(lds + GL_SEGT + (w * 128 + d0) * 4) = (f32x2){run0, run1};
                __syncthreads();
                float off0 = 0.f, off1 = 0.f, tot0 = 0.f, tot1 = 0.f;
#pragma unroll
                for (int ww = 0; ww < 8; ++ww) { const f32x2 t = *(const LAS f32x2*)(lds + GL_SEGT + (ww * 128 + d0) * 4); if (ww < w) { off0 += t[0]; off1 += t[1]; } tot0 += t[0]; tot1 += t[1]; }
                if (w == 0) { const f32x2 dd = (f32x2){__expf(tot0), __expf(tot1)}; *(LAS f32x2*)(lds + GL_DEC + d0 * 4) = dd; *(f32x2*)(cdec + (size_t)(tc >> 6) * 512 + head * 128 + d0) = dd; }
                dsum0 += tot0; dsum1 += tot1;
                char* kbp = kh + (size_t)(hr0 + 64 * c) * 256; char* ebp = ebuf + (size_t)(hr0 + 64 * c) * 256;
#pragma unroll
                for (int ii = 0; ii < 8; ++ii) {
                    const float b0 = bl[ii][0] + off0, b1 = bl[ii][1] + off1;
                    const unsigned kt = pk2(bflo(kraw[ii]) * __expf(-b0), bfhi(kraw[ii]) * __expf(-b1));
                    *(LAS unsigned*)(lds + GL_KT + (8 * w + ii) * GL_QS + d0 * 2) = kt;
                    *(unsigned*)(kbp + (offk + (unsigned)(ii * 256))) = kt;
                    *(unsigned*)(ebp + (offk + (unsigned)(ii * 256))) = pk2(__expf(b0), __expf(b1));
                }
            } else {
                if (w == 0) *(LAS f32x2*)(lds + GL_DEC + d0 * 4) = dcr;
#pragma unroll
                for (int ii = 0; ii < 8; ++ii) {
                    *(LAS unsigned*)(lds + GL_KT + (8 * w + ii) * GL_QS + d0 * 2) = kraw[ii];
                    *(LAS unsigned*)(lds + GL_QT + (8 * w + ii) * GL_QS + d0 * 2) = pk2(bflo(qraw[ii]) * bflo(eraw[ii]), bfhi(qraw[ii]) * bfhi(eraw[ii]));
                }
            }
            if (state) {
#pragma unroll
                for (int j = 0; j < 4; ++j) { const int p = tid + 512 * j, row = p >> 5, c16 = p & 31; *(LAS u32x4*)(lds + GL_VV + row * GL_VS + c16 * 16) = vraw[j]; }
            }
            if (PASS2) {
#pragma unroll
                for (int m = 0; m < 4; ++m) rraw[m] = *(const u32x4*)(rh + (size_t)(hr0 + 64 * c + erow) * 512 + (32 * ejj + 8 * m) * 2);
            }
            if (PASS2) { const int cn_ = 64 * (c < 7 ? c + 1 : c); GLA_LOADS(cn_); }
            if (!state) {
                gdr = gn;
#pragma unroll
                for (int ii = 0; ii < 8; ++ii) kraw[ii] = kn[ii];
                continue; }
            __syncthreads();
            bf16x8 Vf[4];
#pragma unroll
            for (int ks = 0; ks < 4; ++ks) { const s16x4 lo = TR16(lds + GL_VV + (16 * ks + 8 * hh + q4) * GL_VS + (32 * w + 16 * blk + 4 * p4) * 2);
                const s16x4 hi = TR16(lds + GL_VV + (16 * ks + 8 * hh + 4 + q4) * GL_VS + (32 * w + 16 * blk + 4 * p4) * 2);
                Vf[ks] = __builtin_shufflevector(lo, hi, 0, 1, 2, 3, 4, 5, 6, 7); }
            __builtin_amdgcn_sched_barrier(0);
            f32x16 o[2];
            if (PASS2) {
                if (w < 3) {
                    const int ib = (w >= 1) ? 1 : 0, jb = (w == 2) ? 1 : 0;
                    f32x16 X;
#pragma unroll
                    for (int i = 0; i < 16; ++i) X[i] = 0.f;
#pragma unroll
                    for (int s = 0; s < 8; ++s) { const bf16x8 a = *(const LAS bf16x8*)(lds + GL_QT + (32 * ib + r31) * GL_QS + (16 * s + 8 * hh) * 2);
                        const bf16x8 bb = *(const LAS bf16x8*)(lds + GL_KT + (32 * jb + r31) * GL_QS + (16 * s + 8 * hh) * 2); X = MFMA32(a, bb, X); if (s & 1) __builtin_amdgcn_sched_barrier(0); }
#pragma unroll
                    for (int i = 0; i < 16; ++i) { const int il = 8 * (i >> 2) + 4 * hh + (i & 3); const float val = (ib == jb && r31 > il) ? 0.f : X[i];
                        *(LAS unsigned short*)(lds + GL_ATT + (32 * ib + il) * GL_AS + (32 * jb + r31) * 2) = (unsigned short)(pk2(val, 0.f) & 0xffffu); }
                }
                __builtin_amdgcn_sched_barrier(0);
#pragma unroll
                for (int i = 0; i < 16; ++i) { o[0][i] = 0.f; o[1][i] = 0.f; }
#pragma unroll
                for (int db = 0; db < 4; ++db)
#pragma unroll
                    for (int s = 0; s < 2; ++s) {
                        u32x4 pb; pb.x = pk2(S[db][8 * s + 0], S[db][8 * s + 1]); pb.y = pk2(S[db][8 * s + 2], S[db][8 * s + 3]); pb.z = pk2(S[db][8 * s + 4], S[db][8 * s + 5]); pb.w = pk2(S[db][8 * s + 6], S[db][8 * s + 7]);
                        const bf16x8 Bf = __builtin_bit_cast(bf16x8, pb);
#pragma unroll
                        for (int ib = 0; ib < 2; ++ib) { const LAS unsigned char* qp = lds + GL_QT + (32 * ib + r31) * GL_QS + (32 * db + 16 * s + 4 * hh) * 2;
                            const s16x4 lo = *(const LAS s16x4*)(qp), hi = *(const LAS s16x4*)(qp + 16);
                            const bf16x8 a = __builtin_shufflevector(lo, hi, 0, 1, 2, 3, 4, 5, 6, 7); o[ib] = MFMA32(a, Bf, o[ib]); }
                        __builtin_amdgcn_sched_barrier(0);
                    }
            }
#pragma unroll
            for (int ks = 0; ks < 4; ++ks)
#pragma unroll
                for (int db = 0; db < 4; ++db) { const s16x4 lo = TR16(lds + GL_KT + (16 * ks + 8 * hh + q4) * GL_QS + (32 * db + 16 * blk + 4 * p4) * 2);
                    const s16x4 hi = TR16(lds + GL_KT + (16 * ks + 8 * hh + 4 + q4) * GL_QS + (32 * db + 16 * blk + 4 * p4) * 2);
                    const bf16x8 a = __builtin_shufflevector(lo, hi, 0, 1, 2, 3, 4, 5, 6, 7); S[db] = MFMA32(a, Vf[ks], S[db]); if (db & 1) __builtin_amdgcn_sched_barrier(0); }
#pragma unroll
            for (int db = 0; db < 4; ++db)
#pragma unroll
                for (int rg = 0; rg < 4; ++rg) { const f32x4 dv = *(const LAS f32x4*)(lds + GL_DEC + (32 * db + 8 * rg + 4 * hh) * 4);
#pragma unroll
                    for (int e = 0; e < 4; ++e) S[db][4 * rg + e] *= dv[e]; }
            if (!PASS2) {
                gdr = gn;
#pragma unroll
                for (int ii = 0; ii < 8; ++ii) kraw[ii] = kn[ii];
#pragma unroll
                for (int j = 0; j < 4; ++j) vraw[j] = vn[j];
            }
            if (PASS2) {
                __syncthreads();
#pragma unroll
                for (int ib = 0; ib < 2; ++ib)
#pragma unroll
                    for (int ks = 0; ks < 4; ++ks) { if (ib == 0 && ks >= 2) continue;
                        const bf16x8 a = *(const LAS bf16x8*)(lds + GL_ATT + (32 * ib + r31) * GL_AS + (16 * ks + 8 * hh) * 2); o[ib] = MFMA32(a, Vf[ks], o[ib]); }
                __builtin_amdgcn_sched_barrier(0);
#pragma unroll
                for (int ib = 0; ib < 2; ++ib)
#pragma unroll
                    for (int i = 0; i < 16; ++i) { const int il = 8 * (i >> 2) + 4 * hh + (i & 3);
                        *(LAS unsigned short*)(lds + GL_OB + (32 * ib + il) * GL_OS + (32 * w + r31) * 2) = (unsigned short)(pk2(o[ib][i], 0.f) & 0xffffu); }
                __syncthreads();
                float ss = 0.f;
#pragma unroll
                for (int m = 0; m < 4; ++m) { const u32x4 t = *(const LAS u32x4*)(lds + GL_OB + erow * GL_OS + (32 * ejj + 8 * m) * 2);
                    ss += (bflo(t.x) * bflo(t.x) + bfhi(t.x) * bfhi(t.x)) + (bflo(t.y) * bflo(t.y) + bfhi(t.y) * bfhi(t.y)) + (bflo(t.z) * bflo(t.z) + bfhi(t.z) * bfhi(t.z)) + (bflo(t.w) * bflo(t.w) + bfhi(t.w) * bfhi(t.w)); }
                ss += __shfl_xor(ss, 1); ss += __shfl_xor(ss, 2); ss += __shfl_xor(ss, 4);
                const float rstd = rsqrtf(ss * (1.0f / 256.0f) + EPS);
                const float* gn = A.in[8] + (size_t)l * D + head * 256 + 32 * ejj;
                bf16* zo = (bf16*)(F.ws + WS_Z) + (size_t)(t0 + 64 * c + erow) * ZLD + ZCH + head * 256 + 32 * ejj;
#pragma unroll
                for (int m = 0; m < 4; ++m) { const f32x4 g0 = *(const f32x4*)(gn + 8 * m), g1 = *(const f32x4*)(gn + 8 * m + 4);
                    const u32x4 t = *(const LAS u32x4*)(lds + GL_OB + erow * GL_OS + (32 * ejj + 8 * m) * 2);
                    const unsigned tt[4] = {t.x, t.y, t.z, t.w};
                    const unsigned rr[4] = {rraw[m].x, rraw[m].y, rraw[m].z, rraw[m].w}; unsigned ww[4];
#pragma unroll
                    for (int e = 0; e < 4; ++e) { const float ra = bflo(rr[e]), rb = bfhi(rr[e]); const float ga = e < 2 ? g0[2 * e] : g1[2 * e - 4], gb2 = e < 2 ? g0[2 * e + 1] : g1[2 * e - 3];
                        ww[e] = pk2(bflo(tt[e]) * rstd * ga * ra, bfhi(tt[e]) * rstd * gb2 * rb); }
                    *(u32x4*)(zo + 8 * m) = (u32x4){ww[0], ww[1], ww[2], ww[3]}; }
            }
        }
#undef GLA_LOADS
        if (!PASS2 && state) {
            const int w = F.wave, lane = F.lane, d0 = 2 * lane;
            u32x4* sp = (u32x4*)(F.ws + WS_SLOC) + ((size_t)(unit * 8 + w) * 8) * 64 + lane;
#pragma unroll
            for (int i = 0; i < 8; ++i) { const int da = (2 * i) >> 2, ra = (2 * i) & 3, dc = (2 * i + 1) >> 2, rc = (2 * i + 1) & 3;
                sp[i * 64] = (u32x4){pk2(S[da][4 * ra], S[da][4 * ra + 1]), pk2(S[da][4 * ra + 2], S[da][4 * ra + 3]), pk2(S[dc][4 * rc], S[dc][4 * rc + 1]), pk2(S[dc][4 * rc + 2], S[dc][4 * rc + 3])}; }
            if (w == 0) *(f32x2*)(dseg + (size_t)unit * 128 + d0) = (f32x2){__expf(dsum0), __expf(dsum1)};
        }
    }
}

__device__ __forceinline__ void norm2_router_phase(Frame& F, const Args& A, int l, const float* modl) {
    LAS float* GV = (LAS float*)(F.lds); LAS float* SHV = (LAS float*)(F.lds + 4096); LAS float* LG = (LAS float*)(F.lds + 16384);
    LAS int* LCNT = (LAS int*)(F.lds + L_LCNT); LAS int* LBASE = (LAS int*)(F.lds + L_LBASE);
    const bf16* xb = (const bf16*)(F.ws + WS_XB); bf16* hout = (bf16*)(F.ws + WS_H);
    const bf16* wr = (const bf16*)(F.ws + WS_WR) + (size_t)l * 256 * 1024;
    const float* gain = A.in[13] + (size_t)l * D;
    const float* rgb = A.in[15] + l * 8; const float* reb = A.in[17] + l * 64;
    int* ltok = (int*)(F.ws + WS_LTOK); float* lw = (float*)(F.ws + WS_LW); int* route = (int*)(F.ws + WS_ROUTE);
    for (int ch = F.bx; ch < NTOK / 128; ch += F.G) {
        const int b = ch >> 5;
        __syncthreads();
        for (int k = F.tid; k < D; k += NTHR) { GV[k] = gain[k] * (1.0f + modl[(size_t)b * MODW + 4096 + k]); SHV[k] = modl[(size_t)b * MODW + 3072 + k]; }
        if (F.tid < 64) LCNT[F.tid] = 0;
        __syncthreads();
        u32x4 wreg[5];
#define RT_GLOAD(sl) do { _Pragma("unroll") for (int j = 0; j < 5; ++j) { const int u_ = F.tid + NTHR * j; wreg[j] = *(const u32x4*)((const char*)wr + (size_t)(u_ >> 5) * 2048 + (sl) * 512 + (u_ & 31) * 16); } } while (0)
#define RT_LSTORE(bo) do { _Pragma("unroll") for (int j = 0; j < 5; ++j) { const int u_ = F.tid + NTHR * j; *(LAS u32x4*)(F.lds + (bo) + (u_ >> 5) * 528 + (u_ & 31) * 16) = wreg[j]; } } while (0)
        RT_GLOAD(0);
#pragma unroll 1
        for (int g = 0; g < 8; ++g) {
            const int r0 = ch * 128 + F.wave * 16 + g * 2;
            f32x4 v[2][4];
#pragma unroll
            for (int r = 0; r < 2; ++r)
#pragma unroll
                for (int j = 0; j < 4; ++j) { const u32x2 t = *(const u32x2*)(xb + (size_t)(r0 + r) * D + 256 * j + 4 * F.lane); v[r][j] = (f32x4){bflo(t.x), bfhi(t.x), bflo(t.y), bfhi(t.y)}; }
            float rstd[2];
#pragma unroll
            for (int r = 0; r < 2; ++r) { float s = 0.f;
#pragma unroll
                for (int j = 0; j < 4; ++j) s += (v[r][j][0] * v[r][j][0] + v[r][j][1] * v[r][j][1]) + (v[r][j][2] * v[r][j][2] + v[r][j][3] * v[r][j][3]);
                rstd[r] = rsqrtf(wave_sum(s) * (1.0f / D) + EPS); }
#pragma unroll
            for (int j = 0; j < 4; ++j) { const f32x4 gg = *(const LAS f32x4*)(GV + 256 * j + 4 * F.lane), ss = *(const LAS f32x4*)(SHV + 256 * j + 4 * F.lane);
#pragma unroll
                for (int r = 0; r < 2; ++r) { const f32x4 y = v[r][j] * rstd[r] * gg + ss; u32x2 w; w.x = pk2(y[0], y[1]); w.y = pk2(y[2], y[3]);
                    *(u32x2*)(hout + (size_t)(r0 + r) * D + 256 * j + 4 * F.lane) = w; } }
        }
        asm volatile("s_waitcnt vmcnt(0)" ::: "memory");
        {
            const int lr = F.lane & 15, kq = F.lane >> 4;
            const bf16* ap = hout + (size_t)(ch * 128 + F.wave * 16 + lr) * D + 8 * kq;
            constexpr int RB0 = 8192, RB1 = 8192 + 80 * 528;
            f32x4 acc[5];
#pragma unroll
            for (int cb = 0; cb < 5; ++cb) acc[cb] = (f32x4){0.f, 0.f, 0.f, 0.f};
            bf16x8 af[2][8];
#define RT_ALOAD(buf, sl) do { _Pragma("unroll") for (int q = 0; q < 8; ++q) af[buf][q] = *(const bf16x8*)(ap + 256 * (sl) + 32 * q); } while (0)
#define RT_MMA(buf, bo) do { _Pragma("unroll") for (int q = 0; q < 8; ++q) _Pragma("unroll") for (int cb = 0; cb < 5; ++cb) \
                acc[cb] = __builtin_amdgcn_mfma_f32_16x16x32_bf16(af[buf][q], *(const LAS bf16x8*)(F.lds + (bo) + (16 * cb + lr) * 528 + (32 * q + 8 * kq) * 2), acc[cb], 0, 0, 0); } while (0)
            RT_ALOAD(0, 0);
            RT_LSTORE(RB0); RT_GLOAD(1); RT_ALOAD(1, 1); __syncthreads(); RT_MMA(0, RB0);
            RT_LSTORE(RB1); RT_GLOAD(2); RT_ALOAD(0, 2); __syncthreads(); RT_MMA(1, RB1);
            RT_LSTORE(RB0); RT_GLOAD(3); RT_ALOAD(1, 3); __syncthreads(); RT_MMA(0, RB0);
            RT_LSTORE(RB1); __syncthreads(); RT_MMA(1, RB1);
#undef RT_ALOAD
#undef RT_MMA
#undef RT_GLOAD
#undef RT_LSTORE
            __syncthreads();
#pragma unroll
            for (int cb = 0; cb < 5; ++cb)
#pragma unroll
                for (int r = 0; r < 4; ++r) LG[(F.wave * 16 + 4 * kq + r) * 81 + 16 * cb + lr] = acc[cb][r];
        }
        __syncthreads();
        int e0 = 0, e1 = 0, r0 = 0, r1 = 0; float wa = 0.f, wb = 0.f; const int t = ch * 128 + F.tid;
        if (F.tid < 128) {
            const LAS float* lp = LG + F.tid * 81;
            float lg[8];
#pragma unroll
            for (int j = 0; j < 8; ++j) lg[j] = lp[j] + rgb[j];
            float m = lg[0]; int gi = 0;
#pragma unroll
            for (int j = 1; j < 8; ++j) if (lg[j] > m) { m = lg[j]; gi = j; }
            float sum = 0.f;
#pragma unroll
            for (int j = 0; j < 8; ++j) sum += __expf(lg[j] - m);
            const float gw = 1.0f / sum;
            float le[8];
#pragma unroll
            for (int j = 0; j < 8; ++j) le[j] = lp[8 + gi * 8 + j] + reb[gi * 8 + j];
            float m0 = le[0]; int i0 = 0;
#pragma unroll
            for (int j = 1; j < 8; ++j) if (le[j] > m0) { m0 = le[j]; i0 = j; }
            float m1 = -3.0e38f; int i1 = 0;
#pragma unroll
            for (int j = 0; j < 8; ++j) if (j != i0 && le[j] > m1) { m1 = le[j]; i1 = j; }
            const float pr = __expf(m1 - m0);
            wa = gw / (1.0f + pr); wb = gw * pr / (1.0f + pr);
            e0 = gi * 8 + i0; e1 = gi * 8 + i1;
            r0 = __hip_atomic_fetch_add(&LCNT[e0], 1, __ATOMIC_RELAXED, __HIP_MEMORY_SCOPE_WORKGROUP); r1 = __hip_atomic_fetch_add(&LCNT[e1], 1, __ATOMIC_RELAXED, __HIP_MEMORY_SCOPE_WORKGROUP);
        }
        __syncthreads();
        if (F.tid < 64) { const int n = LCNT[F.tid]; LBASE[F.tid] = n ? (int)__hip_atomic_fetch_add(F.ctl + CW_CNT + (l * 64 + F.tid) * 64, (unsigned)n, RLX_AGENT) : 0; }
        __syncthreads();
        if (F.tid < 128) {
            r0 += LBASE[e0]; r1 += LBASE[e1];
            ltok[(size_t)e0 * CAP + r0] = t; lw[(size_t)e0 * CAP + r0] = wa;
            ltok[(size_t)e1 * CAP + r1] = t; lw[(size_t)e1 * CAP + r1] = wb;
            route[2 * t] = (e0 << 16) | r0; route[2 * t + 1] = (e1 << 16) | r1;
        }
    }
    __syncthreads();
}

__device__ __forceinline__ void topk_phase(Frame& F, const Args& A, int l) {
    LAS int* LCNT = (LAS int*)(F.lds + L_LCNT); LAS int* LBASE = (LAS int*)(F.lds + L_LBASE);
    const float* logits = (const float*)(F.ws + WS_LOGITS);
    const float* rgb = A.in[15] + l * 8; const float* reb = A.in[17] + l * 64;
    int* ltok = (int*)(F.ws + WS_LTOK); float* lw = (float*)(F.ws + WS_LW); int* route = (int*)(F.ws + WS_ROUTE);
    for (int ch = F.bx; ch < NTOK / 128; ch += F.G) {
        __syncthreads();
        if (F.tid < 64) LCNT[F.tid] = 0;
        __syncthreads();
        int e0 = 0, e1 = 0, r0 = 0, r1 = 0; float wa = 0.f, wb = 0.f; const int t = ch * 128 + F.tid;
        if (F.tid < 128) {
            const float* lp = logits + (size_t)t * 128;
            float lg[8];
#pragma unroll
            for (int j = 0; j < 8; ++j) lg[j] = lp[j] + rgb[j];
            float m = lg[0]; int gi = 0;
#pragma unroll
            for (int j = 1; j < 8; ++j) if (lg[j] > m) { m = lg[j]; gi = j; }
            float sum = 0.f;
#pragma unroll
            for (int j = 0; j < 8; ++j) sum += __expf(lg[j] - m);
            const float gw = 1.0f / sum;
            float le[8];
#pragma unroll
            for (int j = 0; j < 8; ++j) le[j] = lp[8 + gi * 8 + j] + reb[gi * 8 + j];
            float m0 = le[0]; int i0 = 0;
#pragma unroll
            for (int j = 1; j < 8; ++j) if (le[j] > m0) { m0 = le[j]; i0 = j; }
            float m1 = -3.0e38f; int i1 = 0;
#pragma unroll
            for (int j = 0; j < 8; ++j) if (j != i0 && le[j] > m1) { m1 = le[j]; i1 = j; }
            const float pr = __expf(m1 - m0);
            wa = gw / (1.0f + pr); wb = gw * pr / (1.0f + pr);
            e0 = gi * 8 + i0; e1 = gi * 8 + i1;
            r0 = __hip_atomic_fetch_add(&LCNT[e0], 1, __ATOMIC_RELAXED, __HIP_MEMORY_SCOPE_WORKGROUP); r1 = __hip_atomic_fetch_add(&LCNT[e1], 1, __ATOMIC_RELAXED, __HIP_MEMORY_SCOPE_WORKGROUP);
        }
        __syncthreads();
        if (F.tid < 64) { const int n = LCNT[F.tid]; LBASE[F.tid] = n ? (int)__hip_atomic_fetch_add(F.ctl + CW_CNT + (l * 64 + F.tid) * 64, (unsigned)n, RLX_AGENT) : 0; }
        __syncthreads();
        if (F.tid < 128) {
            r0 += LBASE[e0]; r1 += LBASE[e1];
            ltok[(size_t)e0 * CAP + r0] = t; lw[(size_t)e0 * CAP + r0] = wa;
            ltok[(size_t)e1 * CAP + r1] = t; lw[(size_t)e1 * CAP + r1] = wb;
            route[2 * t] = (e0 << 16) | r0; route[2 * t + 1] = (e1 << 16) | r1;
        }
    }
    __syncthreads();
}

constexpr int NPHASE = 20;

__global__ void __launch_bounds__(NTHR, 2) mega_fwd(Args args) {
    extern __shared__ __attribute__((aligned(16))) unsigned char lds_raw[];
    Frame F;
    F.lds = (LAS unsigned char*)lds_raw;
    F.tid = threadIdx.x; F.lane = F.tid & 63; F.wave = __builtin_amdgcn_readfirstlane(F.tid >> 6);
    F.G = gridDim.x; F.bx = blockIdx.x;
    F.ws = args.ws; F.ctl = (unsigned*)(args.ws + WS_CTL); F.out = args.out;
    for (int u = F.tid; u < (LDS_BYTES - LDSCTL_OFF) / 4; u += NTHR) ((LAS unsigned*)(F.lds + LDSCTL_OFF))[u] = 0u;
    __syncthreads();
    XcdBarrier bar = xcd_barrier_post(F.ctl + CW_BAR, (volatile LAS unsigned*)(F.lds + L_BARW));
    const int lo = args.ph_lo, hi = args.ph_hi;
#ifdef ONLY
#define PHON(k) ((k) == ONLY)
#else
#define PHON(k) true
#endif
#define PHASE_FENCE() do { F.tid = threadIdx.x; asm volatile("" : "+v"(F.tid)); F.lane = F.tid & 63; F.wave = __builtin_amdgcn_readfirstlane(F.tid >> 6); \
    unsigned long long zo_ = 0; unsigned zl_ = 0; asm volatile("" : "+s"(zo_), "+s"(zl_));        \
    F.ws = args.ws + zo_; F.out = args.out + zo_; F.lds = (LAS unsigned char*)lds_raw + zl_; F.bx = blockIdx.x; F.G = gridDim.x; \
    asm volatile("" : "+s"(F.bx), "+s"(F.G)); F.ctl = (unsigned*)(F.ws + WS_CTL); } while (0)
#define IN(k) (lo <= (k) && (k) < hi)
#define SEAM(k) do { if (IN(k) && IN((k) + 1)) xcd_barrier(bar); PHASE_FENCE(); } while (0)

#define Z ((bf16*)(F.ws + WS_Z))
#define H ((bf16*)(F.ws + WS_H))
#define MOD ((const float*)(F.ws + WS_MOD))

    if (PHON(0)) if (IN(0)) { p0_prologue(F, args); }
    SEAM(0);

    for (int l = 0; l < DEPTH; ++l) {
        const int pb = 1 + 9 * l;
#define modl (MOD + (size_t)l * 8 * MODW)
        if (PHON(1)) if (IN(pb + 0)) {
            if (l == 0) {
                {
                    const float* mp = (const float*)(F.ws + WS_MODP); float* mo = (float*)(F.ws + WS_MOD);
                    for (int i = F.bx * NTHR + F.tid; i < 2 * 8 * MODW; i += F.G * NTHR) { float a = args.in[3][(i / (8 * MODW)) * MODW + i % MODW];
#pragma unroll
                        for (int kc = 0; kc < 8; ++kc) a += mp[(size_t)kc * 16 * MODW + i];
                        mo[i] = a; }
                }
                row_phase<false, false, true, false, true, false>(F, args.in[0], nullptr, H, args.in[4], (const float*)(F.ws + WS_MODP), 1024, 0, nullptr, (const float*)(F.ws + WS_WG), (float*)(F.ws + WS_GDN), args.in[3]);
            }
            else { moe_tables(F, l - 1);
                row_phase<true, true, true, false>(F, (const float*)(F.ws + WS_XB), (float*)(F.ws + WS_XB), H, args.in[4] + (size_t)l * D, modl, 1024, 0, MOD + (size_t)(l - 1) * 8 * MODW, (const float*)(F.ws + WS_WG) + (size_t)l * 16 * 1024, (float*)(F.ws + WS_GDN)); }
        }
        SEAM(pb + 0);
        if (PHON(2)) if (IN(pb + 1)) {
            const int rsplit = 1 + 2 * (F.bx & 7);
            const char* aB = (const char*)H; const char* bB = (const char*)((bf16*)(F.ws + WS_WIN) + (size_t)l * 8192 * 1024);
            pg8::EpiZ E{F.ws};
            { pg8::StaticOrder S; S.init(NTOK, 8192, F.G, F.bx, D, D); S.i1 = rsplit;
              pg8::gemm_phase<pg8::EpiZ, pg8::StaticOrder, true>(F.lds, F.tid, aB, bB, D, S, E); }
            __syncthreads();
            convert_experts(F, args, l);
            __syncthreads();
            { asm volatile("" : "+s"(aB), "+s"(bB));
              pg8::StaticOrder S; S.init(NTOK, 8192, F.G, F.bx, D, D); S.i0 = rsplit;
              pg8::gemm_phase<pg8::EpiZ, pg8::StaticOrder, true>(F.lds, F.tid, aB, bB, D, S, E); }
        }
        SEAM(pb + 1);
        if (PHON(3)) if (IN(pb + 2)) {
            if (F.bx & 1) { conv_phase(F, args, l); __syncthreads(); gla_pass<false>(F, args, l); }
            else { gla_pass<false>(F, args, l); __syncthreads(); conv_phase(F, args, l); }
        }
        SEAM(pb + 2);
        if (PHON(4)) if (IN(pb + 3)) { gla_pass<true>(F, args, l); }
        SEAM(pb + 3);
        if (PHON(5)) if (IN(pb + 4)) {
            pg8::StaticOrder S; S.init(NTOK, D, F.G, F.bx, ZLD, WOEP); S.wgm = 8; S.kshift = 4; S.kjump = (size_t)(16 * 128 + (ZCH - ZCB - 1024) * 2);
            pg8::EpiGate2 E{Z + ZGC, Z + ZGA, Z + ZCC, ZLD};
            pg8::gemm_phase<pg8::EpiGate2, pg8::StaticOrder, true, false, true>(F.lds, F.tid, (const char*)(Z + ZCB), (const char*)(F.ws + WS_WO3 + (size_t)l * WO_L), 2048, S, E);
        }
        SEAM(pb + 4);
        if (PHON(6)) if (IN(pb + 5)) {
            pg8::StaticOrder S; S.init(NTOK, D, F.G, F.bx, ZLD, D); S.wgm = 8;
            const char* aF = (const char*)(Z + ZCC); const char* bF = (const char*)(F.ws + WS_WO3 + (size_t)l * WO_L + WO_OUT);
            if (l == 0) { pg8::EpiResid<true> E{args.in[0], nullptr, (bf16*)(F.ws + WS_XB), modl + 2048};
                pg8::gemm_phase<pg8::EpiResid<true>, pg8::StaticOrder, true>(F.lds, F.tid, aF, bF, D, S, E); }
            else { pg8::EpiResid<false> E{nullptr, (const bf16*)(F.ws + WS_XB), (bf16*)(F.ws + WS_XB), modl + 2048};
                pg8::gemm_phase<pg8::EpiResid<false>, pg8::StaticOrder, true>(F.lds, F.tid, aF, bF, D, S, E); }
        }
        SEAM(pb + 5);
        if (PHON(7)) if (IN(pb + 6)) { norm2_router_phase(F, args, l, modl); }
        SEAM(pb + 6);
        if (PHON(10)) if (IN(pb + 7)) {
            moe_tables(F, l); moe_toktab(F);
            pg8::MoeOrder<true> S{F.lds, F.G, F.bx, 2048u};
            pg8::EpiAct E{(bf16*)(F.ws + WS_H1)};
            pg8::gemm_phase<pg8::EpiAct, pg8::MoeOrder<true>, true>(F.lds, F.tid, (const char*)H, (const char*)(F.ws + WS_W13), D, S, E);
        }
        SEAM(pb + 7);
        if (PHON(11)) if (IN(pb + 8)) {
            moe_tables(F, l); moe_wtab(F);
            pg8::MoeOrder<false> S{F.lds, F.G, F.bx, 1024u};
            pg8::EpiYb E{(bf16*)(F.ws + WS_YB), (const float*)(F.ws + WS_LW), F.lds};
            pg8::gemm_phase<pg8::EpiYb, pg8::MoeOrder<false>, true>(F.lds, F.tid, (const char*)(F.ws + WS_H1), (const char*)(F.ws + WS_W2), DEXP, S, E);
        }
        SEAM(pb + 8);
    }
    if (PHON(12)) if (IN(19)) {
        moe_tables(F, DEPTH - 1);
        row_phase<true, false, false, true>(F, (const float*)(F.ws + WS_XB), F.out, nullptr, args.in[21], nullptr, 0, 0, MOD + (size_t)(DEPTH - 1) * 8 * MODW, nullptr, nullptr);
    }
#undef IN
#undef SEAM
#undef Z
#undef H
#undef MOD
#undef modl
}

extern "C" void kernel_launch(void* const* d_in, const int* in_sizes, int n_in, void* d_out, int out_size, void* d_ws, size_t ws_size, hipStream_t stream) {
    static int grid = 0;
    if (grid == 0) {
        if (n_in != 22 || out_size != NTOK * D || ws_size < WS_END) { fprintf(stderr, "kernel_launch: unexpected shapes (n_in %d out %d ws %zu)\n", n_in, out_size, ws_size); grid = -1; return; }
        int dev = 0, cus = 0, per_cu = 0;
        if (hipGetDevice(&dev) != hipSuccess || hipDeviceGetAttribute(&cus, hipDeviceAttributeMultiprocessorCount, dev) != hipSuccess) { grid = -1; return; }
        if (hipFuncSetAttribute((const void*)mega_fwd, hipFuncAttributeMaxDynamicSharedMemorySize, LDS_BYTES) != hipSuccess) { fprintf(stderr, "kernel_launch: hipFuncSetAttribute failed\n"); grid = -1; return; }
        if (hipOccupancyMaxActiveBlocksPerMultiprocessor(&per_cu, (const void*)mega_fwd, NTHR, LDS_BYTES) != hipSuccess || per_cu < 1)
            fprintf(stderr, "kernel_launch: occupancy query reports %d workgroups per CU\n", per_cu);
        (void)hipGetLastError();
        grid = cus;
        if (grid > 256) grid = 256;
    }
    if (grid < 0) return;
    if (hipMemsetAsync((char*)d_ws + WS_CTL, 0, CTL_ZERO_BYTES, stream) != hipSuccess) return;
    Args a{};
    for (int i = 0; i < 22; ++i) a.in[i] = (const float*)d_in[i];
    a.out = (float*)d_out; a.ws = (unsigned char*)d_ws;
#if MK_N_LAUNCHES == 1
    a.ph_lo = 0; a.ph_hi = NPHASE;
    hipLaunchKernelGGL(mega_fwd, dim3(grid), dim3(NTHR), LDS_BYTES, stream, a);
#else
    for (int p = 0; p < NPHASE; ++p) { a.ph_lo = p; a.ph_hi = p + 1; hipLaunchKernelGGL(mega_fwd, dim3(grid), dim3(NTHR), LDS_BYTES, stream, a); }
#endif
}
```

```cpp
#include <hip/hip_runtime.h>
#include <cstdio>
#include <cstdint>

#ifndef MK_N_LAUNCHES
#define MK_N_LAUNCHES 1
#endif

#define GAS __attribute__((address_space(1)))
#define LAS __attribute__((address_space(3)))
typedef unsigned short bf16;
typedef short bf16x8 __attribute__((ext_vector_type(8)));
typedef short s16x4 __attribute__((ext_vector_type(4)));
typedef float f32x4 __attribute__((ext_vector_type(4)));
typedef float f32x2 __attribute__((ext_vector_type(2)));
typedef float f32x16 __attribute__((ext_vector_type(16)));
typedef unsigned u32x4 __attribute__((ext_vector_type(4)));
typedef unsigned u32x2 __attribute__((ext_vector_type(2)));
typedef __bf16 bf16x2_t __attribute__((ext_vector_type(2)));

constexpr int BATCH = 8, SEQ = 4096, D = 1024, NTOK = BATCH * SEQ, DEPTH = 2;
constexpr int ZLD = 5120 + 128;
constexpr int ZCB = 0, ZCC = 1024, ZCH = 2048, ZGA = 3072, ZGC = 4096;
constexpr int INCOLS = 8208, GDN_COL = 2048;
constexpr int NEXP = 64, DEXP = 512, CAP = 32768, MAXROWS = 81920;
constexpr int MODW = 6144;
constexpr float EPS = 1e-6f;
constexpr int NWAVES = 8, NTHR = 512;

constexpr size_t MiB = 1u << 20;
constexpr size_t WS_CTL = 0, CTL_ZERO_BYTES = 1 * MiB;
constexpr size_t WS_MOD = 1 * MiB;
constexpr size_t WS_ROUTE = 2 * MiB;
constexpr size_t WS_GDN = 4 * MiB;
constexpr size_t WS_LTOK = 8 * MiB;
constexpr size_t WS_LW = 16 * MiB;
constexpr size_t WS_WR = 24 * MiB;
constexpr size_t WS_WG = 25 * MiB;
constexpr size_t WS_WIN = 26 * MiB;
constexpr int WOEP = 2048 + 64;
constexpr size_t WO_L = 7 * MiB, WO_OUT = 5 * MiB;
constexpr size_t WS_WO3 = 58 * MiB;
constexpr size_t WS_SLOC = 72 * MiB;
constexpr size_t WS_DSEG = 104 * MiB;
constexpr int AEP = 2048 + 128;
constexpr size_t WS_AE = 106 * MiB;
constexpr size_t WS_W13 = 106 * MiB;
constexpr size_t WS_W2 = 234 * MiB;
constexpr size_t WS_H = 298 * MiB;
constexpr size_t WS_Z = 362 * MiB;
constexpr size_t WS_QH = 690 * MiB, WS_KH = 722 * MiB;
constexpr size_t WS_VH = 754 * MiB, WS_RH = 818 * MiB;
constexpr size_t WS_LOGITS = WS_Z;
constexpr size_t WS_H1 = WS_Z + 16 * MiB;
constexpr size_t WS_YB = WS_Z + 96 * MiB;
constexpr size_t WS_MODP = 884 * MiB;
constexpr size_t WS_EB = 888 * MiB;
constexpr size_t WS_CDEC = 920 * MiB;
constexpr size_t WS_XB = 922 * MiB;
constexpr size_t WS_END = 986 * MiB;
constexpr int CW_BAR = 4096, CW_CNT = 16384;

constexpr int RING_BYTES = 131072;
constexpr int LDSCTL_OFF = RING_BYTES;
constexpr int L_BARW = LDSCTL_OFF + 32;
constexpr int L_TB = LDSCTL_OFF + 64;
constexpr int L_CNT = LDSCTL_OFF + 256;
constexpr int L_PRE = LDSCTL_OFF + 512;
constexpr int L_LCNT = LDSCTL_OFF + 768;
constexpr int L_LBASE = LDSCTL_OFF + 1024;
constexpr int L_MBEI = LDSCTL_OFF + 2048;
constexpr int L_TOKT = LDSCTL_OFF + 4096;
constexpr int LDS_BYTES = 147456;

#define RLX_AGENT __ATOMIC_RELAXED, __HIP_MEMORY_SCOPE_AGENT
#define LDS_WAIT() asm volatile("s_waitcnt lgkmcnt(0)" ::: "memory")
#define VM_WAIT() asm volatile("s_waitcnt vmcnt(0)" ::: "memory")

__device__ __forceinline__ unsigned pk2(float lo, float hi) { bf16x2_t v; v[0] = (__bf16)lo; v[1] = (__bf16)hi; return __builtin_bit_cast(unsigned, v); }
__device__ __forceinline__ float bflo(unsigned u) { return __builtin_bit_cast(float, u << 16); }
__device__ __forceinline__ float bfhi(unsigned u) { return __builtin_bit_cast(float, u & 0xffff0000u); }
__device__ __forceinline__ float fsigmoid(float x) { return __builtin_amdgcn_rcpf(1.0f + __expf(-x)); }
__device__ __forceinline__ float wave_sum(float v) {
#pragma unroll
    for (int o = 1; o < 64; o <<= 1) v += __shfl_xor(v, o);
    return v;
}

#define XB_TMO      128
#define XB_XCNT(j)  (256  + 64 * (j))
#define XB_XSUB(j)  (1280 + 64 * (j))
#define XB_XGEN(j)  (2304 + 64 * (j))
#define XB_TOP      3328
#define XB_TOPGEN   3392
#define XCD_BAR_WORDS 3456
#define XB_SPIN_CAP (1u << 18)

__device__ __forceinline__ unsigned xb_ld(unsigned* p)              { return __hip_atomic_load(p, __ATOMIC_RELAXED, __HIP_MEMORY_SCOPE_AGENT); }
__device__ __forceinline__ unsigned xb_add(unsigned* p, unsigned v) { return __hip_atomic_fetch_add(p, v, __ATOMIC_RELAXED, __HIP_MEMORY_SCOPE_AGENT); }
__device__ __forceinline__ unsigned xb_xcc_id() { return (unsigned)__builtin_amdgcn_s_getreg((3 << 11) | 20) & 0xFu; }
#define XB_SPIN(cond, bar) do { unsigned _sp = 0; while (cond) { __builtin_amdgcn_s_sleep(1); \
    if ((++_sp & 255u) == 0u) { if (xb_ld(&(bar)[XB_TMO])) break; if (_sp > XB_SPIN_CAP) { atomicAdd(&(bar)[XB_TMO], 1u); break; } } } } while (0)

struct XcdBarrier { unsigned* bar; unsigned x; volatile LAS unsigned* st; };

__device__ __forceinline__ XcdBarrier xcd_barrier_post(unsigned* bar, volatile LAS unsigned* st) {
    XcdBarrier b; b.bar = bar; b.x = xb_xcc_id(); b.st = st;
    if (threadIdx.x == 0) (void)xb_add(&bar[XB_XCNT(b.x)], 1u);
    return b;
}
__device__ __forceinline__ void xcd_barrier_complete(unsigned* bar, unsigned x, unsigned& nloc, unsigned& nx) {
    const unsigned G = gridDim.x * gridDim.y * gridDim.z;
    unsigned sum, cnt, mine, sp = 0u;
    for (;;) {
        sum = 0u; cnt = 0u; mine = 0u;
#pragma unroll
        for (unsigned j = 0; j < 16; ++j) { const unsigned c = xb_ld(&bar[XB_XCNT(j)]); sum += c; cnt += (c > 0u) ? 1u : 0u; mine = (j == x) ? c : mine; }
        if (sum == G) break;
        __builtin_amdgcn_s_sleep(1);
        if ((++sp & 255u) == 0u) { if (xb_ld(&bar[XB_TMO])) break; if (sp > XB_SPIN_CAP) { atomicAdd(&bar[XB_TMO], 1u); break; } }
    }
    nloc = mine > 0u ? mine : 1u; nx = cnt > 0u ? cnt : 1u;
}
__device__ __forceinline__ void xcd_barrier(const XcdBarrier& b) {
    asm volatile("s_waitcnt vmcnt(0)" ::: "memory");
    __syncthreads();
    if (threadIdx.x == 0) {
        unsigned* bar = b.bar;
        __builtin_amdgcn_s_waitcnt(0);
        unsigned nloc = b.st[0], nx = b.st[1];
        if (nloc == 0u) { xcd_barrier_complete(bar, b.x, nloc, nx); b.st[0] = nloc; b.st[1] = nx; }
        const unsigned old = xb_add(&bar[XB_XSUB(b.x)], 1u);
        const unsigned gen = old / nloc;
        if (old + 1u == (gen + 1u) * nloc) {
            __builtin_amdgcn_fence(__ATOMIC_RELEASE, "agent");
            asm volatile("s_waitcnt vmcnt(0)" ::: "memory");
            const unsigned og = xb_add(&bar[XB_TOP], 1u);
            const unsigned tg = og / nx;
            if (og + 1u == (tg + 1u) * nx) xb_add(&bar[XB_TOPGEN], 1u);
            else XB_SPIN(xb_ld(&bar[XB_TOPGEN]) == tg, bar);
            __builtin_amdgcn_fence(__ATOMIC_ACQUIRE, "agent");
            xb_add(&bar[XB_XGEN(b.x)], 1u);
            asm volatile("s_waitcnt vmcnt(0)" ::: "memory");
        } else {
            XB_SPIN(xb_ld(&bar[XB_XGEN(b.x)]) == gen, bar);
            __builtin_amdgcn_fence(__ATOMIC_ACQUIRE, "agent");
            asm volatile("s_waitcnt vmcnt(0)" ::: "memory");
        }
    }
    __syncthreads();
}

namespace pg8 {
constexpr int BM = 256, BK = 64, HALF = 128, HTB = HALF * BK * 2, STAGE_BYTES = 8 * HTB, NXCD = 8, WGM = 4;
__host__ __device__ __forceinline__ int lds_byte(int r, int c) { const int st = (r >> 4) * 2 + (c >> 5), rr = r & 15, cc = c & 31, ob = rr * 64 + cc * 2; return st * 1024 + (ob ^ (((ob >> 9) & 1) << 5)); }
__host__ __device__ __forceinline__ void stage_rc(int b, int& R, int& C) { const int st = b / 1024, sb = b % 1024, swz = sb ^ (((sb >> 9) & 1) << 5); R = (st >> 1) * 16 + swz / 64; C = (st & 1) * 32 + (swz % 64) / 2; }
__host__ __device__ __forceinline__ int perm32(int rho) { const int n = rho >> 4, i = rho & 15; return 8 * (i >> 2) + 4 * n + (i & 3); }

struct Unit { int pm, pn, e, mi, slot; };

struct StaticOrder {
    int nM, nN, nwg, G, c; unsigned lda2; unsigned ldb2;
    int wgm = WGM;
    int i0 = 0, i1 = 1 << 30;
    int kshift = 30; size_t kjump = 0; bool headA = false;
    __device__ void init(int M, int N, int G_, int c_, int lda, int ldb) { nM = M / BM; nN = N / BM; nwg = nM * nN; G = G_; c = c_; lda2 = (unsigned)lda * 2u; ldb2 = (unsigned)ldb * 2u; }
    __device__ void init_head(int M, int N, int G_, int c_, int ldb) { init(M, N, G_, c_, 256, ldb); kshift = 2; kjump = (size_t)SEQ * 512; headA = true; }
    __device__ __forceinline__ size_t kbyte(int kt) const { return (size_t)(kt & ((1 << kshift) - 1)) * 128 + (size_t)(kt >> kshift) * kjump; }
    __device__ bool next(int i, Unit& u) const {
        if (i0 + i >= i1) return false;
        const long L = (long)(i0 + i) * G + c; if (L >= nwg) return false;
        int wgid = (int)L; { const int q = nwg / NXCD, r = nwg % NXCD, xcd = wgid % NXCD, off = wgid / NXCD; wgid = (xcd < r ? xcd * (q + 1) : r * (q + 1) + (xcd - r) * q) + off; }
        const int nig = wgm * nN, gid = wgid / nig, fm = gid * wgm, gsz = (nM - fm) < wgm ? (nM - fm) : wgm;
        u.pm = fm + ((wgid % nig) % gsz); u.pn = (wgid % nig) / gsz; u.e = 0; u.mi = 0; u.slot = 0; return true;
    }
    static constexpr bool GATHER_A = false;
    __device__ __forceinline__ void a_off(const Unit& u, int ui, const int (&R)[2], const int (&C)[2], unsigned (&vo)[2][2]) const {}
    __device__ __forceinline__ size_t a_base(const Unit& u) const { return headA ? ((size_t)(u.pm >> 4) * 4 * SEQ + (size_t)(u.pm & 15) * BM) * 512 : (size_t)u.pm * BM * lda2; }
    __device__ __forceinline__ size_t b_off(const Unit& u) const { return (size_t)u.pn * BM * ldb2; }
    __device__ __forceinline__ unsigned ldb_bytes() const { return ldb2; }
    __device__ __forceinline__ unsigned lda_bytes() const { return lda2; }
};

template <bool GATHER> struct MoeOrder {
    LAS unsigned char* lds; int G, c; unsigned ldb2;
    __device__ bool next(int i, Unit& u) const {
        const int TB = *(const LAS int*)(lds + L_TB);
        const int mb = i * 64 + (c & 7) * 8 + (c >> 5);
        if (mb >= TB) return false;
        const int ei = ((const LAS int*)(lds + L_MBEI))[mb];
        u.pm = mb; u.pn = (c >> 3) & 3; u.e = ei >> 16; u.mi = ei & 0xffff; u.slot = i & 7; return true;
    }
    static constexpr bool GATHER_A = GATHER;
    __device__ __forceinline__ void a_off(const Unit& u, int ui, const int (&R)[2], const int (&C)[2], unsigned (&vo)[2][2]) const {
#pragma unroll
        for (int h = 0; h < 2; ++h)
#pragma unroll
            for (int i = 0; i < 2; ++i) { const int tok = ((const LAS int*)(lds + L_TOKT))[(ui & 7) * 256 + h * HALF + R[i]]; vo[h][i] = (unsigned)tok * 2048u + (unsigned)C[i] * 2u; }
    }
    __device__ __forceinline__ size_t a_base(const Unit& u) const { return (size_t)u.pm * BM * 1024u; }
    __device__ __forceinline__ size_t b_off(const Unit& u) const { return ((size_t)u.e * 1024 + (size_t)u.pn * BM) * ldb2; }
    __device__ __forceinline__ unsigned ldb_bytes() const { return ldb2; }
    __device__ __forceinline__ unsigned lda_bytes() const { return GATHER ? 2048u : 1024u; }
    __device__ __forceinline__ size_t kbyte(int kt) const { return (size_t)kt * 128; }
};

template <class Epi, class Sched, bool ALIGN_EPI, bool DEFER = false, bool RESC = false>
__device__ __forceinline__ void gemm_phase(LAS unsigned char* lds, int tid, const char* Abase, const char* Bbase, int K, const Sched& S, const Epi& E) {
    constexpr bool GATHER = Sched::GATHER_A;
    const int wid = __builtin_amdgcn_readfirstlane(tid >> 6), lane = tid & 63, wr = wid >> 2, wc = wid & 3, fr = lane & 15, fq = lane >> 4;
    const int nt = K / BK;
    int Rs[2], Cs[2]; unsigned voffB[2], voffA[2];
    const unsigned ldb2 = S.ldb_bytes(), lda2 = S.lda_bytes();
#pragma unroll
    for (int i = 0; i < 2; ++i) { int R, C; stage_rc(tid * 16 + i * 8192, R, C); Rs[i] = R; Cs[i] = C; const int Rb = Epi::PERM ? ((R & ~31) + perm32(R & 31)) : R;
        voffB[i] = (unsigned)Rb * ldb2 + (unsigned)C * 2u; voffA[i] = (unsigned)R * lda2 + (unsigned)C * 2u; }
    const size_t kstep = (size_t)(BK * 2);
    const size_t hstepB = (size_t)HALF * ldb2, hstepA = (size_t)HALF * lda2;
    const unsigned ldsw = (unsigned)wid * 1024u;
    const int aoff = lds_byte(wr * 64 + fr, fq * 8), boff = lds_byte(wc * 32 + fr, fq * 8);
#define PG8_SA(b, h) (((b) * 2 + (h)) * HTB)
#define PG8_SB(b, h) ((4 + (b) * 2 + (h)) * HTB)
#define PG8_STAGE(bufoff, gbase, v0, v1) do { \
        __builtin_amdgcn_global_load_lds((const unsigned*)((const char*)(gbase) + (v0)), (LAS unsigned*)(lds + (bufoff) + ldsw), 16, 0, 0); \
        __builtin_amdgcn_global_load_lds((const unsigned*)((const char*)(gbase) + (v1)), (LAS unsigned*)(lds + (bufoff) + ldsw + 8192), 16, 0, 0); } while (0)
#define PG8_STAGEB(bufoff, gbase) PG8_STAGE(bufoff, gbase, voffB[0], voffB[1])
#define PG8_STAGEA(bufoff, kb, h, nx) do { if constexpr (GATHER) { const unsigned o0_ = (nx) ? vN[h][0] : vA[h][0], o1_ = (nx) ? vN[h][1] : vA[h][1]; PG8_STAGE(bufoff, Abase + (kb), o0_, o1_); } \
        else { const char* p_ = Abase + ((nx) ? uN : uA) + (kb) + (h) * hstepA; PG8_STAGE(bufoff, p_, voffA[0], voffA[1]); } } while (0)
#define PG8_LDA(dst, b, h) do { _Pragma("unroll") for (int m = 0; m < 4; ++m) _Pragma("unroll") for (int k = 0; k < 2; ++k) dst[m][k] = *(const LAS bf16x8*)(lds + PG8_SA(b, h) + aoff + m * 2048 + k * 1024); } while (0)
#define PG8_LDB(dst, b, h) do { _Pragma("unroll") for (int n = 0; n < 2; ++n) _Pragma("unroll") for (int k = 0; k < 2; ++k) dst[n][k] = *(const LAS bf16x8*)(lds + PG8_SB(b, h) + boff + n * 2048 + k * 1024); } while (0)
#define PG8_MMA(ai, bj, At, Bt) do { __builtin_amdgcn_s_setprio(1); _Pragma("unroll") for (int m = 0; m < 4; ++m) _Pragma("unroll") for (int n = 0; n < 2; ++n) _Pragma("unroll") for (int k = 0; k < 2; ++k) \
        acc[ai][bj][m][n] = __builtin_amdgcn_mfma_f32_16x16x32_bf16(Bt[n][k], At[m][k], acc[ai][bj][m][n], 0, 0, 0); __builtin_amdgcn_s_setprio(0); } while (0)
#define PG8_WAIT_V(n) asm volatile("s_waitcnt vmcnt(" #n ")" ::: "memory")
#define PG8_WAIT_L(n) asm volatile("s_waitcnt lgkmcnt(" #n ")" ::: "memory")
#define PG8_BAR __builtin_amdgcn_s_barrier()
#define PG8_SCHED __builtin_amdgcn_sched_barrier(0)
    Unit cur, nxt, prv; int ui = 0;
    if (!S.next(0, cur)) return;
    prv = cur;
    f32x4 acc[2][2][4][2];
#pragma unroll
    for (int a = 0; a < 2; ++a)
#pragma unroll
        for (int b = 0; b < 2; ++b)
#pragma unroll
            for (int m = 0; m < 4; ++m)
#pragma unroll
                for (int n = 0; n < 2; ++n) acc[a][b][m][n] = (f32x4){0.f, 0.f, 0.f, 0.f};
    bf16x8 At[4][2], B0[2][2], B1[2][2];
    unsigned vA[2][2], vN[2][2]; size_t uA = 0, uN = 0;
    if constexpr (GATHER) S.a_off(cur, 0, Rs, Cs, vA); else uA = S.a_base(cur);
    const char* cB = Bbase + S.b_off(cur);
    PG8_STAGEB(PG8_SB(0, 0), cB); PG8_STAGEB(PG8_SB(0, 1), cB + hstepB); PG8_STAGEA(PG8_SA(0, 0), 0, 0, false); PG8_STAGEA(PG8_SA(0, 1), 0, 1, false);
    if (wr == 1) PG8_BAR;
    PG8_WAIT_V(2); PG8_BAR;
    PG8_STAGEB(PG8_SB(1, 0), cB + kstep); PG8_STAGEA(PG8_SA(1, 0), kstep, 0, false); PG8_STAGEB(PG8_SB(1, 1), cB + hstepB + kstep);
    PG8_WAIT_V(6); PG8_BAR;
    for (;;) {
        const bool has_next = S.next(ui + 1, nxt);
        if constexpr (GATHER) {
            if (has_next) S.a_off(nxt, ui + 1, Rs, Cs, vN);
            else {
#pragma unroll
                for (int h = 0; h < 2; ++h)
#pragma unroll
                    for (int i = 0; i < 2; ++i) vN[h][i] = vA[h][i];
            }
        } else uN = has_next ? S.a_base(nxt) : uA;
        const char* nB = has_next ? Bbase + S.b_off(nxt) : cB;
#define PG8_WAITX(n16, n32) do { if constexpr (Epi::NST == 16) PG8_WAIT_V(n16); else PG8_WAIT_V(n32); } while (0)
#define PG8_ZERO(ai) do { _Pragma("unroll") for (int b_ = 0; b_ < 2; ++b_) _Pragma("unroll") for (int m_ = 0; m_ < 4; ++m_) _Pragma("unroll") for (int n_ = 0; n_ < 2; ++n_) acc[ai][b_][m_][n_] = (f32x4){0.f, 0.f, 0.f, 0.f}; } while (0)
#define PG8_BODY(EPI) do { \
            asm volatile("" : "+v"(voffB[0]), "+v"(voffB[1]), "+v"(voffA[0]), "+v"(voffA[1]));     \
            const bool last = (t == nt - 2); \
            const size_t k1 = S.kbyte(t + 1), k2 = last ? 0 : S.kbyte(t + 2), k3 = last ? kstep : S.kbyte(t + 3); \
            const char* b2 = last ? nB : cB + (size_t)(t + 2) * kstep; const char* b3 = b2 + kstep; \
              \
            PG8_LDB(B0, 0, 0); PG8_LDB(B1, 0, 1); PG8_SCHED; PG8_LDA(At, 0, 0); PG8_STAGEA(PG8_SA(1, 1), k1, 1, false); \
            if constexpr (EPI) { PG8_SCHED; int fr_ = fr, fq_ = fq; asm volatile("" : "+v"(fr_), "+v"(fq_)); E.template run<0, 1>(acc, prv, wr, wc, fr_, fq_); PG8_ZERO(0); PG8_SCHED; PG8_WAITX(16, 24); } else PG8_WAIT_V(8); \
            PG8_WAIT_L(0); PG8_BAR; PG8_MMA(0, 0, At, B0); PG8_MMA(0, 1, At, B1); PG8_BAR; PG8_SCHED; \
              \
            PG8_LDA(At, 0, 1); PG8_STAGEB(PG8_SB(0, 0), b2); PG8_STAGEB(PG8_SB(0, 1), b2 + hstepB); PG8_STAGEA(PG8_SA(0, 0), k2, 0, last); \
            if constexpr (EPI) { PG8_SCHED; int fr_ = fr, fq_ = fq; asm volatile("" : "+v"(fr_), "+v"(fq_)); E.template run<1, 2>(acc, prv, wr, wc, fr_, fq_); PG8_ZERO(1); PG8_SCHED; PG8_WAITX(24, 40); } else PG8_WAIT_V(8); \
            PG8_WAIT_L(0); PG8_BAR; PG8_MMA(1, 0, At, B0); PG8_MMA(1, 1, At, B1); PG8_BAR; PG8_SCHED; \
              \
            PG8_LDB(B0, 1, 0); PG8_LDB(B1, 1, 1); PG8_SCHED; PG8_LDA(At, 1, 0); PG8_STAGEA(PG8_SA(0, 1), k2, 1, last); \
            if constexpr (EPI) PG8_WAITX(24, 40); else PG8_WAIT_V(8); \
            PG8_WAIT_L(0); PG8_BAR; PG8_MMA(0, 0, At, B0); PG8_MMA(0, 1, At, B1); PG8_BAR; PG8_SCHED; \
              \
            PG8_LDA(At, 1, 1); PG8_STAGEB(PG8_SB(1, 0), b3); PG8_STAGEB(PG8_SB(1, 1), b3 + hstepB); PG8_STAGEA(PG8_SA(1, 0), k3, 0, last); \
            if constexpr (EPI) PG8_WAITX(16, 24); else PG8_WAIT_V(8); \
            PG8_WAIT_L(0); PG8_BAR; PG8_MMA(1, 0, At, B0); PG8_MMA(1, 1, At, B1); PG8_BAR; PG8_SCHED; \
        } while (0)
        if constexpr (DEFER) {
            int t = 0;
            PG8_BODY(true);
            for (t = 2; t < nt; t += 2) PG8_BODY(false);
        } else if constexpr (RESC) {
            for (int t = 0; t < nt / 2; t += 2) PG8_BODY(false);
            { int fr_ = fr, fq_ = fq; asm volatile("" : "+v"(fr_), "+v"(fq_)); E.rescale(acc, cur, wr, wc, fr_, fq_); }
            for (int t = nt / 2; t < nt; t += 2) PG8_BODY(false);
        } else {
            for (int t = 0; t < nt; t += 2) PG8_BODY(false);
        }
        if (!DEFER || !has_next) {
            if constexpr (ALIGN_EPI) { if (wr == 0) PG8_BAR; }
            { int fr_ = fr, fq_ = fq; asm volatile("" : "+v"(fr_), "+v"(fq_)); E.template run<0, 2>(acc, cur, wr, wc, fr_, fq_); }
            if (!has_next) break;
            PG8_ZERO(0); PG8_ZERO(1);
            if constexpr (ALIGN_EPI) { if (wr == 1) PG8_BAR; }
        }
        prv = cur;
        cur = nxt; cB = nB; ++ui; uA = uN;
        if constexpr (GATHER) {
#pragma unroll
            for (int h = 0; h < 2; ++h)
#pragma unroll
                for (int i = 0; i < 2; ++i) vA[h][i] = vN[h][i];
        }
    }
    PG8_WAIT_V(0);
    if constexpr (!ALIGN_EPI) { if (wr == 0) PG8_BAR; }
    PG8_BAR;
#undef PG8_SA
#undef PG8_SB
#undef PG8_STAGE
#undef PG8_STAGEA
#undef PG8_STAGEB
#undef PG8_LDA
#undef PG8_LDB
#undef PG8_MMA
#undef PG8_WAIT_V
#undef PG8_WAITX
#undef PG8_ZERO
#undef PG8_BODY
#undef PG8_WAIT_L
#undef PG8_BAR
#undef PG8_SCHED
}

typedef const f32x4 (&AccRef)[2][2][4][2];

struct EpiZ {
    static constexpr bool PERM = true; static constexpr int NST = 16;
    unsigned char* ws;
    template <int A0, int A1> __device__ __forceinline__ void run(AccRef acc, const Unit& u, int wr, int wc, int fr, int fq) const {
        const int b = u.pm >> 4, tl = (u.pm & 15) * BM + wr * 64 + fr;
        char* base; unsigned off0, rowp, bjs;
        if (u.pn < 4) { base = (char*)ws + (u.pn < 2 ? WS_QH : WS_KH);
            off0 = ((unsigned)((b * 4 + (u.pn & 1) * 2) * SEQ + tl) * 128u + (unsigned)(wc * 32 + 8 * fq)) * 2u; rowp = 256u; bjs = (unsigned)SEQ * 256u; }
        else if (u.pn < 12) { base = (char*)ws + (u.pn < 8 ? WS_VH : WS_RH);
            off0 = ((unsigned)((b * 4 + ((u.pn - 4) & 3)) * SEQ + tl) * 256u + (unsigned)(wc * 32 + 8 * fq)) * 2u; rowp = 512u; bjs = 256u; }
        else if (u.pn >= 16 && u.pn < 24) {
            const unsigned o0 = ((unsigned)(u.pm * BM + wr * 64 + fr) * (unsigned)ZLD + (unsigned)(ZCC + (u.pn - 16) * 128 + wc * 16 + 4 * fq)) * 2u; char* zb = (char*)ws + WS_Z;
#pragma unroll
            for (int ai = A0; ai < A1; ++ai)
#pragma unroll
                for (int m = 0; m < 4; ++m)
#pragma unroll
                    for (int bj = 0; bj < 2; ++bj) { const f32x4 a = acc[ai][bj][m][0], b2 = acc[ai][bj][m][1];
                        u32x2 w; w.x = pk2(a[0] * b2[0], a[1] * b2[1]); w.y = pk2(a[2] * b2[2], a[3] * b2[3]);
                        *(u32x2*)(zb + (o0 + (unsigned)(ai * HALF + m * 16) * (unsigned)(ZLD * 2) + (unsigned)(bj * 128))) = w; }
            return; }
        else { base = (char*)ws + WS_Z;
            const int zc = u.pn < 16 ? ZCB + (u.pn - 12) * BM : ZGA + (u.pn - 24) * BM;
            off0 = ((unsigned)(u.pm * BM + wr * 64 + fr) * (unsigned)ZLD + (unsigned)(zc + wc * 32 + 8 * fq)) * 2u; rowp = (unsigned)ZLD * 2u; bjs = 256u; }
#pragma unroll
        for (int ai = A0; ai < A1; ++ai)
#pragma unroll
            for (int m = 0; m < 4; ++m) { const unsigned ro = off0 + (unsigned)(ai * HALF + m * 16) * rowp;
#pragma unroll
                for (int bj = 0; bj < 2; ++bj) { f32x4 v0 = acc[ai][bj][m][0], v1 = acc[ai][bj][m][1];
                    if (u.pn >= 24) {
#pragma unroll
                        for (int j = 0; j < 4; ++j) { v0[j] = fsigmoid(v0[j]); v1[j] = fsigmoid(v1[j]); } }
                    else if (u.pn >= 8 && u.pn < 12) {
#pragma unroll
                        for (int j = 0; j < 4; ++j) { v0[j] = v0[j] * fsigmoid(v0[j]); v1[j] = v1[j] * fsigmoid(v1[j]); } }
                    u32x4 w; w.x = pk2(v0[0], v0[1]); w.y = pk2(v0[2], v0[3]); w.z = pk2(v1[0], v1[1]); w.w = pk2(v1[2], v1[3]);
                    *(u32x4*)(base + (ro + (unsigned)bj * bjs)) = w; } }
    }
};
template <bool FIRST> struct EpiGate {
    static constexpr bool PERM = true; static constexpr int NST = 16;
    const bf16* Gt; bf16* Y; int ldc;
    template <int A0, int A1> __device__ __forceinline__ void run(AccRef acc, const Unit& u, int wr, int wc, int fr, int fq) const {
        const unsigned off0 = ((unsigned)(u.pm * BM + wr * 64 + fr) * (unsigned)ldc + (unsigned)(u.pn * BM + wc * 32 + 8 * fq)) * 2u;
        const char* gb = (const char*)Gt; char* yb = (char*)Y;
#pragma unroll
        for (int ai = A0; ai < A1; ++ai)
#pragma unroll
            for (int mp = 0; mp < 2; ++mp) {
                u32x4 g[2][2], p[2][2];
#pragma unroll
                for (int mm = 0; mm < 2; ++mm)
#pragma unroll
                    for (int bj = 0; bj < 2; ++bj) { const unsigned ro = off0 + (unsigned)(ai * HALF + (2 * mp + mm) * 16) * (unsigned)ldc * 2u + (unsigned)(bj * 256);
                        g[mm][bj] = *(const u32x4*)(gb + ro); if (!FIRST) p[mm][bj] = *(const u32x4*)(yb + ro); }
#pragma unroll
                for (int mm = 0; mm < 2; ++mm)
#pragma unroll
                    for (int bj = 0; bj < 2; ++bj) { const int m = 2 * mp + mm; const f32x4 v0 = acc[ai][bj][m][0], v1 = acc[ai][bj][m][1]; const u32x4 gg = g[mm][bj];
                        float y[8];
                        y[0] = bflo(gg.x) * v0[0]; y[1] = bfhi(gg.x) * v0[1]; y[2] = bflo(gg.y) * v0[2]; y[3] = bfhi(gg.y) * v0[3];
                        y[4] = bflo(gg.z) * v1[0]; y[5] = bfhi(gg.z) * v1[1]; y[6] = bflo(gg.w) * v1[2]; y[7] = bfhi(gg.w) * v1[3];
                        if (!FIRST) { const u32x4 pp = p[mm][bj];
                            y[0] += bflo(pp.x); y[1] += bfhi(pp.x); y[2] += bflo(pp.y); y[3] += bfhi(pp.y); y[4] += bflo(pp.z); y[5] += bfhi(pp.z); y[6] += bflo(pp.w); y[7] += bfhi(pp.w); }
                        u32x4 w; w.x = pk2(y[0], y[1]); w.y = pk2(y[2], y[3]); w.z = pk2(y[4], y[5]); w.w = pk2(y[6], y[7]);
                        const unsigned ro = off0 + (unsigned)(ai * HALF + m * 16) * (unsigned)ldc * 2u + (unsigned)(bj * 256);
                        *(u32x4*)(yb + ro) = w; }
                asm volatile("" ::: "memory");
            }
    }
};
struct EpiGate2 {
    static constexpr bool PERM = true; static constexpr int NST = 16;
    const bf16* SA; const bf16* SC; bf16* Y; int ldc;
    typedef f32x4 (&AccMut)[2][2][4][2];
    __device__ __forceinline__ void rescale(AccMut acc, const Unit& u, int wr, int wc, int fr, int fq) const {
        const unsigned off0 = ((unsigned)(u.pm * BM + wr * 64 + fr) * (unsigned)ldc + (unsigned)(u.pn * BM + wc * 32 + 8 * fq)) * 2u;
        const char* ab = (const char*)SA; const char* cb = (const char*)SC;
#pragma unroll
        for (int ai = 0; ai < 2; ++ai)
#pragma unroll
            for (int mp = 0; mp < 2; ++mp) {
                u32x4 ga[2][2], gc[2][2];
#pragma unroll
                for (int mm = 0; mm < 2; ++mm)
#pragma unroll
                    for (int bj = 0; bj < 2; ++bj) { const unsigned ro = off0 + (unsigned)(ai * HALF + (2 * mp + mm) * 16) * (unsigned)ldc * 2u + (unsigned)(bj * 256);
                        ga[mm][bj] = *(const u32x4*)(ab + ro); gc[mm][bj] = *(const u32x4*)(cb + ro); }
#pragma unroll
                for (int mm = 0; mm < 2; ++mm)
#pragma unroll
                    for (int bj = 0; bj < 2; ++bj) { const int m = 2 * mp + mm; const u32x4 a = ga[mm][bj], c = gc[mm][bj];
                        f32x4 r0, r1;
#define RC_(x) __builtin_amdgcn_rcpf(fmaxf((x), 1e-30f))
                        r0[0] = bflo(a.x) * RC_(bflo(c.x)); r0[1] = bfhi(a.x) * RC_(bfhi(c.x)); r0[2] = bflo(a.y) * RC_(bflo(c.y)); r0[3] = bfhi(a.y) * RC_(bfhi(c.y));
                        r1[0] = bflo(a.z) * RC_(bflo(c.z)); r1[1] = bfhi(a.z) * RC_(bfhi(c.z)); r1[2] = bflo(a.w) * RC_(bflo(c.w)); r1[3] = bfhi(a.w) * RC_(bfhi(c.w));
#undef RC_
                        acc[ai][bj][m][0] = acc[ai][bj][m][0] * r0; acc[ai][bj][m][1] = acc[ai][bj][m][1] * r1; }
                asm volatile("" ::: "memory");
            }
    }
    template <int A0, int A1> __device__ __forceinline__ void run(AccRef acc, const Unit& u, int wr, int wc, int fr, int fq) const {
        const unsigned off0 = ((unsigned)(u.pm * BM + wr * 64 + fr) * (unsigned)ldc + (unsigned)(u.pn * BM + wc * 32 + 8 * fq)) * 2u;
        const char* cb = (const char*)SC; char* yb = (char*)Y;
#pragma unroll
        for (int ai = A0; ai < A1; ++ai) {
            u32x4 gc[4][2];
#pragma unroll
            for (int m = 0; m < 4; ++m)
#pragma unroll
                for (int bj = 0; bj < 2; ++bj) gc[m][bj] = *(const u32x4*)(cb + (off0 + (unsigned)(ai * HALF + m * 16) * (unsigned)ldc * 2u + (unsigned)(bj * 256)));
#pragma unroll
            for (int m = 0; m < 4; ++m)
#pragma unroll
                for (int bj = 0; bj < 2; ++bj) { const f32x4 v0 = acc[ai][bj][m][0], v1 = acc[ai][bj][m][1]; const u32x4 c = gc[m][bj];
                    u32x4 w; w.x = pk2(bflo(c.x) * v0[0], bfhi(c.x) * v0[1]); w.y = pk2(bflo(c.y) * v0[2], bfhi(c.y) * v0[3]); w.z = pk2(bflo(c.z) * v1[0], bfhi(c.z) * v1[1]); w.w = pk2(bflo(c.w) * v1[2], bfhi(c.w) * v1[3]);
                    *(u32x4*)(yb + (off0 + (unsigned)(ai * HALF + m * 16) * (unsigned)ldc * 2u + (unsigned)(bj * 256))) = w; }
            asm volatile("" ::: "memory");
        }
    }
};
template <bool XF32> struct EpiResid {
    static constexpr bool PERM = true; static constexpr int NST = 16;
    const float* xin32; const bf16* xin16; bf16* xout; const float* g1;
    template <int A0, int A1> __device__ __forceinline__ void run(AccRef acc, const Unit& u, int wr, int wc, int fr, int fq) const {
        const unsigned e0 = (unsigned)(u.pm * BM + wr * 64 + fr) * (unsigned)D + (unsigned)(u.pn * BM + wc * 32 + 8 * fq);
        const float* gp = g1 + (size_t)(u.pm >> 4) * MODW + (u.pn * BM + wc * 32 + 8 * fq);
        f32x4 gv[2][2];
#pragma unroll
        for (int bj = 0; bj < 2; ++bj)
#pragma unroll
            for (int n = 0; n < 2; ++n) gv[bj][n] = *(const f32x4*)(gp + bj * HALF + n * 4);
        if constexpr (!XF32) {
            constexpr int NB = (A1 - A0) * 2;
            u32x4 xr[2][2][2];
#define ER_LD(buf, q) do { _Pragma("unroll") for (int mm = 0; mm < 2; ++mm) _Pragma("unroll") for (int bj = 0; bj < 2; ++bj) \
                xr[buf][mm][bj] = *(const u32x4*)((const char*)xin16 + (e0 + (unsigned)((A0 + ((q) >> 1)) * HALF + (2 * ((q) & 1) + mm) * 16) * (unsigned)D + (unsigned)(bj * HALF)) * 2u); } while (0)
            ER_LD(0, 0);
#pragma unroll
            for (int q = 0; q < NB; ++q) {
                if (q + 1 < NB) { if ((q & 1) == 0) ER_LD(1, q + 1); else ER_LD(0, q + 1); }
                const int ai = A0 + (q >> 1), mp = q & 1;
#pragma unroll
                for (int mm = 0; mm < 2; ++mm)
#pragma unroll
                    for (int bj = 0; bj < 2; ++bj) { const int m = 2 * mp + mm; const unsigned eo = e0 + (unsigned)(ai * HALF + m * 16) * (unsigned)D + (unsigned)(bj * HALF); const u32x4 t = xr[q & 1][mm][bj];
                        const f32x4 x0 = (f32x4){bflo(t.x), bfhi(t.x), bflo(t.y), bfhi(t.y)}, x1 = (f32x4){bflo(t.z), bfhi(t.z), bflo(t.w), bfhi(t.w)};
                        const f32x4 y0 = x0 + gv[bj][0] * acc[ai][bj][m][0], y1 = x1 + gv[bj][1] * acc[ai][bj][m][1];
                        u32x4 w; w.x = pk2(y0[0], y0[1]); w.y = pk2(y0[2], y0[3]); w.z = pk2(y1[0], y1[1]); w.w = pk2(y1[2], y1[3]);
                        *(u32x4*)((char*)xout + eo * 2u) = w; }
                asm volatile("" ::: "memory");
            }
#undef ER_LD
            return;
        }
#pragma unroll
        for (int ai = A0; ai < A1; ++ai)
#pragma unroll
            for (int mp = 0; mp < 2; ++mp) {
                f32x4 xv[2][2][2];
#pragma unroll
                for (int mm = 0; mm < 2; ++mm)
#pragma unroll
                    for (int bj = 0; bj < 2; ++bj) { const unsigned eo = e0 + (unsigned)(ai * HALF + (2 * mp + mm) * 16) * (unsigned)D + (unsigned)(bj * HALF);
                        if (XF32) { xv[mm][bj][0] = *(const f32x4*)((const char*)xin32 + eo * 4u); xv[mm][bj][1] = *(const f32x4*)((const char*)xin32 + (eo * 4u + 16u)); }
                        else { const u32x4 t = *(const u32x4*)((const char*)xin16 + eo * 2u);
                            xv[mm][bj][0] = (f32x4){bflo(t.x), bfhi(t.x), bflo(t.y), bfhi(t.y)}; xv[mm][bj][1] = (f32x4){bflo(t.z), bfhi(t.z), bflo(t.w), bfhi(t.w)}; } }
#pragma unroll
                for (int mm = 0; mm < 2; ++mm)
#pragma unroll
                    for (int bj = 0; bj < 2; ++bj) { const int m = 2 * mp + mm; const unsigned eo = e0 + (unsigned)(ai * HALF + m * 16) * (unsigned)D + (unsigned)(bj * HALF);
                        const f32x4 y0 = xv[mm][bj][0] + gv[bj][0] * acc[ai][bj][m][0], y1 = xv[mm][bj][1] + gv[bj][1] * acc[ai][bj][m][1];
                        u32x4 w; w.x = pk2(y0[0], y0[1]); w.y = pk2(y0[2], y0[3]); w.z = pk2(y1[0], y1[1]); w.w = pk2(y1[2], y1[3]);
                        *(u32x4*)((char*)xout + eo * 2u) = w; }
                asm volatile("" ::: "memory");
            }
    }
};
struct EpiLogits {
    static constexpr bool PERM = false; static constexpr int NST = 16;
    float* L;
    template <int A0, int A1> __device__ __forceinline__ void run(AccRef acc, const Unit& u, int wr, int wc, int fr, int fq) const {
        const int row0 = u.pm * BM + wr * 64 + fr, col0 = wc * 32 + 4 * fq;
#pragma unroll
        for (int ai = A0; ai < A1; ++ai)
#pragma unroll
            for (int m = 0; m < 4; ++m) { float* rowp = L + (size_t)(row0 + ai * HALF + m * 16) * 128 + col0;
#pragma unroll
                for (int n = 0; n < 2; ++n) *(f32x4*)(rowp + n * 16) = acc[ai][0][m][n]; }
    }
};
struct EpiAct {
    static constexpr bool PERM = true; static constexpr int NST = 16;
    bf16* H1;
    template <int A0, int A1> __device__ __forceinline__ void run(AccRef acc, const Unit& u, int wr, int wc, int fr, int fq) const {
        const int row0 = u.pm * BM + wr * 64 + fr, col0 = u.pn * 128 + wc * 16 + 4 * fq;
#pragma unroll
        for (int ai = A0; ai < A1; ++ai)
#pragma unroll
            for (int m = 0; m < 4; ++m) { bf16* rowp = H1 + (size_t)(row0 + ai * HALF + m * 16) * DEXP + col0;
#pragma unroll
                for (int bj = 0; bj < 2; ++bj) { const f32x4 a = acc[ai][bj][m][0], b = acc[ai][bj][m][1];
                    float y[4];
#pragma unroll
                    for (int j = 0; j < 4; ++j) y[j] = a[j] * fsigmoid(a[j]) * b[j];
                    u32x2 w; w.x = pk2(y[0], y[1]); w.y = pk2(y[2], y[3]);
                    *(u32x2*)(rowp + bj * 64) = w; } }
    }
};
struct EpiYb {
    static constexpr bool PERM = true; static constexpr int NST = 16;
    bf16* YB; const float* lw; LAS unsigned char* lds;
    template <int A0, int A1> __device__ __forceinline__ void run(AccRef acc, const Unit& u, int wr, int wc, int fr, int fq) const {
        const int rl0 = wr * 64 + fr;
        const unsigned off0 = ((unsigned)(u.pm * BM + rl0) * (unsigned)D + (unsigned)(u.pn * BM + wc * 32 + 8 * fq)) * 2u;
        char* base = (char*)YB; const LAS float* wt = (const LAS float*)(lds + L_TOKT) + u.slot * 256 + rl0;
        float wgt[2][4];
#pragma unroll
        for (int ai = A0; ai < A1; ++ai)
#pragma unroll
            for (int m = 0; m < 4; ++m) wgt[ai][m] = wt[ai * HALF + m * 16];
#pragma unroll
        for (int ai = A0; ai < A1; ++ai)
#pragma unroll
            for (int m = 0; m < 4; ++m) { const unsigned ro = off0 + (unsigned)(ai * HALF + m * 16) * (unsigned)(D * 2);
#pragma unroll
                for (int bj = 0; bj < 2; ++bj) { const f32x4 v0 = acc[ai][bj][m][0] * wgt[ai][m], v1 = acc[ai][bj][m][1] * wgt[ai][m];
                    u32x4 w; w.x = pk2(v0[0], v0[1]); w.y = pk2(v0[2], v0[3]); w.z = pk2(v1[0], v1[1]); w.w = pk2(v1[2], v1[3]);
                    *(u32x4*)(base + (ro + (unsigned)(bj * 256))) = w; } }
    }
};
}

struct Args { const float* in[22]; float* out; unsigned char* ws; int ph_lo, ph_hi; };
struct Frame {
    LAS unsigned char* lds;
    unsigned* ctl;
    unsigned char* ws;
    int tid, lane, wave, G, bx;
    float* out;
};

__device__ __forceinline__ void tr_item(const float* W, int ldw, int k0, int scol0, bf16* WT, int ldt, int drow0, int ilv, float scale, LAS float* scr, int lane) {
#pragma unroll 8
    for (int i = 0; i < 32; ++i) { const int kk = 2 * i + (lane >> 5); scr[kk * 33 + (lane & 31)] = W[(size_t)(k0 + kk) * ldw + scol0 + (lane & 31)] * scale; }
    LDS_WAIT(); asm volatile("" ::: "memory");
    const int c = lane & 7;
#pragma unroll
    for (int j = 0; j < 4; ++j) { const int n = (lane >> 3) + 8 * j; const LAS float* s = scr + (8 * c) * 33 + n;
        u32x4 o; o.x = pk2(s[0 * 33], s[1 * 33]); o.y = pk2(s[2 * 33], s[3 * 33]); o.z = pk2(s[4 * 33], s[5 * 33]); o.w = pk2(s[6 * 33], s[7 * 33]);
        const int drow = ilv ? drow0 + 8 * (n >> 2) + (n & 3) + 4 * (ilv - 1) : drow0 + n;
        *(u32x4*)(WT + (size_t)drow * ldt + k0 + 8 * c) = o; }
    LDS_WAIT(); asm volatile("" ::: "memory");
}

__device__ __forceinline__ void p0_prologue(Frame& F, const Args& A) {
    const int gw = F.bx * NWAVES + F.wave, NGW = F.G * NWAVES;
    {
        LAS float* sc = (LAS float*)(F.lds + 69632);
        bool have = false;
        for (int it = F.bx; it < 192; it += F.G) {
            if (!have) { for (int i = F.tid; i < 8192; i += NTHR) { const float v = A.in[1][i]; sc[i] = v * fsigmoid(v); } __syncthreads(); have = true; }
            const int l = it / 96, cc = (it % 96) >> 3, kc = it & 7, col = cc * 512 + F.tid;
            const float* w = A.in[2] + ((size_t)l * D + kc * 128) * MODW + col;
            float a[8];
#pragma unroll
            for (int b = 0; b < 8; ++b) a[b] = 0.f;
#pragma unroll 32
            for (int k = 0; k < 128; ++k) { const float wv = w[(size_t)k * MODW];
#pragma unroll
                for (int b = 0; b < 8; ++b) a[b] += sc[b * 1024 + kc * 128 + k] * wv; }
            float* mo = (float*)(F.ws + WS_MODP) + ((size_t)(kc * 2 + l) * 8) * MODW + col;
#pragma unroll
            for (int b = 0; b < 8; ++b) mo[(size_t)b * MODW] = a[b];
        }
        __syncthreads();
    }
    LAS float* scr = (LAS float*)(F.lds + F.wave * 8448);
    constexpr int I_IN = 16 * 256, I_SQ = 16 * 32, I_L = I_IN + 3 * I_SQ;
    for (int it = gw; it < 2 * I_L; it += NGW) {
        const int l = it / I_L; int r = it % I_L;
        if (r < I_IN) { const int kb = r / 256, nb = r % 256, n0 = nb * 32; const int scol = n0 < 2048 ? n0 : n0 + 16;
            bf16* wt = (bf16*)(F.ws + WS_WIN) + (size_t)l * 8192 * 1024;
            if (nb >= 128 && nb < 192) {
                const int sh = (nb - 128) >> 5, nq = (nb - 128) & 31;
                tr_item(A.in[5] + (size_t)l * D * INCOLS, INCOLS, kb * 64, (sh ? 5136 : 4112) + 32 * nq, wt, 1024, 4096 + 64 * nq, 1 + sh, 1.0f, scr, F.lane); }
            else tr_item(A.in[5] + (size_t)l * D * INCOLS, INCOLS, kb * 64, scol, wt, 1024, n0, 0, n0 < 512 ? 0.08838834764831845f : 1.0f, scr, F.lane);
            continue; }
        r -= I_IN; const int which = r / I_SQ; r %= I_SQ; const int kb = r / 32, nb = r % 32;
        bf16* dst = (bf16*)(F.ws + WS_WO3 + (size_t)l * WO_L);
        if (which == 0) tr_item(A.in[10] + (size_t)l * D * D, D, kb * 64, nb * 32, dst + 1024, WOEP, nb * 32, 0, 1.0f, scr, F.lane);
        else if (which == 1) tr_item(A.in[11] + (size_t)l * D * D, D, kb * 64, nb * 32, dst, WOEP, nb * 32, 0, 1.0f, scr, F.lane);
        else tr_item(A.in[12] + (size_t)l * D * D, D, kb * 64, nb * 32, (bf16*)(F.ws + WS_WO3 + (size_t)l * WO_L + WO_OUT), 1024, nb * 32, 0, 1.0f, scr, F.lane);
    }
    {
        const int gt = F.bx * NTHR + F.tid, NGT = F.G * NTHR;
        bf16* wr = (bf16*)(F.ws + WS_WR);
        for (int i = gt; i < 2 * 256 * 1024; i += NGT) { const int l = i >> 18, n = (i >> 10) & 255, k = i & 1023;
            float v = 0.f; if (n < 8) v = A.in[14][((size_t)l * D + k) * 8 + n]; else if (n < 72) v = A.in[16][((size_t)l * D + k) * 64 + (n - 8)];
            wr[i] = (bf16)(pk2(v, 0.f) & 0xffffu); }
        float* wg = (float*)(F.ws + WS_WG);
        for (int i = gt; i < 2 * 16 * 1024; i += NGT) { const int l = i >> 14, c = (i >> 10) & 15, k = i & 1023;
            wg[i] = A.in[5][((size_t)l * D + k) * INCOLS + GDN_COL + c]; }
    }
}

struct TrItem { const float* wp; int ldw; bf16* wt; int ldt; int drow0, ilv, k0; };
__device__ __forceinline__ void tr_load(const TrItem& t, float (&v)[32], int lane) {
    const float* wp = t.wp + (size_t)(t.k0 + (lane >> 5)) * t.ldw + (lane & 31);
#pragma unroll
    for (int i = 0; i < 32; ++i) v[i] = __builtin_nontemporal_load(wp + (size_t)(2 * i) * t.ldw);
}
__device__ __forceinline__ void tr_store(const TrItem& t, const float (&v)[32], LAS float* scr, int lane) {
#pragma unroll
    for (int i = 0; i < 32; ++i) scr[(2 * i + (lane >> 5)) * 33 + (lane & 31)] = v[i];
    LDS_WAIT(); asm volatile("" ::: "memory");
    const int c = lane & 7;
#pragma unroll
    for (int j = 0; j < 4; ++j) { const int n = (lane >> 3) + 8 * j; const LAS float* s = scr + (8 * c) * 33 + n;
        u32x4 o; o.x = pk2(s[0 * 33], s[1 * 33]); o.y = pk2(s[2 * 33], s[3 * 33]); o.z = pk2(s[4 * 33], s[5 * 33]); o.w = pk2(s[6 * 33], s[7 * 33]);
        const int drow = t.ilv ? t.drow0 + 8 * (n >> 2) + (n & 3) + 4 * (t.ilv - 1) : t.drow0 + n;
        __builtin_nontemporal_store(o, (u32x4*)(t.wt + (size_t)drow * t.ldt + t.k0 + 8 * c)); }
    LDS_WAIT(); asm volatile("" ::: "memory");
}
__device__ __forceinline__ TrItem expert_item(Frame& F, const Args& A, int l, int it) {
    constexpr int I13 = 16 * 16, I2 = 8 * 32, IE = 2 * I13 + I2;
    const int e = it / IE; int r = it % IE; TrItem t;
    if (r < 2 * I13) { const int s = r / I13; r %= I13; const int kb = r / 16, nb = r % 16;
        t.wp = (s == 0 ? A.in[18] : A.in[19]) + ((size_t)l * NEXP + e) * D * DEXP + nb * 32; t.ldw = DEXP;
        t.wt = (bf16*)(F.ws + WS_W13) + (size_t)e * 1024 * 1024; t.ldt = 1024; t.drow0 = 2 * nb * 32; t.ilv = 1 + s; t.k0 = kb * 64; }
    else { r -= 2 * I13; const int kb = r / 32, nb = r % 32;
        t.wp = A.in[20] + ((size_t)l * NEXP + e) * DEXP * D + nb * 32; t.ldw = D;
        t.wt = (bf16*)(F.ws + WS_W2) + (size_t)e * 1024 * 512; t.ldt = 512; t.drow0 = nb * 32; t.ilv = 0; t.k0 = kb * 64; }
    return t;
}
__device__ __forceinline__ void convert_experts(Frame& F, const Args& A, int l) {
    const int gw = F.bx * NWAVES + F.wave, NGW = F.G * NWAVES;
    LAS float* scr = (LAS float*)(F.lds + F.wave * 8448);
    constexpr int NIT = NEXP * (2 * 16 * 16 + 8 * 32);
    TrItem ta, tb, tc, td, te; float va[32], vb[32], vc[32], vd[32], ve[32];
    int it = gw;
    if (it >= NIT) return;
    ta = expert_item(F, A, l, it); tr_load(ta, va, F.lane);
    if (it + NGW < NIT) { tb = expert_item(F, A, l, it + NGW); tr_load(tb, vb, F.lane); }
    if (it + 2 * NGW < NIT) { tc = expert_item(F, A, l, it + 2 * NGW); tr_load(tc, vc, F.lane); }
    if (it + 3 * NGW < NIT) { td = expert_item(F, A, l, it + 3 * NGW); tr_load(td, vd, F.lane); }
#define CV_STEP(TL, VL, TS, VS) do { if (it + 4 * NGW < NIT) { TL = expert_item(F, A, l, it + 4 * NGW); tr_load(TL, VL, F.lane); } \
        tr_store(TS, VS, scr, F.lane); it += NGW; } while (0)
#pragma unroll 1
    for (;;) {
        CV_STEP(te, ve, ta, va); if (it >= NIT) break;
        CV_STEP(ta, va, tb, vb); if (it >= NIT) break;
        CV_STEP(tb, vb, tc, vc); if (it >= NIT) break;
        CV_STEP(tc, vc, td, vd); if (it >= NIT) break;
        CV_STEP(td, vd, te, ve); if (it >= NIT) break;
    }
#undef CV_STEP
}

__device__ __forceinline__ void moe_tables(Frame& F, int l) {
    LAS int* CNT = (LAS int*)(F.lds + L_CNT); LAS int* PRE = (LAS int*)(F.lds + L_PRE); LAS int* MBEI = (LAS int*)(F.lds + L_MBEI);
    __syncthreads();
    if (F.tid < NEXP) CNT[F.tid] = (int)__hip_atomic_load(F.ctl + CW_CNT + (l * 64 + F.tid) * 64, RLX_AGENT);
    __syncthreads();
    if (F.tid < NEXP) {
        const int nb = (CNT[F.tid] + 255) >> 8; int inc = nb;
#pragma unroll
        for (int o = 1; o < 64; o <<= 1) { const int v = __shfl_up(inc, o); if (F.tid >= o) inc += v; }
        const int pre = inc - nb; PRE[F.tid] = pre;
        for (int i = 0; i < nb; ++i) MBEI[pre + i] = (F.tid << 16) | i;
        if (F.tid == NEXP - 1) *(LAS int*)(F.lds + L_TB) = inc; }
    __syncthreads();
}
__device__ __forceinline__ void moe_toktab(Frame& F) {
    const int TB = *(const LAS int*)(F.lds + L_TB);
    const LAS int* CNT = (const LAS int*)(F.lds + L_CNT); const LAS int* MBEI = (const LAS int*)(F.lds + L_MBEI);
    LAS int* TOKT = (LAS int*)(F.lds + L_TOKT);
    const int* ltok = (const int*)(F.ws + WS_LTOK);
    for (int i = 0; i < 8; ++i) { const int mb = i * 64 + (F.bx & 7) * 8 + (F.bx >> 5); if (mb >= TB) break;
        if (F.tid < 256) { const int ei = MBEI[mb], e = ei >> 16, rank = (ei & 0xffff) * 256 + F.tid;
            TOKT[i * 256 + F.tid] = rank < CNT[e] ? ltok[(size_t)e * CAP + rank] : 0; } }
    __syncthreads();
}

__device__ __forceinline__ void moe_wtab(Frame& F) {
    const int TB = *(const LAS int*)(F.lds + L_TB);
    const LAS int* CNT = (const LAS int*)(F.lds + L_CNT); const LAS int* MBEI = (const LAS int*)(F.lds + L_MBEI);
    LAS float* WT = (LAS float*)(F.lds + L_TOKT);
    const float* lw = (const float*)(F.ws + WS_LW);
    for (int i = 0; i < 8; ++i) { const int mb = i * 64 + (F.bx & 7) * 8 + (F.bx >> 5); if (mb >= TB) break;
        if (F.tid < 256) { const int ei = MBEI[mb], e = ei >> 16, rank = (ei & 0xffff) * 256 + F.tid;
            WT[i * 256 + F.tid] = rank < CNT[e] ? lw[(size_t)e * CAP + rank] : 0.f; } }
    __syncthreads();
}
template <bool COMBINE, bool WRITE_X, bool GDN, bool FINAL, bool MODPART = false, bool XBF = true>
__device__ __forceinline__ void row_phase(Frame& F, const float* xin, float* xout, bf16* hout, const float* gain, const float* modl, int sc_off, int sh_off,
                                          const float* modprev, const float* wg, float* gdn_out, const float* modbias = nullptr) {
    LAS float* GV = (LAS float*)(F.lds); LAS float* SHV = (LAS float*)(F.lds + 4096); LAS float* G2P = (LAS float*)(F.lds + 8192); LAS float* WG = (LAS float*)(F.lds + 16384);
    const LAS int* PRE = (const LAS int*)(F.lds + L_PRE);
    if (GDN) { for (int i = F.tid; i < 16 * 1024; i += NTHR) WG[i] = wg[i]; }
    for (int ch = F.bx; ch < NTOK / 128; ch += F.G) {
        const int b = ch >> 5;
        __syncthreads();
        for (int k = F.tid; k < D; k += NTHR) {
            if (FINAL) { GV[k] = gain[k]; SHV[k] = 0.f; }
            else if (MODPART) {
                float a = modbias[sc_off + k], c2 = modbias[sh_off + k];
#pragma unroll
                for (int kc = 0; kc < 8; ++kc) { a += modl[(size_t)kc * 16 * MODW + (size_t)b * MODW + sc_off + k]; c2 += modl[(size_t)kc * 16 * MODW + (size_t)b * MODW + sh_off + k]; }
                GV[k] = gain[k] * (1.0f + a); SHV[k] = c2; }
            else { GV[k] = gain[k] * (1.0f + modl[(size_t)b * MODW + sc_off + k]); SHV[k] = modl[(size_t)b * MODW + sh_off + k]; }
            if (COMBINE) G2P[k] = modprev[(size_t)b * MODW + 5120 + k];
        }
        __syncthreads();
#pragma unroll 1
        for (int g = 0; g < 8; ++g) {
            const int r0 = ch * 128 + F.wave * 16 + g * 2;
            f32x4 v[2][4];
#pragma unroll
            for (int r = 0; r < 2; ++r)
#pragma unroll
                for (int j = 0; j < 4; ++j) {
                    if (XBF) { const u32x2 t = *(const u32x2*)((const bf16*)xin + (size_t)(r0 + r) * D + 256 * j + 4 * F.lane); v[r][j] = (f32x4){bflo(t.x), bfhi(t.x), bflo(t.y), bfhi(t.y)}; }
                    else v[r][j] = *(const f32x4*)(xin + (size_t)(r0 + r) * D + 256 * j + 4 * F.lane); }
            if (COMBINE) {
                const int* route = (const int*)(F.ws + WS_ROUTE); const bf16* yb = (const bf16*)(F.ws + WS_YB);
#pragma unroll
                for (int r = 0; r < 2; ++r) {
                    const int er0 = route[2 * (r0 + r)], er1 = route[2 * (r0 + r) + 1];
                    const int row_a = (PRE[er0 >> 16] + ((er0 & 0xffff) >> 8)) * 256 + (er0 & 255);
                    const int row_b = (PRE[er1 >> 16] + ((er1 & 0xffff) >> 8)) * 256 + (er1 & 255);
#pragma unroll
                    for (int j = 0; j < 4; ++j) {
                        const u32x2 ya = *(const u32x2*)(yb + (size_t)row_a * D + 256 * j + 4 * F.lane), yc = *(const u32x2*)(yb + (size_t)row_b * D + 256 * j + 4 * F.lane);
                        const f32x4 gg = *(const LAS f32x4*)(G2P + 256 * j + 4 * F.lane);
                        f32x4 s; s[0] = bflo(ya.x) + bflo(yc.x); s[1] = bfhi(ya.x) + bfhi(yc.x); s[2] = bflo(ya.y) + bflo(yc.y); s[3] = bfhi(ya.y) + bfhi(yc.y);
                        v[r][j] = v[r][j] + gg * s;
                    }
                }
            }
            float rstd[2];
#pragma unroll
            for (int r = 0; r < 2; ++r) { float s = 0.f;
#pragma unroll
                for (int j = 0; j < 4; ++j) s += (v[r][j][0] * v[r][j][0] + v[r][j][1] * v[r][j][1]) + (v[r][j][2] * v[r][j][2] + v[r][j][3] * v[r][j][3]);
                rstd[r] = rsqrtf(wave_sum(s) * (1.0f / D) + EPS); }
            if (WRITE_X) {
#pragma unroll
                for (int r = 0; r < 2; ++r)
#pragma unroll
                    for (int j = 0; j < 4; ++j) { u32x2 w; w.x = pk2(v[r][j][0], v[r][j][1]); w.y = pk2(v[r][j][2], v[r][j][3]); *(u32x2*)((bf16*)xout + (size_t)(r0 + r) * D + 256 * j + 4 * F.lane) = w; }
            }
#pragma unroll
            for (int j = 0; j < 4; ++j) { const f32x4 gg = *(const LAS f32x4*)(GV + 256 * j + 4 * F.lane), ss = *(const LAS f32x4*)(SHV + 256 * j + 4 * F.lane);
#pragma unroll
                for (int r = 0; r < 2; ++r) v[r][j] = v[r][j] * rstd[r] * gg + ss; }
            if (FINAL) {
#pragma unroll
                for (int r = 0; r < 2; ++r)
#pragma unroll
                    for (int j = 0; j < 4; ++j) *(f32x4*)(xout + (size_t)(r0 + r) * D + 256 * j + 4 * F.lane) = v[r][j];
            } else {
#pragma unroll
                for (int r = 0; r < 2; ++r)
#pragma unroll
                    for (int j = 0; j < 4; ++j) { u32x2 w; w.x = pk2(v[r][j][0], v[r][j][1]); w.y = pk2(v[r][j][2], v[r][j][3]);
                        *(u32x2*)(hout + (size_t)(r0 + r) * D + 256 * j + 4 * F.lane) = w; }
            }
            if (GDN) {
                float p[32];
#pragma unroll
                for (int c = 0; c < 16; ++c) {
                    f32x4 wv[4];
#pragma unroll
                    for (int j = 0; j < 4; ++j) wv[j] = *(const LAS f32x4*)(WG + c * 1024 + 256 * j + 4 * F.lane);
#pragma unroll
                    for (int r = 0; r < 2; ++r) { float s = 0.f;
#pragma unroll
                        for (int j = 0; j < 4; ++j) s += (v[r][j][0] * wv[j][0] + v[r][j][1] * wv[j][1]) + (v[r][j][2] * wv[j][2] + v[r][j][3] * wv[j][3]);
                        p[r * 16 + c] = s; }
                    asm volatile("" ::: "memory");
                }
#define SWZX(x, o) __builtin_bit_cast(float, __builtin_amdgcn_ds_swizzle(__builtin_bit_cast(int, (x)), ((o) << 10) | 0x1f))
#define BFLY(o) do { const bool up = (F.lane & (o)) != 0; _Pragma("unroll") for (int i = 0; i < (o); ++i) { const float a_ = p[i], b_ = p[i + (o)]; const float t_ = SWZX(up ? a_ : b_, (o)); p[i] = (up ? b_ : a_) + t_; } } while (0)
                BFLY(16); BFLY(8); BFLY(4); BFLY(2); BFLY(1);
#undef BFLY
#undef SWZX
                const float tot = p[0] + __shfl_xor(p[0], 32);
                if (F.lane < 32) gdn_out[(size_t)r0 * 16 + F.lane] = tot;
            }
        }
    }
    __syncthreads();
}

__device__ __forceinline__ void conv_phase(Frame& F, const Args& A, int l) {
    bf16* z = (bf16*)(F.ws + WS_Z);
    const float* cw = A.in[9] + (size_t)l * 3 * D;
    const int cg = F.tid & 127, run = F.tid >> 7;
    float w0[8], w1[8], w2[8];
#pragma unroll
    for (int j = 0; j < 8; ++j) { w0[j] = cw[cg * 8 + j]; w1[j] = cw[D + cg * 8 + j]; w2[j] = cw[2 * D + cg * 8 + j]; }
    for (int ch = F.bx; ch < NTOK / 128; ch += F.G) {
        const int t0 = ch * 128 + run * 32;
        float um2[8], um1[8];
#pragma unroll
        for (int j = 0; j < 8; ++j) { um2[j] = 0.f; um1[j] = 0.f; }
        if ((t0 & (SEQ - 1)) != 0) {
            const u32x4 c2 = *(const u32x4*)(z + (size_t)(t0 - 2) * ZLD + ZCC + cg * 8), c1 = *(const u32x4*)(z + (size_t)(t0 - 1) * ZLD + ZCC + cg * 8);
            um2[0] = bflo(c2.x); um2[1] = bfhi(c2.x); um2[2] = bflo(c2.y); um2[3] = bfhi(c2.y); um2[4] = bflo(c2.z); um2[5] = bfhi(c2.z); um2[6] = bflo(c2.w); um2[7] = bfhi(c2.w);
            um1[0] = bflo(c1.x); um1[1] = bfhi(c1.x); um1[2] = bflo(c1.y); um1[3] = bfhi(c1.y); um1[4] = bflo(c1.z); um1[5] = bfhi(c1.z); um1[6] = bflo(c1.w); um1[7] = bfhi(c1.w);
        }
        u32x4 ca[8], ba[8], cb2[8], bb2[8];
#define CV_LD(cc_, bb_, i0_) do { _Pragma("unroll") for (int r = 0; r < 8; ++r) { const size_t ro_ = (size_t)(t0 + (i0_) + r) * ZLD + cg * 8; \
            cc_[r] = __builtin_nontemporal_load((const u32x4*)(z + ro_ + ZCC)); bb_[r] = __builtin_nontemporal_load((const u32x4*)(z + ro_ + ZCB)); } } while (0)
#define CV_DO(cc_, bb_, i0_) do { _Pragma("unroll") for (int r = 0; r < 8; ++r) { const size_t ro_ = (size_t)(t0 + (i0_) + r) * ZLD + cg * 8; const u32x4 cc = cc_[r], bb = bb_[r]; \
            float u[8], bv[8], o[8]; \
            u[0] = bflo(cc.x); u[1] = bfhi(cc.x); u[2] = bflo(cc.y); u[3] = bfhi(cc.y); u[4] = bflo(cc.z); u[5] = bfhi(cc.z); u[6] = bflo(cc.w); u[7] = bfhi(cc.w); \
            bv[0] = bflo(bb.x); bv[1] = bfhi(bb.x); bv[2] = bflo(bb.y); bv[3] = bfhi(bb.y); bv[4] = bflo(bb.z); bv[5] = bfhi(bb.z); bv[6] = bflo(bb.w); bv[7] = bfhi(bb.w); \
            _Pragma("unroll") for (int j = 0; j < 8; ++j) { o[j] = bv[j] * (w0[j] * um2[j] + w1[j] * um1[j] + w2[j] * u[j]); um2[j] = um1[j]; um1[j] = u[j]; } \
            u32x4 w; w.x = pk2(o[0], o[1]); w.y = pk2(o[2], o[3]); w.z = pk2(o[4], o[5]); w.w = pk2(o[6], o[7]); \
            *(u32x4*)(z + ro_ + ZCB) = w; } } while (0)
        CV_LD(ca, ba, 0);
        CV_LD(cb2, bb2, 8);  CV_DO(ca, ba, 0);
        CV_LD(ca, ba, 16);   CV_DO(cb2, bb2, 8);
        CV_LD(cb2, bb2, 24); CV_DO(ca, ba, 16);
        CV_DO(cb2, bb2, 24);
#undef CV_LD
#undef CV_DO
    }
}

constexpr int GL_QS = 272, GL_VS = 528, GL_AS = 144, GL_OS = 528;
constexpr int GL_QT = 0, GL_KT = 17408, GL_VV = 34816, GL_ATT = 68608, GL_OB = 77824, GL_GD = 111616, GL_SEGT = 115712, GL_DEC = 119808, GL_W2 = L_TOKT;
static_assert(GL_DEC + 512 <= RING_BYTES, "GLA LDS map");
#define MFMA32(a, b, c) __builtin_amdgcn_mfma_f32_32x32x16_bf16((a), (b), (c), 0, 0, 0)
#define TR16(p) __builtin_amdgcn_ds_read_tr16_b64_v4i16((LAS s16x4*)(p))

__device__ __forceinline__ float log_sigmoid_f(float x) { return fminf(x, 0.f) - __logf(1.0f + __expf(-fabsf(x))); }

template <bool PASS2>
__device__ __forceinline__ void gla_pass(Frame& F, const Args& A, int l) {
    LAS unsigned char* lds = F.lds;
    char* qh = (char*)(F.ws + WS_QH); char* kh = (char*)(F.ws + WS_KH); char* vh = (char*)(F.ws + WS_VH); const char* rh = (const char*)(F.ws + WS_RH);
    const float* gdn = (const float*)(F.ws + WS_GDN);
    float* dseg = (float*)(F.ws + WS_DSEG);
    char* ebuf = (char*)(F.ws + WS_EB); float* cdec = (float*)(F.ws + WS_CDEC);
#pragma unroll 1
    for (int unit = F.bx; unit < 256; unit += F.G) {
        const int b = unit >> 5, head = (unit >> 3) & 3, seg = unit & 7;
        const int t0 = b * SEQ + seg * 512;
        const int hr0 = (b * 4 + head) * SEQ + seg * 512;
        const bool state = PASS2 || seg < 7;
        f32x2 gb;
        {
            const int tid = F.tid, lane = F.lane, d0 = 2 * lane;
            __syncthreads();
            if (!PASS2) {
#pragma unroll
                for (int j = 0; j < 4; ++j) { const int i = tid + 512 * j; *(LAS float*)(lds + GL_W2 + i * 4) = A.in[6][((size_t)l * 16 + (i >> 7)) * 512 + head * 128 + (i & 127)]; }
                gb = *(const f32x2*)(A.in[7] + (size_t)l * 512 + head * 128 + d0);
            }
        }
        f32x16 S[4];
#pragma unroll
        for (int db = 0; db < 4; ++db)
#pragma unroll
            for (int i = 0; i < 16; ++i) S[db][i] = 0.f;
        if (PASS2 && seg > 0) {
            const int w = F.wave, lane = F.lane, hh = lane >> 5;
            const u32x4* sb = (const u32x4*)(F.ws + WS_SLOC) + ((size_t)((unit - seg) * 8 + w) * 8) * 64 + lane;
            u32x4 b0[8], b1[8], b2[8];
            for (int i = F.tid; i < seg * 128; i += NTHR) *(LAS float*)(lds + GL_OB + i * 4) = dseg[(size_t)(unit - seg) * 128 + i];
#define PF_LD(buf, j_) do { const int jc_ = (j_) < seg ? (j_) : seg - 1; _Pragma("unroll") for (int i = 0; i < 8; ++i) buf[i] = sb[(size_t)jc_ * 4096 + i * 64]; } while (0)
#define PF_FOLD(buf, j_) do { const LAS float* dp = (const LAS float*)(lds + GL_OB) + (j_) * 128 + 4 * hh; \
                _Pragma("unroll") for (int i = 0; i < 8; ++i) _Pragma("unroll") for (int hf = 0; hf < 2; ++hf) { \
                    const int db = (2 * i + hf) >> 2, rg = (2 * i + hf) & 3; const f32x4 dv = *(const LAS f32x4*)(dp + 32 * db + 8 * rg); \
                    const unsigned lo = hf ? buf[i].z : buf[i].x, hi = hf ? buf[i].w : buf[i].y; \
                    S[db][4 * rg] = S[db][4 * rg] * dv[0] + bflo(lo); S[db][4 * rg + 1] = S[db][4 * rg + 1] * dv[1] + bfhi(lo); \
                    S[db][4 * rg + 2] = S[db][4 * rg + 2] * dv[2] + bflo(hi); S[db][4 * rg + 3] = S[db][4 * rg + 3] * dv[3] + bfhi(hi); } } while (0)
            PF_LD(b0, 0); PF_LD(b1, 1);
            __syncthreads();
#pragma unroll 1
            for (int j = 0; j < seg; j += 3) {
                PF_LD(b2, j + 2);
                PF_FOLD(b0, j);
                PF_LD(b0, j + 3);
                if (j + 1 < seg) PF_FOLD(b1, j + 1);
                PF_LD(b1, j + 4);
                if (j + 2 < seg) PF_FOLD(b2, j + 2);
            }
#undef PF_LD
#undef PF_FOLD
        }
        float dsum0 = 0.f, dsum1 = 0.f;
        unsigned kraw[8], qraw[8], eraw[8]; u32x4 vraw[4]; f32x4 gdr = (f32x4){0.f, 0.f, 0.f, 0.f}; u32x4 rraw[4]; f32x2 dcr = (f32x2){0.f, 0.f};
#define GLA_LOADS(co_) do { const size_t hr_ = (size_t)(hr0 + (co_)); const char* kb_ = kh + hr_ * 256; const char* qb_ = qh + hr_ * 256; const char* eb_ = ebuf + hr_ * 256; const char* vb_ = vh + hr_ * 512; \
            if (!PASS2) { if (tid < 256) gdr = *(const f32x4*)(gdn + (size_t)(t0 + (co_)) * 16 + tid * 4); } \
            else if (w == 0) dcr = *(const f32x2*)(cdec + (size_t)((t0 + (co_)) >> 6) * 512 + head * 128 + d0); \
            _Pragma("unroll") for (int ii = 0; ii < 8; ++ii) { \
                kraw[ii] = *(const unsigned*)(kb_ + (offk + (unsigned)(ii * 256))); \
                if (PASS2) { qraw[ii] = *(const unsigned*)(qb_ + (offk + (unsigned)(ii * 256))); eraw[ii] = *(const unsigned*)(eb_ + (offk + (unsigned)(ii * 256))); } } \
            if (state) { _Pragma("unroll") for (int j = 0; j < 4; ++j) vraw[j] = *(const u32x4*)(vb_ + (offv + (unsigned)(j * 16 * 512))); } \
        } while (0)
        {
            const int tid = F.tid, lane = F.lane, w = F.wave, d0 = 2 * lane;
            const unsigned offk = (unsigned)((8 * w) * 128 + d0) * 2u;
            const unsigned offv = (unsigned)((tid >> 5) * 256 + (tid & 31) * 8) * 2u;
            GLA_LOADS(0);
        }
#pragma unroll 1
        for (int c = 0; c < 8; ++c) {
            const int tc = t0 + 64 * c;
            int tq_ = F.tid; asm volatile("" : "+v"(tq_));
            const int tid = tq_, lane = tq_ & 63, w = __builtin_amdgcn_readfirstlane(tq_ >> 6);
            const int r31 = lane & 31, hh = lane >> 5, blk = (lane >> 4) & 1, q4 = (lane & 15) >> 2, p4 = lane & 3;
            const int erow = tid >> 3, ejj = tid & 7, d0 = 2 * lane;
            const unsigned offk = (unsigned)((8 * w) * 128 + d0) * 2u;
            const unsigned offv = (unsigned)((tid >> 5) * 256 + (tid & 31) * 8) * 2u;
            if (!PASS2) {
                if (tid < 256) *(LAS f32x4*)(lds + GL_GD + tid * 16) = gdr;
                __syncthreads();
                float bl[8][2]; float run0 = 0.f, run1 = 0.f;
#pragma unroll
                for (int ii = 0; ii < 8; ++ii) { bl[ii][0] = gb[0]; bl[ii][1] = gb[1]; }
#pragma unroll
                for (int r4 = 0; r4 < 4; ++r4) {
                    f32x2 wv[4];
#pragma unroll
                    for (int e = 0; e < 4; ++e) wv[e] = *(const LAS f32x2*)(lds + GL_W2 + ((4 * r4 + e) * 128 + d0) * 4);
#pragma unroll
                    for (int ii = 0; ii < 8; ++ii) { const f32x4 g = *(const LAS f32x4*)(lds + GL_GD + (8 * w + ii) * 64 + r4 * 16);
#pragma unroll
                        for (int e = 0; e < 4; ++e) { bl[ii][0] += g[e] * wv[e][0]; bl[ii][1] += g[e] * wv[e][1]; } }
                }
#pragma unroll
                for (int ii = 0; ii < 8; ++ii) { run0 += log_sigmoid_f(bl[ii][0]) * 0.0625f; run1 += log_sigmoid_f(bl[ii][1]) * 0.0625f; bl[ii][0] = run0; bl[ii][1] = run1; }
                *(LAS f32x2*)(lds + GL_SEGT + (w * 128 + d0) * 4) = (f32x2){run0, run1};
                __syncthreads();
                float off0 = 0.f, off1 = 0.f, tot0 = 0.f, tot1 = 0.f;
#pragma unroll
                for (int ww = 0; ww < 8; ++ww) { const f32x2 t = *(const LAS f32x2*)(lds + GL_SEGT + (ww * 128 + d0) * 4); if (ww < w) { off0 += t[0]; off1 += t[1]; } tot0 += t[0]; tot1 += t[1]; }
                if (w == 0) { const f32x2 dd = (f32x2){__expf(tot0), __expf(tot1)}; *(LAS f32x2*)(lds + GL_DEC + d0 * 4) = dd; *(f32x2*)(cdec + (size_t)(tc >> 6) * 512 + head * 128 + d0) = dd; }
                dsum0 += tot0; dsum1 += tot1;
                char* kbp = kh + (size_t)(hr0 + 64 * c) * 256; char* ebp = ebuf + (size_t)(hr0 + 64 * c) * 256;
#pragma unroll
                for (int ii = 0; ii < 8; ++ii) {
                    const float b0 = bl[ii][0] + off0, b1 = bl[ii][1] + off1;
                    const unsigned kt = pk2(bflo(kraw[ii]) * __expf(-b0), bfhi(kraw[ii]) * __expf(-b1));
                    *(LAS unsigned*)(lds + GL_KT + (8 * w + ii) * GL_QS + d0 * 2) = kt;
                    *(unsigned*)(kbp + (offk + (unsigned)(ii * 256))) = kt;
                    *(unsigned*)(ebp + (offk + (unsigned)(ii * 256))) = pk2(__expf(b0), __expf(b1));
                }
            } else {
                if (w == 0) *(LAS f32x2*)(lds + GL_DEC + d0 * 4) = dcr;
#pragma unroll
                for (int ii = 0; ii < 8; ++ii) {
                    *(LAS unsigned*)(lds + GL_KT + (8 * w + ii) * GL_QS + d0 * 2) = kraw[ii];
                    *(LAS unsigned*)(lds + GL_QT + (8 * w + ii) * GL_QS + d0 * 2) = pk2(bflo(qraw[ii]) * bflo(eraw[ii]), bfhi(qraw[ii]) * bfhi(eraw[ii]));
                }
            }
            if (state) {
#pragma unroll
                for (int j = 0; j < 4; ++j) { const int p = tid + 512 * j, row = p >> 5, c16 = p & 31; *(LAS u32x4*)(lds + GL_VV + row * GL_VS + c16 * 16) = vraw[j]; }
            }
            if (PASS2) {
#pragma unroll
                for (int m = 0; m < 4; ++m) rraw[m] = *(const u32x4*)(rh + (size_t)(hr0 + 64 * c + erow) * 512 + (32 * ejj + 8 * m) * 2);
            }
            { const int cn_ = 64 * (c < 7 ? c + 1 : c); GLA_LOADS(cn_); }
            if (!state) continue;
            __syncthreads();
            bf16x8 Vf[4];
#pragma unroll
            for (int ks = 0; ks < 4; ++ks) { const s16x4 lo = TR16(lds + GL_VV + (16 * ks + 8 * hh + q4) * GL_VS + (32 * w + 16 * blk + 4 * p4) * 2);
                const s16x4 hi = TR16(lds + GL_VV + (16 * ks + 8 * hh + 4 + q4) * GL_VS + (32 * w + 16 * blk + 4 * p4) * 2);
                Vf[ks] = __builtin_shufflevector(lo, hi, 0, 1, 2, 3, 4, 5, 6, 7); }
            __builtin_amdgcn_sched_barrier(0);
            f32x16 o[2];
            if (PASS2) {
                if (w < 3) {
                    const int ib = (w >= 1) ? 1 : 0, jb = (w == 2) ? 1 : 0;
                    f32x16 X;
#pragma unroll
                    for (int i = 0; i < 16; ++i) X[i] = 0.f;
#pragma unroll
                    for (int s = 0; s < 8; ++s) { const bf16x8 a = *(const LAS bf16x8*)(lds + GL_QT + (32 * ib + r31) * GL_QS + (16 * s + 8 * hh) * 2);
                        const bf16x8 bb = *(const LAS bf16x8*)(lds + GL_KT + (32 * jb + r31) * GL_QS + (16 * s + 8 * hh) * 2); X = MFMA32(a, bb, X); if (s & 1) __builtin_amdgcn_sched_barrier(0); }
#pragma unroll
                    for (int i = 0; i < 16; ++i) { const int il = 8 * (i >> 2) + 4 * hh + (i & 3); const float val = (ib == jb && r31 > il) ? 0.f : X[i];
                        *(LAS unsigned short*)(lds + GL_ATT + (32 * ib + il) * GL_AS + (32 * jb + r31) * 2) = (unsigned short)(pk2(val, 0.f) & 0xffffu); }
                }
                __builtin_amdgcn_sched_barrier(0);
#pragma unroll
                for (int i = 0; i < 16; ++i) { o[0][i] = 0.f; o[1][i] = 0.f; }
#pragma unroll
                for (int db = 0; db < 4; ++db)
#pragma unroll
                    for (int s = 0; s < 2; ++s) {
                        u32x4 pb; pb.x = pk2(S[db][8 * s + 0], S[db][8 * s + 1]); pb.y = pk2(S[db][8 * s + 2], S[db][8 * s + 3]); pb.z = pk2(S[db][8 * s + 4], S[db][8 * s + 5]); pb.w = pk2(S[db][8 * s + 6], S[db][8 * s + 7]);
                        const bf16x8 Bf = __builtin_bit_cast(bf16x8, pb);
#pragma unroll
                        for (int ib = 0; ib < 2; ++ib) { const LAS unsigned char* qp = lds + GL_QT + (32 * ib + r31) * GL_QS + (32 * db + 16 * s + 4 * hh) * 2;
                            const s16x4 lo = *(const LAS s16x4*)(qp), hi = *(const LAS s16x4*)(qp + 16);
                            const bf16x8 a = __builtin_shufflevector(lo, hi, 0, 1, 2, 3, 4, 5, 6, 7); o[ib] = MFMA32(a, Bf, o[ib]); }
                        __builtin_amdgcn_sched_barrier(0);
                    }
            }
#pragma unroll
            for (int ks = 0; ks < 4; ++ks)
#pragma unroll
                for (int db = 0; db < 4; ++db) { const s16x4 lo = TR16(lds + GL_KT + (16 * ks + 8 * hh + q4) * GL_QS + (32 * db + 16 * blk + 4 * p4) * 2);
                    const s16x4 hi = TR16(lds + GL_KT + (16 * ks + 8 * hh + 4 + q4) * GL_QS + (32 * db + 16 * blk + 4 * p4) * 2);
                    const bf16x8 a = __builtin_shufflevector(lo, hi, 0, 1, 2, 3, 4, 5, 6, 7); S[db] = MFMA32(a, Vf[ks], S[db]); if (db & 1) __builtin_amdgcn_sched_barrier(0); }
#pragma unroll
            for (int db = 0; db < 4; ++db)
#pragma unroll
                for (int rg = 0; rg < 4; ++rg) { const f32x4 dv = *(const LAS f32x4*)(lds + GL_DEC + (32 * db + 8 * rg + 4 * hh) * 4);
#pragma unroll
                    for (int e = 0; e < 4; ++e) S[db][4 * rg + e] *= dv[e]; }
            if (PASS2) {
                __syncthreads();
#pragma unroll
                for (int ib = 0; ib < 2; ++ib)
#pragma unroll
                    for (int ks = 0; ks < 4; ++ks) { if (ib == 0 && ks >= 2) continue;
                        const bf16x8 a = *(const LAS bf16x8*)(lds + GL_ATT + (32 * ib + r31) * GL_AS + (16 * ks + 8 * hh) * 2); o[ib] = MFMA32(a, Vf[ks], o[ib]); }
                __builtin_amdgcn_sched_barrier(0);
#pragma unroll
                for (int ib = 0; ib < 2; ++ib)
#pragma unroll
                    for (int i = 0; i < 16; ++i) { const int il = 8 * (i >> 2) + 4 * hh + (i & 3);
                        *(LAS unsigned short*)(lds + GL_OB + (32 * ib + il) * GL_OS + (32 * w + r31) * 2) = (unsigned short)(pk2(o[ib][i], 0.f) & 0xffffu); }
                __syncthreads();
                float ss = 0.f;
#pragma unroll
                for (int m = 0; m < 4; ++m) { const u32x4 t = *(const LAS u32x4*)(lds + GL_OB + erow * GL_OS + (32 * ejj + 8 * m) * 2);
                    ss += (bflo(t.x) * bflo(t.x) + bfhi(t.x) * bfhi(t.x)) + (bflo(t.y) * bflo(t.y) + bfhi(t.y) * bfhi(t.y)) + (bflo(t.z) * bflo(t.z) + bfhi(t.z) * bfhi(t.z)) + (bflo(t.w) * bflo(t.w) + bfhi(t.w) * bfhi(t.w)); }
                ss += __shfl_xor(ss, 1); ss += __shfl_xor(ss, 2); ss += __shfl_xor(ss, 4);
                const float rstd = rsqrtf(ss * (1.0f / 256.0f) + EPS);
                const float* gn = A.in[8] + (size_t)l * D + head * 256 + 32 * ejj;
                bf16* zo = (bf16*)(F.ws + WS_Z) + (size_t)(t0 + 64 * c + erow) * ZLD + ZCH + head * 256 + 32 * ejj;
#pragma unroll
                for (int m = 0; m < 4; ++m) { const f32x4 g0 = *(const f32x4*)(gn + 8 * m), g1 = *(const f32x4*)(gn + 8 * m + 4);
                    const u32x4 t = *(const LAS u32x4*)(lds + GL_OB + erow * GL_OS + (32 * ejj + 8 * m) * 2);
                    const unsigned tt[4] = {t.x, t.y, t.z, t.w};
                    const unsigned rr[4] = {rraw[m].x, rraw[m].y, rraw[m].z, rraw[m].w}; unsigned ww[4];
#pragma unroll
                    for (int e = 0; e < 4; ++e) { const float ra = bflo(rr[e]), rb = bfhi(rr[e]); const float ga = e < 2 ? g0[2 * e] : g1[2 * e - 4], gb2 = e < 2 ? g0[2 * e + 1] : g1[2 * e - 3];
                        ww[e] = pk2(bflo(tt[e]) * rstd * ga * ra, bfhi(tt[e]) * rstd * gb2 * rb); }
                    *(u32x4*)(zo + 8 * m) = (u32x4){ww[0], ww[1], ww[2], ww[3]}; }
            }
        }
#undef GLA_LOADS
        if (!PASS2 && state) {
            const int w = F.wave, lane = F.lane, d0 = 2 * lane;
            u32x4* sp = (u32x4*)(F.ws + WS_SLOC) + ((size_t)(unit * 8 + w) * 8) * 64 + lane;
#pragma unroll
            for (int i = 0; i < 8; ++i) { const int da = (2 * i) >> 2, ra = (2 * i) & 3, dc = (2 * i + 1) >> 2, rc = (2 * i + 1) & 3;
                sp[i * 64] = (u32x4){pk2(S[da][4 * ra], S[da][4 * ra + 1]), pk2(S[da][4 * ra + 2], S[da][4 * ra + 3]), pk2(S[dc][4 * rc], S[dc][4 * rc + 1]), pk2(S[dc][4 * rc + 2], S[dc][4 * rc + 3])}; }
            if (w == 0) *(f32x2*)(dseg + (size_t)unit * 128 + d0) = (f32x2){__expf(dsum0), __expf(dsum1)};
        }
    }
}

__device__ __forceinline__ void norm2_router_phase(Frame& F, const Args& A, int l, const float* modl) {
    LAS float* GV = (LAS float*)(F.lds); LAS float* SHV = (LAS float*)(F.lds + 4096); LAS float* LG = (LAS float*)(F.lds + 16384);
    LAS int* LCNT = (LAS int*)(F.lds + L_LCNT); LAS int* LBASE = (LAS int*)(F.lds + L_LBASE);
    const bf16* xb = (const bf16*)(F.ws + WS_XB); bf16* hout = (bf16*)(F.ws + WS_H);
    const bf16* wr = (const bf16*)(F.ws + WS_WR) + (size_t)l * 256 * 1024;
    const float* gain = A.in[13] + (size_t)l * D;
    const float* rgb = A.in[15] + l * 8; const float* reb = A.in[17] + l * 64;
    int* ltok = (int*)(F.ws + WS_LTOK); float* lw = (float*)(F.ws + WS_LW); int* route = (int*)(F.ws + WS_ROUTE);
    for (int ch = F.bx; ch < NTOK / 128; ch += F.G) {
        const int b = ch >> 5;
        __syncthreads();
        for (int k = F.tid; k < D; k += NTHR) { GV[k] = gain[k] * (1.0f + modl[(size_t)b * MODW + 4096 + k]); SHV[k] = modl[(size_t)b * MODW + 3072 + k]; }
        if (F.tid < 64) LCNT[F.tid] = 0;
        __syncthreads();
        u32x4 wreg[5];
#define RT_GLOAD(sl) do { _Pragma("unroll") for (int j = 0; j < 5; ++j) { const int u_ = F.tid + NTHR * j; wreg[j] = *(const u32x4*)((const char*)wr + (size_t)(u_ >> 5) * 2048 + (sl) * 512 + (u_ & 31) * 16); } } while (0)
#define RT_LSTORE(bo) do { _Pragma("unroll") for (int j = 0; j < 5; ++j) { const int u_ = F.tid + NTHR * j; *(LAS u32x4*)(F.lds + (bo) + (u_ >> 5) * 528 + (u_ & 31) * 16) = wreg[j]; } } while (0)
        RT_GLOAD(0);
#pragma unroll 1
        for (int g = 0; g < 8; ++g) {
            const int r0 = ch * 128 + F.wave * 16 + g * 2;
            f32x4 v[2][4];
#pragma unroll
            for (int r = 0; r < 2; ++r)
#pragma unroll
                for (int j = 0; j < 4; ++j) { const u32x2 t = *(const u32x2*)(xb + (size_t)(r0 + r) * D + 256 * j + 4 * F.lane); v[r][j] = (f32x4){bflo(t.x), bfhi(t.x), bflo(t.y), bfhi(t.y)}; }
            float rstd[2];
#pragma unroll
            for (int r = 0; r < 2; ++r) { float s = 0.f;
#pragma unroll
                for (int j = 0; j < 4; ++j) s += (v[r][j][0] * v[r][j][0] + v[r][j][1] * v[r][j][1]) + (v[r][j][2] * v[r][j][2] + v[r][j][3] * v[r][j][3]);
                rstd[r] = rsqrtf(wave_sum(s) * (1.0f / D) + EPS); }
#pragma unroll
            for (int j = 0; j < 4; ++j) { const f32x4 gg = *(const LAS f32x4*)(GV + 256 * j + 4 * F.lane), ss = *(const LAS f32x4*)(SHV + 256 * j + 4 * F.lane);
#pragma unroll
                for (int r = 0; r < 2; ++r) { const f32x4 y = v[r][j] * rstd[r] * gg + ss; u32x2 w; w.x = pk2(y[0], y[1]); w.y = pk2(y[2], y[3]);
                    *(u32x2*)(hout + (size_t)(r0 + r) * D + 256 * j + 4 * F.lane) = w; } }
        }
        asm volatile("s_waitcnt vmcnt(0)" ::: "memory");
        {
            const int lr = F.lane & 15, kq = F.lane >> 4;
            const bf16* ap = hout + (size_t)(ch * 128 + F.wave * 16 + lr) * D + 8 * kq;
            constexpr int RB0 = 8192, RB1 = 8192 + 80 * 528;
            f32x4 acc[5];
#pragma unroll
            for (int cb = 0; cb < 5; ++cb) acc[cb] = (f32x4){0.f, 0.f, 0.f, 0.f};
            bf16x8 af[2][8];
#define RT_ALOAD(buf, sl) do { _Pragma("unroll") for (int q = 0; q < 8; ++q) af[buf][q] = *(const bf16x8*)(ap + 256 * (sl) + 32 * q); } while (0)
#define RT_MMA(buf, bo) do { _Pragma("unroll") for (int q = 0; q < 8; ++q) _Pragma("unroll") for (int cb = 0; cb < 5; ++cb) \
                acc[cb] = __builtin_amdgcn_mfma_f32_16x16x32_bf16(af[buf][q], *(const LAS bf16x8*)(F.lds + (bo) + (16 * cb + lr) * 528 + (32 * q + 8 * kq) * 2), acc[cb], 0, 0, 0); } while (0)
            RT_ALOAD(0, 0);
            RT_LSTORE(RB0); RT_GLOAD(1); RT_ALOAD(1, 1); __syncthreads(); RT_MMA(0, RB0);
            RT_LSTORE(RB1); RT_GLOAD(2); RT_ALOAD(0, 2); __syncthreads(); RT_MMA(1, RB1);
            RT_LSTORE(RB0); RT_GLOAD(3); RT_ALOAD(1, 3); __syncthreads(); RT_MMA(0, RB0);
            RT_LSTORE(RB1); __syncthreads(); RT_MMA(1, RB1);
#undef RT_ALOAD
#undef RT_MMA
#undef RT_GLOAD
#undef RT_LSTORE
            __syncthreads();
#pragma unroll
            for (int cb = 0; cb < 5; ++cb)
#pragma unroll
                for (int r = 0; r < 4; ++r) LG[(F.wave * 16 + 4 * kq + r) * 81 + 16 * cb + lr] = acc[cb][r];
        }
        __syncthreads();
        int e0 = 0, e1 = 0, r0 = 0, r1 = 0; float wa = 0.f, wb = 0.f; const int t = ch * 128 + F.tid;
        if (F.tid < 128) {
            const LAS float* lp = LG + F.tid * 81;
            float lg[8];
#pragma unroll
            for (int j = 0; j < 8; ++j) lg[j] = lp[j] + rgb[j];
            float m = lg[0]; int gi = 0;
#pragma unroll
            for (int j = 1; j < 8; ++j) if (lg[j] > m) { m = lg[j]; gi = j; }
            float sum = 0.f;
#pragma unroll
            for (int j = 0; j < 8; ++j) sum += __expf(lg[j] - m);
            const float gw = 1.0f / sum;
            float le[8];
#pragma unroll
            for (int j = 0; j < 8; ++j) le[j] = lp[8 + gi * 8 + j] + reb[gi * 8 + j];
            float m0 = le[0]; int i0 = 0;
#pragma unroll
            for (int j = 1; j < 8; ++j) if (le[j] > m0) { m0 = le[j]; i0 = j; }
            float m1 = -3.0e38f; int i1 = 0;
#pragma unroll
            for (int j = 0; j < 8; ++j) if (j != i0 && le[j] > m1) { m1 = le[j]; i1 = j; }
            const float pr = __expf(m1 - m0);
            wa = gw / (1.0f + pr); wb = gw * pr / (1.0f + pr);
            e0 = gi * 8 + i0; e1 = gi * 8 + i1;
            r0 = __hip_atomic_fetch_add(&LCNT[e0], 1, __ATOMIC_RELAXED, __HIP_MEMORY_SCOPE_WORKGROUP); r1 = __hip_atomic_fetch_add(&LCNT[e1], 1, __ATOMIC_RELAXED, __HIP_MEMORY_SCOPE_WORKGROUP);
        }
        __syncthreads();
        if (F.tid < 64) { const int n = LCNT[F.tid]; LBASE[F.tid] = n ? (int)__hip_atomic_fetch_add(F.ctl + CW_CNT + (l * 64 + F.tid) * 64, (unsigned)n, RLX_AGENT) : 0; }
        __syncthreads();
        if (F.tid < 128) {
            r0 += LBASE[e0]; r1 += LBASE[e1];
            ltok[(size_t)e0 * CAP + r0] = t; lw[(size_t)e0 * CAP + r0] = wa;
            ltok[(size_t)e1 * CAP + r1] = t; lw[(size_t)e1 * CAP + r1] = wb;
            route[2 * t] = (e0 << 16) | r0; route[2 * t + 1] = (e1 << 16) | r1;
        }
    }
    __syncthreads();
}

__device__ __forceinline__ void topk_phase(Frame& F, const Args& A, int l) {
    LAS int* LCNT = (LAS int*)(F.lds + L_LCNT); LAS int* LBASE = (LAS int*)(F.lds + L_LBASE);
    const float* logits = (const float*)(F.ws + WS_LOGITS);
    const float* rgb = A.in[15] + l * 8; const float* reb = A.in[17] + l * 64;
    int* ltok = (int*)(F.ws + WS_LTOK); float* lw = (float*)(F.ws + WS_LW); int* route = (int*)(F.ws + WS_ROUTE);
    for (int ch = F.bx; ch < NTOK / 128; ch += F.G) {
        __syncthreads();
        if (F.tid < 64) LCNT[F.tid] = 0;
        __syncthreads();
        int e0 = 0, e1 = 0, r0 = 0, r1 = 0; float wa = 0.f, wb = 0.f; const int t = ch * 128 + F.tid;
        if (F.tid < 128) {
            const float* lp = logits + (size_t)t * 128;
            float lg[8];
#pragma unroll
            for (int j = 0; j < 8; ++j) lg[j] = lp[j] + rgb[j];
            float m = lg[0]; int gi = 0;
#pragma unroll
            for (int j = 1; j < 8; ++j) if (lg[j] > m) { m = lg[j]; gi = j; }
            float sum = 0.f;
#pragma unroll
            for (int j = 0; j < 8; ++j) sum += __expf(lg[j] - m);
            const float gw = 1.0f / sum;
            float le[8];
#pragma unroll
            for (int j = 0; j < 8; ++j) le[j] = lp[8 + gi * 8 + j] + reb[gi * 8 + j];
            float m0 = le[0]; int i0 = 0;
#pragma unroll
            for (int j = 1; j < 8; ++j) if (le[j] > m0) { m0 = le[j]; i0 = j; }
            float m1 = -3.0e38f; int i1 = 0;
#pragma unroll
            for (int j = 0; j < 8; ++j) if (j != i0 && le[j] > m1) { m1 = le[j]; i1 = j; }
            const float pr = __expf(m1 - m0);
            wa = gw / (1.0f + pr); wb = gw * pr / (1.0f + pr);
            e0 = gi * 8 + i0; e1 = gi * 8 + i1;
            r0 = __hip_atomic_fetch_add(&LCNT[e0], 1, __ATOMIC_RELAXED, __HIP_MEMORY_SCOPE_WORKGROUP); r1 = __hip_atomic_fetch_add(&LCNT[e1], 1, __ATOMIC_RELAXED, __HIP_MEMORY_SCOPE_WORKGROUP);
        }
        __syncthreads();
        if (F.tid < 64) { const int n = LCNT[F.tid]; LBASE[F.tid] = n ? (int)__hip_atomic_fetch_add(F.ctl + CW_CNT + (l * 64 + F.tid) * 64, (unsigned)n, RLX_AGENT) : 0; }
        __syncthreads();
        if (F.tid < 128) {
            r0 += LBASE[e0]; r1 += LBASE[e1];
            ltok[(size_t)e0 * CAP + r0] = t; lw[(size_t)e0 * CAP + r0] = wa;
            ltok[(size_t)e1 * CAP + r1] = t; lw[(size_t)e1 * CAP + r1] = wb;
            route[2 * t] = (e0 << 16) | r0; route[2 * t + 1] = (e1 << 16) | r1;
        }
    }
    __syncthreads();
}

constexpr int NPHASE = 20;

__global__ void __launch_bounds__(NTHR, 2) mega_fwd(Args args) {
    extern __shared__ __attribute__((aligned(16))) unsigned char lds_raw[];
    Frame F;
    F.lds = (LAS unsigned char*)lds_raw;
    F.tid = threadIdx.x; F.lane = F.tid & 63; F.wave = __builtin_amdgcn_readfirstlane(F.tid >> 6);
    F.G = gridDim.x; F.bx = blockIdx.x;
    F.ws = args.ws; F.ctl = (unsigned*)(args.ws + WS_CTL); F.out = args.out;
    for (int u = F.tid; u < (LDS_BYTES - LDSCTL_OFF) / 4; u += NTHR) ((LAS unsigned*)(F.lds + LDSCTL_OFF))[u] = 0u;
    __syncthreads();
    XcdBarrier bar = xcd_barrier_post(F.ctl + CW_BAR, (volatile LAS unsigned*)(F.lds + L_BARW));
    const int lo = args.ph_lo, hi = args.ph_hi;
#ifdef ONLY
#define PHON(k) ((k) == ONLY)
#else
#define PHON(k) true
#endif
#define PHASE_FENCE() do { F.tid = threadIdx.x; asm volatile("" : "+v"(F.tid)); F.lane = F.tid & 63; F.wave = __builtin_amdgcn_readfirstlane(F.tid >> 6); \
    unsigned long long zo_ = 0; unsigned zl_ = 0; asm volatile("" : "+s"(zo_), "+s"(zl_));        \
    F.ws = args.ws + zo_; F.out = args.out + zo_; F.lds = (LAS unsigned char*)lds_raw + zl_; F.bx = blockIdx.x; F.G = gridDim.x; \
    asm volatile("" : "+s"(F.bx), "+s"(F.G)); F.ctl = (unsigned*)(F.ws + WS_CTL); } while (0)
#define IN(k) (lo <= (k) && (k) < hi)
#define SEAM(k) do { if (IN(k) && IN((k) + 1)) xcd_barrier(bar); PHASE_FENCE(); } while (0)

#define Z ((bf16*)(F.ws + WS_Z))
#define H ((bf16*)(F.ws + WS_H))
#define MOD ((const float*)(F.ws + WS_MOD))

    if (PHON(0)) if (IN(0)) { p0_prologue(F, args); }
    SEAM(0);

    for (int l = 0; l < DEPTH; ++l) {
        const int pb = 1 + 9 * l;
#define modl (MOD + (size_t)l * 8 * MODW)
        if (PHON(1)) if (IN(pb + 0)) {
            if (l == 0) {
                {
                    const float* mp = (const float*)(F.ws + WS_MODP); float* mo = (float*)(F.ws + WS_MOD);
                    for (int i = F.bx * NTHR + F.tid; i < 2 * 8 * MODW; i += F.G * NTHR) { float a = args.in[3][(i / (8 * MODW)) * MODW + i % MODW];
#pragma unroll
                        for (int kc = 0; kc < 8; ++kc) a += mp[(size_t)kc * 16 * MODW + i];
                        mo[i] = a; }
                }
                row_phase<false, false, true, false, true, false>(F, args.in[0], nullptr, H, args.in[4], (const float*)(F.ws + WS_MODP), 1024, 0, nullptr, (const float*)(F.ws + WS_WG), (float*)(F.ws + WS_GDN), args.in[3]);
            }
            else { moe_tables(F, l - 1);
                row_phase<true, true, true, false>(F, (const float*)(F.ws + WS_XB), (float*)(F.ws + WS_XB), H, args.in[4] + (size_t)l * D, modl, 1024, 0, MOD + (size_t)(l - 1) * 8 * MODW, (const float*)(F.ws + WS_WG) + (size_t)l * 16 * 1024, (float*)(F.ws + WS_GDN)); }
        }
        SEAM(pb + 0);
        if (PHON(2)) if (IN(pb + 1)) {
            const int rsplit = 1 + 2 * (F.bx & 7);
            const char* aB = (const char*)H; const char* bB = (const char*)((bf16*)(F.ws + WS_WIN) + (size_t)l * 8192 * 1024);
            pg8::EpiZ E{F.ws};
            { pg8::StaticOrder S; S.init(NTOK, 8192, F.G, F.bx, D, D); S.i1 = rsplit;
              pg8::gemm_phase<pg8::EpiZ, pg8::StaticOrder, true>(F.lds, F.tid, aB, bB, D, S, E); }
            __syncthreads();
            convert_experts(F, args, l);
            __syncthreads();
            { asm volatile("" : "+s"(aB), "+s"(bB));
              pg8::StaticOrder S; S.init(NTOK, 8192, F.G, F.bx, D, D); S.i0 = rsplit;
              pg8::gemm_phase<pg8::EpiZ, pg8::StaticOrder, true>(F.lds, F.tid, aB, bB, D, S, E); }
        }
        SEAM(pb + 1);
        if (PHON(3)) if (IN(pb + 2)) {
            if (F.bx & 1) { conv_phase(F, args, l); __syncthreads(); gla_pass<false>(F, args, l); }
            else { gla_pass<false>(F, args, l); __syncthreads(); conv_phase(F, args, l); }
        }
        SEAM(pb + 2);
        if (PHON(4)) if (IN(pb + 3)) { gla_pass<true>(F, args, l); }
        SEAM(pb + 3);
        if (PHON(5)) if (IN(pb + 4)) {
            pg8::StaticOrder S; S.init(NTOK, D, F.G, F.bx, ZLD, WOEP); S.wgm = 8; S.kshift = 4; S.kjump = (size_t)(16 * 128 + (ZCH - ZCB - 1024) * 2);
            pg8::EpiGate2 E{Z + ZGC, Z + ZGA, Z + ZCC, ZLD};
            pg8::gemm_phase<pg8::EpiGate2, pg8::StaticOrder, true, false, true>(F.lds, F.tid, (const char*)(Z + ZCB), (const char*)(F.ws + WS_WO3 + (size_t)l * WO_L), 2048, S, E);
        }
        SEAM(pb + 4);
        if (PHON(6)) if (IN(pb + 5)) {
            pg8::StaticOrder S; S.init(NTOK, D, F.G, F.bx, ZLD, D); S.wgm = 8;
            const char* aF = (const char*)(Z + ZCC); const char* bF = (const char*)(F.ws + WS_WO3 + (size_t)l * WO_L + WO_OUT);
            if (l == 0) { pg8::EpiResid<true> E{args.in[0], nullptr, (bf16*)(F.ws + WS_XB), modl + 2048};
                pg8::gemm_phase<pg8::EpiResid<true>, pg8::StaticOrder, true>(F.lds, F.tid, aF, bF, D, S, E); }
            else { pg8::EpiResid<false> E{nullptr, (const bf16*)(F.ws + WS_XB), (bf16*)(F.ws + WS_XB), modl + 2048};
                pg8::gemm_phase<pg8::EpiResid<false>, pg8::StaticOrder, true>(F.lds, F.tid, aF, bF, D, S, E); }
        }
        SEAM(pb + 5);
        if (PHON(7)) if (IN(pb + 6)) { norm2_router_phase(F, args, l, modl); }
        SEAM(pb + 6);
        if (PHON(10)) if (IN(pb + 7)) {
            moe_tables(F, l); moe_toktab(F);
            pg8::MoeOrder<true> S{F.lds, F.G, F.bx, 2048u};
            pg8::EpiAct E{(bf16*)(F.ws + WS_H1)};
            pg8::gemm_phase<pg8::EpiAct, pg8::MoeOrder<true>, true>(F.lds, F.tid, (const char*)H, (const char*)(F.ws + WS_W13), D, S, E);
        }
        SEAM(pb + 7);
        if (PHON(11)) if (IN(pb + 8)) {
            moe_tables(F, l); moe_wtab(F);
            pg8::MoeOrder<false> S{F.lds, F.G, F.bx, 1024u};
            pg8::EpiYb E{(bf16*)(F.ws + WS_YB), (const float*)(F.ws + WS_LW), F.lds};
            pg8::gemm_phase<pg8::EpiYb, pg8::MoeOrder<false>, true>(F.lds, F.tid, (const char*)(F.ws + WS_H1), (const char*)(F.ws + WS_W2), DEXP, S, E);
        }
        SEAM(pb + 8);
    }
    if (PHON(12)) if (IN(19)) {
        moe_tables(F, DEPTH - 1);
        row_phase<true, false, false, true>(F, (const float*)(F.ws + WS_XB), F.out, nullptr, args.in[21], nullptr, 0, 0, MOD + (size_t)(DEPTH - 1) * 8 * MODW, nullptr, nullptr);
    }
#undef IN
#undef SEAM
#undef Z
#undef H
#undef MOD
#undef modl
}

extern "C" void kernel_launch(void* const* d_in, const int* in_sizes, int n_in, void* d_out, int out_size, void* d_ws, size_t ws_size, hipStream_t stream) {
    static int grid = 0;
    if (grid == 0) {
        if (n_in != 22 || out_size != NTOK * D || ws_size < WS_END) { fprintf(stderr, "kernel_launch: unexpected shapes (n_in %d out %d ws %zu)\n", n_in, out_size, ws_size); grid = -1; return; }
        int dev = 0, cus = 0, per_cu = 0;
        if (hipGetDevice(&dev) != hipSuccess || hipDeviceGetAttribute(&cus, hipDeviceAttributeMultiprocessorCount, dev) != hipSuccess) { grid = -1; return; }
        if (hipFuncSetAttribute((const void*)mega_fwd, hipFuncAttributeMaxDynamicSharedMemorySize, LDS_BYTES) != hipSuccess) { fprintf(stderr, "kernel_launch: hipFuncSetAttribute failed\n"); grid = -1; return; }
        if (hipOccupancyMaxActiveBlocksPerMultiprocessor(&per_cu, (const void*)mega_fwd, NTHR, LDS_BYTES) != hipSuccess || per_cu < 1)
            fprintf(stderr, "kernel_launch: occupancy query reports %d workgroups per CU\n", per_cu);
        (void)hipGetLastError();
        grid = cus;
        if (grid > 256) grid = 256;
    }
    if (grid < 0) return;
    if (hipMemsetAsync((char*)d_ws + WS_CTL, 0, CTL_ZERO_BYTES, stream) != hipSuccess) return;
    Args a{};
    for (int i = 0; i < 22; ++i) a.in[i] = (const float*)d_in[i];
    a.out = (float*)d_out; a.ws = (unsigned char*)d_ws;
#if MK_N_LAUNCHES == 1
    a.ph_lo = 0; a.ph_hi = NPHASE;
    hipLaunchKernelGGL(mega_fwd, dim3(grid), dim3(NTHR), LDS_BYTES, stream, a);
#else
    for (int p = 0; p < NPHASE; ++p) { a.ph_lo = p; a.ph_hi = p + 1; hipLaunchKernelGGL(mega_fwd, dim3(grid), dim3(NTHR), LDS_BYTES, stream, a); }
#endif
}
```

```cpp
#include <hip/hip_runtime.h>
#include <cstdio>
#include <cstdint>

#ifndef MK_N_LAUNCHES
#define MK_N_LAUNCHES 1
#endif

#define GAS __attribute__((address_space(1)))
#define LAS __attribute__((address_space(3)))
typedef unsigned short bf16;
typedef short bf16x8 __attribute__((ext_vector_type(8)));
typedef short s16x4 __attribute__((ext_vector_type(4)));
typedef float f32x4 __attribute__((ext_vector_type(4)));
typedef float f32x2 __attribute__((ext_vector_type(2)));
typedef float f32x16 __attribute__((ext_vector_type(16)));
typedef unsigned u32x4 __attribute__((ext_vector_type(4)));
typedef unsigned u32x2 __attribute__((ext_vector_type(2)));
typedef __bf16 bf16x2_t __attribute__((ext_vector_type(2)));

constexpr int BATCH = 8, SEQ = 4096, D = 1024, NTOK = BATCH * SEQ, DEPTH = 2;
constexpr int ZLD = 5120 + 128;
constexpr int ZCB = 0, ZCC = 1024, ZCH = 2048, ZGA = 3072, ZGC = 4096;
constexpr int INCOLS = 8208, GDN_COL = 2048;
constexpr int NEXP = 64, DEXP = 512, CAP = 32768, MAXROWS = 81920;
constexpr int MODW = 6144;
constexpr float EPS = 1e-6f;
constexpr int NWAVES = 8, NTHR = 512;

constexpr size_t MiB = 1u << 20;
constexpr size_t WS_CTL = 0, CTL_ZERO_BYTES = 1 * MiB;
constexpr size_t WS_MOD = 1 * MiB;
constexpr size_t WS_ROUTE = 2 * MiB;
constexpr size_t WS_GDN = 4 * MiB;
constexpr size_t WS_LTOK = 8 * MiB;
constexpr size_t WS_LW = 16 * MiB;
constexpr size_t WS_WR = 24 * MiB;
constexpr size_t WS_WG = 25 * MiB;
constexpr size_t WS_WIN = 26 * MiB;
constexpr int WOEP = 2048 + 64;
constexpr size_t WO_L = 7 * MiB, WO_OUT = 5 * MiB;
constexpr size_t WS_WO3 = 58 * MiB;
constexpr size_t WS_SLOC = 72 * MiB;
constexpr size_t WS_DSEG = 104 * MiB;
constexpr int AEP = 2048 + 128;
constexpr size_t WS_AE = 106 * MiB;
constexpr size_t WS_W13 = 106 * MiB;
constexpr size_t WS_W2 = 234 * MiB;
constexpr size_t WS_H = 298 * MiB;
constexpr size_t WS_Z = 362 * MiB;
constexpr size_t WS_QH = 690 * MiB, WS_KH = 722 * MiB;
constexpr size_t WS_VH = 754 * MiB, WS_RH = 818 * MiB;
constexpr size_t WS_LOGITS = WS_Z;
constexpr size_t WS_H1 = WS_Z + 16 * MiB;
constexpr size_t WS_YB = WS_Z + 96 * MiB;
constexpr size_t WS_MODP = 884 * MiB;
constexpr size_t WS_EB = 888 * MiB;
constexpr size_t WS_CDEC = 920 * MiB;
constexpr size_t WS_XB = 922 * MiB;
constexpr size_t WS_END = 986 * MiB;
constexpr int CW_BAR = 4096, CW_CNT = 16384;

constexpr int RING_BYTES = 131072;
constexpr int LDSCTL_OFF = RING_BYTES;
constexpr int L_BARW = LDSCTL_OFF + 32;
constexpr int L_TB = LDSCTL_OFF + 64;
constexpr int L_CNT = LDSCTL_OFF + 256;
constexpr int L_PRE = LDSCTL_OFF + 512;
constexpr int L_LCNT = LDSCTL_OFF + 768;
constexpr int L_LBASE = LDSCTL_OFF + 1024;
constexpr int L_MBEI = LDSCTL_OFF + 2048;
constexpr int L_TOKT = LDSCTL_OFF + 4096;
constexpr int LDS_BYTES = 147456;

#define RLX_AGENT __ATOMIC_RELAXED, __HIP_MEMORY_SCOPE_AGENT
#define LDS_WAIT() asm volatile("s_waitcnt lgkmcnt(0)" ::: "memory")
#define VM_WAIT() asm volatile("s_waitcnt vmcnt(0)" ::: "memory")

__device__ __forceinline__ unsigned pk2(float lo, float hi) { bf16x2_t v; v[0] = (__bf16)lo; v[1] = (__bf16)hi; return __builtin_bit_cast(unsigned, v); }
__device__ __forceinline__ float bflo(unsigned u) { return __builtin_bit_cast(float, u << 16); }
__device__ __forceinline__ float bfhi(unsigned u) { return __builtin_bit_cast(float, u & 0xffff0000u); }
__device__ __forceinline__ float fsigmoid(float x) { return __builtin_amdgcn_rcpf(1.0f + __expf(-x)); }
__device__ __forceinline__ float wave_sum(float v) {
#pragma unroll
    for (int o = 1; o < 64; o <<= 1) v += __shfl_xor(v, o);
    return v;
}

#define XB_TMO      128
#define XB_XCNT(j)  (256  + 64 * (j))
#define XB_XSUB(j)  (1280 + 64 * (j))
#define XB_XGEN(j)  (2304 + 64 * (j))
#define XB_TOP      3328
#define XB_TOPGEN   3392
#define XCD_BAR_WORDS 3456
#define XB_SPIN_CAP (1u << 18)

__device__ __forceinline__ unsigned xb_ld(unsigned* p)              { return __hip_atomic_load(p, __ATOMIC_RELAXED, __HIP_MEMORY_SCOPE_AGENT); }
__device__ __forceinline__ unsigned xb_add(unsigned* p, unsigned v) { return __hip_atomic_fetch_add(p, v, __ATOMIC_RELAXED, __HIP_MEMORY_SCOPE_AGENT); }
__device__ __forceinline__ unsigned xb_xcc_id() { return (unsigned)__builtin_amdgcn_s_getreg((3 << 11) | 20) & 0xFu; }
#define XB_SPIN(cond, bar) do { unsigned _sp = 0; while (cond) { __builtin_amdgcn_s_sleep(1); \
    if ((++_sp & 255u) == 0u) { if (xb_ld(&(bar)[XB_TMO])) break; if (_sp > XB_SPIN_CAP) { atomicAdd(&(bar)[XB_TMO], 1u); break; } } } } while (0)

struct XcdBarrier { unsigned* bar; unsigned x; volatile LAS unsigned* st; };

__device__ __forceinline__ XcdBarrier xcd_barrier_post(unsigned* bar, volatile LAS unsigned* st) {
    XcdBarrier b; b.bar = bar; b.x = xb_xcc_id(); b.st = st;
    if (threadIdx.x == 0) (void)xb_add(&bar[XB_XCNT(b.x)], 1u);
    return b;
}
__device__ __forceinline__ void xcd_barrier_complete(unsigned* bar, unsigned x, unsigned& nloc, unsigned& nx) {
    const unsigned G = gridDim.x * gridDim.y * gridDim.z;
    unsigned sum, cnt, mine, sp = 0u;
    for (;;) {
        sum = 0u; cnt = 0u; mine = 0u;
#pragma unroll
        for (unsigned j = 0; j < 16; ++j) { const unsigned c = xb_ld(&bar[XB_XCNT(j)]); sum += c; cnt += (c > 0u) ? 1u : 0u; mine = (j == x) ? c : mine; }
        if (sum == G) break;
        __builtin_amdgcn_s_sleep(1);
        if ((++sp & 255u) == 0u) { if (xb_ld(&bar[XB_TMO])) break; if (sp > XB_SPIN_CAP) { atomicAdd(&bar[XB_TMO], 1u); break; } }
    }
    nloc = mine > 0u ? mine : 1u; nx = cnt > 0u ? cnt : 1u;
}
__device__ __forceinline__ void xcd_barrier(const XcdBarrier& b) {
    asm volatile("s_waitcnt vmcnt(0)" ::: "memory");
    __syncthreads();
    if (threadIdx.x == 0) {
        unsigned* bar = b.bar;
        __builtin_amdgcn_s_waitcnt(0);
        unsigned nloc = b.st[0], nx = b.st[1];
        if (nloc == 0u) { xcd_barrier_complete(bar, b.x, nloc, nx); b.st[0] = nloc; b.st[1] = nx; }
        const unsigned old = xb_add(&bar[XB_XSUB(b.x)], 1u);
        const unsigned gen = old / nloc;
        if (old + 1u == (gen + 1u) * nloc) {
            __builtin_amdgcn_fence(__ATOMIC_RELEASE, "agent");
            asm volatile("s_waitcnt vmcnt(0)" ::: "memory");
            const unsigned og = xb_add(&bar[XB_TOP], 1u);
            const unsigned tg = og / nx;
            if (og + 1u == (tg + 1u) * nx) xb_add(&bar[XB_TOPGEN], 1u);
            else XB_SPIN(xb_ld(&bar[XB_TOPGEN]) == tg, bar);
            __builtin_amdgcn_fence(__ATOMIC_ACQUIRE, "agent");
            xb_add(&bar[XB_XGEN(b.x)], 1u);
            asm volatile("s_waitcnt vmcnt(0)" ::: "memory");
        } else {
            XB_SPIN(xb_ld(&bar[XB_XGEN(b.x)]) == gen, bar);
            __builtin_amdgcn_fence(__ATOMIC_ACQUIRE, "agent");
            asm volatile("s_waitcnt vmcnt(0)" ::: "memory");
        }
    }
    __syncthreads();
}

namespace pg8 {
constexpr int BM = 256, BK = 64, HALF = 128, HTB = HALF * BK * 2, STAGE_BYTES = 8 * HTB, NXCD = 8, WGM = 4;
__host__ __device__ __forceinline__ int lds_byte(int r, int c) { const int st = (r >> 4) * 2 + (c >> 5), rr = r & 15, cc = c & 31, ob = rr * 64 + cc * 2; return st * 1024 + (ob ^ (((ob >> 9) & 1) << 5)); }
__host__ __device__ __forceinline__ void stage_rc(int b, int& R, int& C) { const int st = b / 1024, sb = b % 1024, swz = sb ^ (((sb >> 9) & 1) << 5); R = (st >> 1) * 16 + swz / 64; C = (st & 1) * 32 + (swz % 64) / 2; }
__host__ __device__ __forceinline__ int perm32(int rho) { const int n = rho >> 4, i = rho & 15; return 8 * (i >> 2) + 4 * n + (i & 3); }

struct Unit { int pm, pn, e, mi, slot; };

struct StaticOrder {
    int nM, nN, nwg, G, c; unsigned lda2; unsigned ldb2;
    int wgm = WGM;
    int i0 = 0, i1 = 1 << 30;
    int kshift = 30; size_t kjump = 0; bool headA = false;
    __device__ void init(int M, int N, int G_, int c_, int lda, int ldb) { nM = M / BM; nN = N / BM; nwg = nM * nN; G = G_; c = c_; lda2 = (unsigned)lda * 2u; ldb2 = (unsigned)ldb * 2u; }
    __device__ void init_head(int M, int N, int G_, int c_, int ldb) { init(M, N, G_, c_, 256, ldb); kshift = 2; kjump = (size_t)SEQ * 512; headA = true; }
    __device__ __forceinline__ size_t kbyte(int kt) const { return (size_t)(kt & ((1 << kshift) - 1)) * 128 + (size_t)(kt >> kshift) * kjump; }
    __device__ bool next(int i, Unit& u) const {
        if (i0 + i >= i1) return false;
        const long L = (long)(i0 + i) * G + c; if (L >= nwg) return false;
        int wgid = (int)L; { const int q = nwg / NXCD, r = nwg % NXCD, xcd = wgid % NXCD, off = wgid / NXCD; wgid = (xcd < r ? xcd * (q + 1) : r * (q + 1) + (xcd - r) * q) + off; }
        const int nig = wgm * nN, gid = wgid / nig, fm = gid * wgm, gsz = (nM - fm) < wgm ? (nM - fm) : wgm;
        u.pm = fm + ((wgid % nig) % gsz); u.pn = (wgid % nig) / gsz; u.e = 0; u.mi = 0; u.slot = 0; return true;
    }
    static constexpr bool GATHER_A = false;
    __device__ __forceinline__ void a_off(const Unit& u, int ui, const int (&R)[2], const int (&C)[2], unsigned (&vo)[2][2]) const {}
    __device__ __forceinline__ size_t a_base(const Unit& u) const { return headA ? ((size_t)(u.pm >> 4) * 4 * SEQ + (size_t)(u.pm & 15) * BM) * 512 : (size_t)u.pm * BM * lda2; }
    __device__ __forceinline__ size_t b_off(const Unit& u) const { return (size_t)u.pn * BM * ldb2; }
    __device__ __forceinline__ unsigned ldb_bytes() const { return ldb2; }
    __device__ __forceinline__ unsigned lda_bytes() const { return lda2; }
};

template <bool GATHER> struct MoeOrder {
    LAS unsigned char* lds; int G, c; unsigned ldb2;
    __device__ bool next(int i, Unit& u) const {
        const int TB = *(const LAS int*)(lds + L_TB);
        const int mb = i * 64 + (c & 7) * 8 + (c >> 5);
        if (mb >= TB) return false;
        const int ei = ((const LAS int*)(lds + L_MBEI))[mb];
        u.pm = mb; u.pn = (c >> 3) & 3; u.e = ei >> 16; u.mi = ei & 0xffff; u.slot = i & 7; return true;
    }
    static constexpr bool GATHER_A = GATHER;
    __device__ __forceinline__ void a_off(const Unit& u, int ui, const int (&R)[2], const int (&C)[2], unsigned (&vo)[2][2]) const {
#pragma unroll
        for (int h = 0; h < 2; ++h)
#pragma unroll
            for (int i = 0; i < 2; ++i) { const int tok = ((const LAS int*)(lds + L_TOKT))[(ui & 7) * 256 + h * HALF + R[i]]; vo[h][i] = (unsigned)tok * 2048u + (unsigned)C[i] * 2u; }
    }
    __device__ __forceinline__ size_t a_base(const Unit& u) const { return (size_t)u.pm * BM * 1024u; }
    __device__ __forceinline__ size_t b_off(const Unit& u) const { return ((size_t)u.e * 1024 + (size_t)u.pn * BM) * ldb2; }
    __device__ __forceinline__ unsigned ldb_bytes() const { return ldb2; }
    __device__ __forceinline__ unsigned lda_bytes() const { return GATHER ? 2048u : 1024u; }
    __device__ __forceinline__ size_t kbyte(int kt) const { return (size_t)kt * 128; }
};

template <class Epi, class Sched, bool ALIGN_EPI, bool DEFER = false, bool RESC = false>
__device__ __forceinline__ void gemm_phase(LAS unsigned char* lds, int tid, const char* Abase, const char* Bbase, int K, const Sched& S, const Epi& E) {
    constexpr bool GATHER = Sched::GATHER_A;
    const int wid = __builtin_amdgcn_readfirstlane(tid >> 6), lane = tid & 63, wr = wid >> 2, wc = wid & 3, fr = lane & 15, fq = lane >> 4;
    const int nt = K / BK;
    int Rs[2], Cs[2]; unsigned voffB[2], voffA[2];
    const unsigned ldb2 = S.ldb_bytes(), lda2 = S.lda_bytes();
#pragma unroll
    for (int i = 0; i < 2; ++i) { int R, C; stage_rc(tid * 16 + i * 8192, R, C); Rs[i] = R; Cs[i] = C; const int Rb = Epi::PERM ? ((R & ~31) + perm32(R & 31)) : R;
        voffB[i] = (unsigned)Rb * ldb2 + (unsigned)C * 2u; voffA[i] = (unsigned)R * lda2 + (unsigned)C * 2u; }
    const size_t kstep = (size_t)(BK * 2);
    const size_t hstepB = (size_t)HALF * ldb2, hstepA = (size_t)HALF * lda2;
    const unsigned ldsw = (unsigned)wid * 1024u;
    const int aoff = lds_byte(wr * 64 + fr, fq * 8), boff = lds_byte(wc * 32 + fr, fq * 8);
#define PG8_SA(b, h) (((b) * 2 + (h)) * HTB)
#define PG8_SB(b, h) ((4 + (b) * 2 + (h)) * HTB)
#define PG8_STAGE(bufoff, gbase, v0, v1) do { \
        __builtin_amdgcn_global_load_lds((const unsigned*)((const char*)(gbase) + (v0)), (LAS unsigned*)(lds + (bufoff) + ldsw), 16, 0, 0); \
        __builtin_amdgcn_global_load_lds((const unsigned*)((const char*)(gbase) + (v1)), (LAS unsigned*)(lds + (bufoff) + ldsw + 8192), 16, 0, 0); } while (0)
#define PG8_STAGEB(bufoff, gbase) PG8_STAGE(bufoff, gbase, voffB[0], voffB[1])
#define PG8_STAGEA(bufoff, kb, h, nx) do { if constexpr (GATHER) { const unsigned o0_ = (nx) ? vN[h][0] : vA[h][0], o1_ = (nx) ? vN[h][1] : vA[h][1]; PG8_STAGE(bufoff, Abase + (kb), o0_, o1_); } \
        else { const char* p_ = Abase + ((nx) ? uN : uA) + (kb) + (h) * hstepA; PG8_STAGE(bufoff, p_, voffA[0], voffA[1]); } } while (0)
#define PG8_LDA(dst, b, h) do { _Pragma("unroll") for (int m = 0; m < 4; ++m) _Pragma("unroll") for (int k = 0; k < 2; ++k) dst[m][k] = *(const LAS bf16x8*)(lds + PG8_SA(b, h) + aoff + m * 2048 + k * 1024); } while (0)
#define PG8_LDB(dst, b, h) do { _Pragma("unroll") for (int n = 0; n < 2; ++n) _Pragma("unroll") for (int k = 0; k < 2; ++k) dst[n][k] = *(const LAS bf16x8*)(lds + PG8_SB(b, h) + boff + n * 2048 + k * 1024); } while (0)
#define PG8_MMA(ai, bj, At, Bt) do { __builtin_amdgcn_s_setprio(1); _Pragma("unroll") for (int m = 0; m < 4; ++m) _Pragma("unroll") for (int n = 0; n < 2; ++n) _Pragma("unroll") for (int k = 0; k < 2; ++k) \
        acc[ai][bj][m][n] = __builtin_amdgcn_mfma_f32_16x16x32_bf16(Bt[n][k], At[m][k], acc[ai][bj][m][n], 0, 0, 0); __builtin_amdgcn_s_setprio(0); } while (0)
#define PG8_WAIT_V(n) asm volatile("s_waitcnt vmcnt(" #n ")" ::: "memory")
#define PG8_WAIT_L(n) asm volatile("s_waitcnt lgkmcnt(" #n ")" ::: "memory")
#define PG8_BAR __builtin_amdgcn_s_barrier()
#define PG8_SCHED __builtin_amdgcn_sched_barrier(0)
    Unit cur, nxt, prv; int ui = 0;
    if (!S.next(0, cur)) return;
    prv = cur;
    f32x4 acc[2][2][4][2];
#pragma unroll
    for (int a = 0; a < 2; ++a)
#pragma unroll
        for (int b = 0; b < 2; ++b)
#pragma unroll
            for (int m = 0; m < 4; ++m)
#pragma unroll
                for (int n = 0; n < 2; ++n) acc[a][b][m][n] = (f32x4){0.f, 0.f, 0.f, 0.f};
    bf16x8 At[4][2], B0[2][2], B1[2][2];
    unsigned vA[2][2], vN[2][2]; size_t uA = 0, uN = 0;
    if constexpr (GATHER) S.a_off(cur, 0, Rs, Cs, vA); else uA = S.a_base(cur);
    const char* cB = Bbase + S.b_off(cur);
    PG8_STAGEB(PG8_SB(0, 0), cB); PG8_STAGEB(PG8_SB(0, 1), cB + hstepB); PG8_STAGEA(PG8_SA(0, 0), 0, 0, false); PG8_STAGEA(PG8_SA(0, 1), 0, 1, false);
    if (wr == 1) PG8_BAR;
    PG8_WAIT_V(2); PG8_BAR;
    PG8_STAGEB(PG8_SB(1, 0), cB + kstep); PG8_STAGEA(PG8_SA(1, 0), kstep, 0, false); PG8_STAGEB(PG8_SB(1, 1), cB + hstepB + kstep);
    PG8_WAIT_V(6); PG8_BAR;
    for (;;) {
        const bool has_next = S.next(ui + 1, nxt);
        if constexpr (GATHER) {
            if (has_next) S.a_off(nxt, ui + 1, Rs, Cs, vN);
            else {
#pragma unroll
                for (int h = 0; h < 2; ++h)
#pragma unroll
                    for (int i = 0; i < 2; ++i) vN[h][i] = vA[h][i];
            }
        } else uN = has_next ? S.a_base(nxt) : uA;
        const char* nB = has_next ? Bbase + S.b_off(nxt) : cB;
#define PG8_WAITX(n16, n32) do { if constexpr (Epi::NST == 16) PG8_WAIT_V(n16); else PG8_WAIT_V(n32); } while (0)
#define PG8_ZERO(ai) do { _Pragma("unroll") for (int b_ = 0; b_ < 2; ++b_) _Pragma("unroll") for (int m_ = 0; m_ < 4; ++m_) _Pragma("unroll") for (int n_ = 0; n_ < 2; ++n_) acc[ai][b_][m_][n_] = (f32x4){0.f, 0.f, 0.f, 0.f}; } while (0)
#define PG8_BODY(EPI) do { \
            asm volatile("" : "+v"(voffB[0]), "+v"(voffB[1]), "+v"(voffA[0]), "+v"(voffA[1]));     \
            const bool last = (t == nt - 2); \
            const size_t k1 = S.kbyte(t + 1), k2 = last ? 0 : S.kbyte(t + 2), k3 = last ? kstep : S.kbyte(t + 3); \
            const char* b2 = last ? nB : cB + (size_t)(t + 2) * kstep; const char* b3 = b2 + kstep; \
              \
            PG8_LDB(B0, 0, 0); PG8_LDB(B1, 0, 1); PG8_SCHED; PG8_LDA(At, 0, 0); PG8_STAGEA(PG8_SA(1, 1), k1, 1, false); \
            if constexpr (EPI) { PG8_SCHED; int fr_ = fr, fq_ = fq; asm volatile("" : "+v"(fr_), "+v"(fq_)); E.template run<0, 1>(acc, prv, wr, wc, fr_, fq_); PG8_ZERO(0); PG8_SCHED; PG8_WAITX(16, 24); } else PG8_WAIT_V(8); \
            PG8_WAIT_L(0); PG8_BAR; PG8_MMA(0, 0, At, B0); PG8_MMA(0, 1, At, B1); PG8_BAR; PG8_SCHED; \
              \
            PG8_LDA(At, 0, 1); PG8_STAGEB(PG8_SB(0, 0), b2); PG8_STAGEB(PG8_SB(0, 1), b2 + hstepB); PG8_STAGEA(PG8_SA(0, 0), k2, 0, last); \
            if constexpr (EPI) { PG8_SCHED; int fr_ = fr, fq_ = fq; asm volatile("" : "+v"(fr_), "+v"(fq_)); E.template run<1, 2>(acc, prv, wr, wc, fr_, fq_); PG8_ZERO(1); PG8_SCHED; PG8_WAITX(24, 40); } else PG8_WAIT_V(8); \
            PG8_WAIT_L(0); PG8_BAR; PG8_MMA(1, 0, At, B0); PG8_MMA(1, 1, At, B1); PG8_BAR; PG8_SCHED; \
              \
            PG8_LDB(B0, 1, 0); PG8_LDB(B1, 1, 1); PG8_SCHED; PG8_LDA(At, 1, 0); PG8_STAGEA(PG8_SA(0, 1), k2, 1, last); \
            if constexpr (EPI) PG8_WAITX(24, 40); else PG8_WAIT_V(8); \
            PG8_WAIT_L(0); PG8_BAR; PG8_MMA(0, 0, At, B0); PG8_MMA(0, 1, At, B1); PG8_BAR; PG8_SCHED; \
              \
            PG8_LDA(At, 1, 1); PG8_STAGEB(PG8_SB(1, 0), b3); PG8_STAGEB(PG8_SB(1, 1), b3 + hstepB); PG8_STAGEA(PG8_SA(1, 0), k3, 0, last); \
            if constexpr (EPI) PG8_WAITX(16, 24); else PG8_WAIT_V(8); \
            PG8_WAIT_L(0); PG8_BAR; PG8_MMA(1, 0, At, B0); PG8_MMA(1, 1, At, B1); PG8_BAR; PG8_SCHED; \
        } while (0)
        if constexpr (DEFER) {
            int t = 0;
            PG8_BODY(true);
            for (t = 2; t < nt; t += 2) PG8_BODY(false);
        } else if constexpr (RESC) {
            for (int t = 0; t < nt / 2; t += 2) PG8_BODY(false);
            { int fr_ = fr, fq_ = fq; asm volatile("" : "+v"(fr_), "+v"(fq_)); E.rescale(acc, cur, wr, wc, fr_, fq_); }
            for (int t = nt / 2; t < nt; t += 2) PG8_BODY(false);
        } else {
            for (int t = 0; t < nt; t += 2) PG8_BODY(false);
        }
        if (!DEFER || !has_next) {
            if constexpr (ALIGN_EPI) { if (wr == 0) PG8_BAR; }
            { int fr_ = fr, fq_ = fq; asm volatile("" : "+v"(fr_), "+v"(fq_)); E.template run<0, 2>(acc, cur, wr, wc, fr_, fq_); }
            if (!has_next) break;
            PG8_ZERO(0); PG8_ZERO(1);
            if constexpr (ALIGN_EPI) { if (wr == 1) PG8_BAR; }
        }
        prv = cur;
        cur = nxt; cB = nB; ++ui; uA = uN;
        if constexpr (GATHER) {
#pragma unroll
            for (int h = 0; h < 2; ++h)
#pragma unroll
                for (int i = 0; i < 2; ++i) vA[h][i] = vN[h][i];
        }
    }
    PG8_WAIT_V(0);
    if constexpr (!ALIGN_EPI) { if (wr == 0) PG8_BAR; }
    PG8_BAR;
#undef PG8_SA
#undef PG8_SB
#undef PG8_STAGE
#undef PG8_STAGEA
#undef PG8_STAGEB
#undef PG8_LDA
#undef PG8_LDB
#undef PG8_MMA
#undef PG8_WAIT_V
#undef PG8_WAITX
#undef PG8_ZERO
#undef PG8_BODY
#undef PG8_WAIT_L
#undef PG8_BAR
#undef PG8_SCHED
}

typedef const f32x4 (&AccRef)[2][2][4][2];

struct EpiZ {
    static constexpr bool PERM = true; static constexpr int NST = 16;
    unsigned char* ws;
    template <int A0, int A1> __device__ __forceinline__ void run(AccRef acc, const Unit& u, int wr, int wc, int fr, int fq) const {
        const int b = u.pm >> 4, tl = (u.pm & 15) * BM + wr * 64 + fr;
        char* base; unsigned off0, rowp, bjs;
        if (u.pn < 4) { base = (char*)ws + (u.pn < 2 ? WS_QH : WS_KH);
            off0 = ((unsigned)((b * 4 + (u.pn & 1) * 2) * SEQ + tl) * 128u + (unsigned)(wc * 32 + 8 * fq)) * 2u; rowp = 256u; bjs = (unsigned)SEQ * 256u; }
        else if (u.pn < 12) { base = (char*)ws + (u.pn < 8 ? WS_VH : WS_RH);
            off0 = ((unsigned)((b * 4 + ((u.pn - 4) & 3)) * SEQ + tl) * 256u + (unsigned)(wc * 32 + 8 * fq)) * 2u; rowp = 512u; bjs = 256u; }
        else if (u.pn >= 16 && u.pn < 24) {
            const unsigned o0 = ((unsigned)(u.pm * BM + wr * 64 + fr) * (unsigned)ZLD + (unsigned)(ZCC + (u.pn - 16) * 128 + wc * 16 + 4 * fq)) * 2u; char* zb = (char*)ws + WS_Z;
#pragma unroll
            for (int ai = A0; ai < A1; ++ai)
#pragma unroll
                for (int m = 0; m < 4; ++m)
#pragma unroll
                    for (int bj = 0; bj < 2; ++bj) { const f32x4 a = acc[ai][bj][m][0], b2 = acc[ai][bj][m][1];
                        u32x2 w; w.x = pk2(a[0] * b2[0], a[1] * b2[1]); w.y = pk2(a[2] * b2[2], a[3] * b2[3]);
                        *(u32x2*)(zb + (o0 + (unsigned)(ai * HALF + m * 16) * (unsigned)(ZLD * 2) + (unsigned)(bj * 128))) = w; }
            return; }
        else { base = (char*)ws + WS_Z;
            const int zc = u.pn < 16 ? ZCB + (u.pn - 12) * BM : ZGA + (u.pn - 24) * BM;
            off0 = ((unsigned)(u.pm * BM + wr * 64 + fr) * (unsigned)ZLD + (unsigned)(zc + wc * 32 + 8 * fq)) * 2u; rowp = (unsigned)ZLD * 2u; bjs = 256u; }
#pragma unroll
        for (int ai = A0; ai < A1; ++ai)
#pragma unroll
            for (int m = 0; m < 4; ++m) { const unsigned ro = off0 + (unsigned)(ai * HALF + m * 16) * rowp;
#pragma unroll
                for (int bj = 0; bj < 2; ++bj) { f32x4 v0 = acc[ai][bj][m][0], v1 = acc[ai][bj][m][1];
                    if (u.pn >= 24) {
#pragma unroll
                        for (int j = 0; j < 4; ++j) { v0[j] = fsigmoid(v0[j]); v1[j] = fsigmoid(v1[j]); } }
                    else if (u.pn >= 8 && u.pn < 12) {
#pragma unroll
                        for (int j = 0; j < 4; ++j) { v0[j] = v0[j] * fsigmoid(v0[j]); v1[j] = v1[j] * fsigmoid(v1[j]); } }
                    u32x4 w; w.x = pk2(v0[0], v0[1]); w.y = pk2(v0[2], v0[3]); w.z = pk2(v1[0], v1[1]); w.w = pk2(v1[2], v1[3]);
                    *(u32x4*)(base + (ro + (unsigned)bj * bjs)) = w; } }
    }
};
template <bool FIRST> struct EpiGate {
    static constexpr bool PERM = true; static constexpr int NST = 16;
    const bf16* Gt; bf16* Y; int ldc;
    template <int A0, int A1> __device__ __forceinline__ void run(AccRef acc, const Unit& u, int wr, int wc, int fr, int fq) const {
        const unsigned off0 = ((unsigned)(u.pm * BM + wr * 64 + fr) * (unsigned)ldc + (unsigned)(u.pn * BM + wc * 32 + 8 * fq)) * 2u;
        const char* gb = (const char*)Gt; char* yb = (char*)Y;
#pragma unroll
        for (int ai = A0; ai < A1; ++ai)
#pragma unroll
            for (int mp = 0; mp < 2; ++mp) {
                u32x4 g[2][2], p[2][2];
#pragma unroll
                for (int mm = 0; mm < 2; ++mm)
#pragma unroll
                    for (int bj = 0; bj < 2; ++bj) { const unsigned ro = off0 + (unsigned)(ai * HALF + (2 * mp + mm) * 16) * (unsigned)ldc * 2u + (unsigned)(bj * 256);
                        g[mm][bj] = *(const u32x4*)(gb + ro); if (!FIRST) p[mm][bj] = *(const u32x4*)(yb + ro); }
#pragma unroll
                for (int mm = 0; mm < 2; ++mm)
#pragma unroll
                    for (int bj = 0; bj < 2; ++bj) { const int m = 2 * mp + mm; const f32x4 v0 = acc[ai][bj][m][0], v1 = acc[ai][bj][m][1]; const u32x4 gg = g[mm][bj];
                        float y[8];
                        y[0] = bflo(gg.x) * v0[0]; y[1] = bfhi(gg.x) * v0[1]; y[2] = bflo(gg.y) * v0[2]; y[3] = bfhi(gg.y) * v0[3];
                        y[4] = bflo(gg.z) * v1[0]; y[5] = bfhi(gg.z) * v1[1]; y[6] = bflo(gg.w) * v1[2]; y[7] = bfhi(gg.w) * v1[3];
                        if (!FIRST) { const u32x4 pp = p[mm][bj];
                            y[0] += bflo(pp.x); y[1] += bfhi(pp.x); y[2] += bflo(pp.y); y[3] += bfhi(pp.y); y[4] += bflo(pp.z); y[5] += bfhi(pp.z); y[6] += bflo(pp.w); y[7] += bfhi(pp.w); }
                        u32x4 w; w.x = pk2(y[0], y[1]); w.y = pk2(y[2], y[3]); w.z = pk2(y[4], y[5]); w.w = pk2(y[6], y[7]);
                        const unsigned ro = off0 + (unsigned)(ai * HALF + m * 16) * (unsigned)ldc * 2u + (unsigned)(bj * 256);
                        *(u32x4*)(yb + ro) = w; }
                asm volatile("" ::: "memory");
            }
    }
};
struct EpiGate2 {
    static constexpr bool PERM = true; static constexpr int NST = 16;
    const bf16* SA; const bf16* SC; bf16* Y; int ldc;
    typedef f32x4 (&AccMut)[2][2][4][2];
    __device__ __forceinline__ void rescale(AccMut acc, const Unit& u, int wr, int wc, int fr, int fq) const {
        const unsigned off0 = ((unsigned)(u.pm * BM + wr * 64 + fr) * (unsigned)ldc + (unsigned)(u.pn * BM + wc * 32 + 8 * fq)) * 2u;
        const char* ab = (const char*)SA; const char* cb = (const char*)SC;
#pragma unroll
        for (int ai = 0; ai < 2; ++ai)
#pragma unroll
            for (int mp = 0; mp < 2; ++mp) {
                u32x4 ga[2][2], gc[2][2];
#pragma unroll
                for (int mm = 0; mm < 2; ++mm)
#pragma unroll
                    for (int bj = 0; bj < 2; ++bj) { const unsigned ro = off0 + (unsigned)(ai * HALF + (2 * mp + mm) * 16) * (unsigned)ldc * 2u + (unsigned)(bj * 256);
                        ga[mm][bj] = *(const u32x4*)(ab + ro); gc[mm][bj] = *(const u32x4*)(cb + ro); }
#pragma unroll
                for (int mm = 0; mm < 2; ++mm)
#pragma unroll
                    for (int bj = 0; bj < 2; ++bj) { const int m = 2 * mp + mm; const u32x4 a = ga[mm][bj], c = gc[mm][bj];
                        f32x4 r0, r1;
#define RC_(x) __builtin_amdgcn_rcpf(fmaxf((x), 1e-30f))
                        r0[0] = bflo(a.x) * RC_(bflo(c.x)); r0[1] = bfhi(a.x) * RC_(bfhi(c.x)); r0[2] = bflo(a.y) * RC_(bflo(c.y)); r0[3] = bfhi(a.y) * RC_(bfhi(c.y));
                        r1[0] = bflo(a.z) * RC_(bflo(c.z)); r1[1] = bfhi(a.z) * RC_(bfhi(c.z)); r1[2] = bflo(a.w) * RC_(bflo(c.w)); r1[3] = bfhi(a.w) * RC_(bfhi(c.w));
#undef RC_
                        acc[ai][bj][m][0] = acc[ai][bj][m][0] * r0; acc[ai][bj][m][1] = acc[ai][bj][m][1] * r1; }
                asm volatile("" ::: "memory");
            }
    }
    template <int A0, int A1> __device__ __forceinline__ void run(AccRef acc, const Unit& u, int wr, int wc, int fr, int fq) const {
        const unsigned off0 = ((unsigned)(u.pm * BM + wr * 64 + fr) * (unsigned)ldc + (unsigned)(u.pn * BM + wc * 32 + 8 * fq)) * 2u;
        const char* cb = (const char*)SC; char* yb = (char*)Y;
#pragma unroll
        for (int ai = A0; ai < A1; ++ai) {
            u32x4 gc[4][2];
#pragma unroll
            for (int m = 0; m < 4; ++m)
#pragma unroll
                for (int bj = 0; bj < 2; ++bj) gc[m][bj] = *(const u32x4*)(cb + (off0 + (unsigned)(ai * HALF + m * 16) * (unsigned)ldc * 2u + (unsigned)(bj * 256)));
#pragma unroll
            for (int m = 0; m < 4; ++m)
#pragma unroll
                for (int bj = 0; bj < 2; ++bj) { const f32x4 v0 = acc[ai][bj][m][0], v1 = acc[ai][bj][m][1]; const u32x4 c = gc[m][bj];
                    u32x4 w; w.x = pk2(bflo(c.x) * v0[0], bfhi(c.x) * v0[1]); w.y = pk2(bflo(c.y) * v0[2], bfhi(c.y) * v0[3]); w.z = pk2(bflo(c.z) * v1[0], bfhi(c.z) * v1[1]); w.w = pk2(bflo(c.w) * v1[2], bfhi(c.w) * v1[3]);
                    *(u32x4*)(yb + (off0 + (unsigned)(ai * HALF + m * 16) * (unsigned)ldc * 2u + (unsigned)(bj * 256))) = w; }
            asm volatile("" ::: "memory");
        }
    }
};
template <bool XF32> struct EpiResid {
    static constexpr bool PERM = true; static constexpr int NST = 16;
    const float* xin32; const bf16* xin16; bf16* xout; const float* g1;
    template <int A0, int A1> __device__ __forceinline__ void run(AccRef acc, const Unit& u, int wr, int wc, int fr, int fq) const {
        const unsigned e0 = (unsigned)(u.pm * BM + wr * 64 + fr) * (unsigned)D + (unsigned)(u.pn * BM + wc * 32 + 8 * fq);
        const float* gp = g1 + (size_t)(u.pm >> 4) * MODW + (u.pn * BM + wc * 32 + 8 * fq);
        f32x4 gv[2][2];
#pragma unroll
        for (int bj = 0; bj < 2; ++bj)
#pragma unroll
            for (int n = 0; n < 2; ++n) gv[bj][n] = *(const f32x4*)(gp + bj * HALF + n * 4);
        if constexpr (!XF32) {
            constexpr int NB = (A1 - A0) * 2;
            u32x4 xr[2][2][2];
#define ER_LD(buf, q) do { _Pragma("unroll") for (int mm = 0; mm < 2; ++mm) _Pragma("unroll") for (int bj = 0; bj < 2; ++bj) \
                xr[buf][mm][bj] = *(const u32x4*)((const char*)xin16 + (e0 + (unsigned)((A0 + ((q) >> 1)) * HALF + (2 * ((q) & 1) + mm) * 16) * (unsigned)D + (unsigned)(bj * HALF)) * 2u); } while (0)
            ER_LD(0, 0);
#pragma unroll
            for (int q = 0; q < NB; ++q) {
                if (q + 1 < NB) { if ((q & 1) == 0) ER_LD(1, q + 1); else ER_LD(0, q + 1); }
                const int ai = A0 + (q >> 1), mp = q & 1;
#pragma unroll
                for (int mm = 0; mm < 2; ++mm)
#pragma unroll
                    for (int bj = 0; bj < 2; ++bj) { const int m = 2 * mp + mm; const unsigned eo = e0 + (unsigned)(ai * HALF + m * 16) * (unsigned)D + (unsigned)(bj * HALF); const u32x4 t = xr[q & 1][mm][bj];
                        const f32x4 x0 = (f32x4){bflo(t.x), bfhi(t.x), bflo(t.y), bfhi(t.y)}, x1 = (f32x4){bflo(t.z), bfhi(t.z), bflo(t.w), bfhi(t.w)};
                        const f32x4 y0 = x0 + gv[bj][0] * acc[ai][bj][m][0], y1 = x1 + gv[bj][1] * acc[ai][bj][m][1];
                        u32x4 w; w.x = pk2(y0[0], y0[1]); w.y = pk2(y0[2], y0[3]); w.z = pk2(y1[0], y1[1]); w.w = pk2(y1[2], y1[3]);
                        *(u32x4*)((char*)xout + eo * 2u) = w; }
                asm volatile("" ::: "memory");
            }
#undef ER_LD
            return;
        }
#pragma unroll
        for (int ai = A0; ai < A1; ++ai)
#pragma unroll
            for (int mp = 0; mp < 2; ++mp) {
                f32x4 xv[2][2][2];
#pragma unroll
                for (int mm = 0; mm < 2; ++mm)
#pragma unroll
                    for (int bj = 0; bj < 2; ++bj) { const unsigned eo = e0 + (unsigned)(ai * HALF + (2 * mp + mm) * 16) * (unsigned)D + (unsigned)(bj * HALF);
                        if (XF32) { xv[mm][bj][0] = *(const f32x4*)((const char*)xin32 + eo * 4u); xv[mm][bj][1] = *(const f32x4*)((const char*)xin32 + (eo * 4u + 16u)); }
                        else { const u32x4 t = *(const u32x4*)((const char*)xin16 + eo * 2u);
                            xv[mm][bj][0] = (f32x4){bflo(t.x), bfhi(t.x), bflo(t.y), bfhi(t.y)}; xv[mm][bj][1] = (f32x4){bflo(t.z), bfhi(t.z), bflo(t.w), bfhi(t.w)}; } }
#pragma unroll
                for (int mm = 0; mm < 2; ++mm)
#pragma unroll
                    for (int bj = 0; bj < 2; ++bj) { const int m = 2 * mp + mm; const unsigned eo = e0 + (unsigned)(ai * HALF + m * 16) * (unsigned)D + (unsigned)(bj * HALF);
                        const f32x4 y0 = xv[mm][bj][0] + gv[bj][0] * acc[ai][bj][m][0], y1 = xv[mm][bj][1] + gv[bj][1] * acc[ai][bj][m][1];
                        u32x4 w; w.x = pk2(y0[0], y0[1]); w.y = pk2(y0[2], y0[3]); w.z = pk2(y1[0], y1[1]); w.w = pk2(y1[2], y1[3]);
                        *(u32x4*)((char*)xout + eo * 2u) = w; }
                asm volatile("" ::: "memory");
            }
    }
};
struct EpiLogits {
    static constexpr bool PERM = false; static constexpr int NST = 16;
    float* L;
    template <int A0, int A1> __device__ __forceinline__ void run(AccRef acc, const Unit& u, int wr, int wc, int fr, int fq) const {
        const int row0 = u.pm * BM + wr * 64 + fr, col0 = wc * 32 + 4 * fq;
#pragma unroll
        for (int ai = A0; ai < A1; ++ai)
#pragma unroll
            for (int m = 0; m < 4; ++m) { float* rowp = L + (size_t)(row0 + ai * HALF + m * 16) * 128 + col0;
#pragma unroll
                for (int n = 0; n < 2; ++n) *(f32x4*)(rowp + n * 16) = acc[ai][0][m][n]; }
    }
};
struct EpiAct {
    static constexpr bool PERM = true; static constexpr int NST = 16;
    bf16* H1;
    template <int A0, int A1> __device__ __forceinline__ void run(AccRef acc, const Unit& u, int wr, int wc, int fr, int fq) const {
        const int row0 = u.pm * BM + wr * 64 + fr, col0 = u.pn * 128 + wc * 16 + 4 * fq;
#pragma unroll
        for (int ai = A0; ai < A1; ++ai)
#pragma unroll
            for (int m = 0; m < 4; ++m) { bf16* rowp = H1 + (size_t)(row0 + ai * HALF + m * 16) * DEXP + col0;
#pragma unroll
                for (int bj = 0; bj < 2; ++bj) { const f32x4 a = acc[ai][bj][m][0], b = acc[ai][bj][m][1];
                    float y[4];
#pragma unroll
                    for (int j = 0; j < 4; ++j) y[j] = a[j] * fsigmoid(a[j]) * b[j];
                    u32x2 w; w.x = pk2(y[0], y[1]); w.y = pk2(y[2], y[3]);
                    *(u32x2*)(rowp + bj * 64) = w; } }
    }
};
struct EpiYb {
    static constexpr bool PERM = true; static constexpr int NST = 16;
    bf16* YB; const float* lw; LAS unsigned char* lds;
    template <int A0, int A1> __device__ __forceinline__ void run(AccRef acc, const Unit& u, int wr, int wc, int fr, int fq) const {
        const int rl0 = wr * 64 + fr;
        const unsigned off0 = ((unsigned)(u.pm * BM + rl0) * (unsigned)D + (unsigned)(u.pn * BM + wc * 32 + 8 * fq)) * 2u;
        char* base = (char*)YB; const LAS float* wt = (const LAS float*)(lds + L_TOKT) + u.slot * 256 + rl0;
        float wgt[2][4];
#pragma unroll
        for (int ai = A0; ai < A1; ++ai)
#pragma unroll
            for (int m = 0; m < 4; ++m) wgt[ai][m] = wt[ai * HALF + m * 16];
#pragma unroll
        for (int ai = A0; ai < A1; ++ai)
#pragma unroll
            for (int m = 0; m < 4; ++m) { const unsigned ro = off0 + (unsigned)(ai * HALF + m * 16) * (unsigned)(D * 2);
#pragma unroll
                for (int bj = 0; bj < 2; ++bj) { const f32x4 v0 = acc[ai][bj][m][0] * wgt[ai][m], v1 = acc[ai][bj][m][1] * wgt[ai][m];
                    u32x4 w; w.x = pk2(v0[0], v0[1]); w.y = pk2(v0[2], v0[3]); w.z = pk2(v1[0], v1[1]); w.w = pk2(v1[2], v1[3]);
                    *(u32x4*)(base + (ro + (unsigned)(bj * 256))) = w; } }
    }
};
}

struct Args { const float* in[22]; float* out; unsigned char* ws; int ph_lo, ph_hi; };
struct Frame {
    LAS unsigned char* lds;
    unsigned* ctl;
    unsigned char* ws;
    int tid, lane, wave, G, bx;
    float* out;
};

__device__ __forceinline__ void tr_item(const float* W, int ldw, int k0, int scol0, bf16* WT, int ldt, int drow0, int ilv, float scale, LAS float* scr, int lane) {
#pragma unroll 8
    for (int i = 0; i < 32; ++i) { const int kk = 2 * i + (lane >> 5); scr[kk * 33 + (lane & 31)] = W[(size_t)(k0 + kk) * ldw + scol0 + (lane & 31)] * scale; }
    LDS_WAIT(); asm volatile("" ::: "memory");
    const int c = lane & 7;
#pragma unroll
    for (int j = 0; j < 4; ++j) { const int n = (lane >> 3) + 8 * j; const LAS float* s = scr + (8 * c) * 33 + n;
        u32x4 o; o.x = pk2(s[0 * 33], s[1 * 33]); o.y = pk2(s[2 * 33], s[3 * 33]); o.z = pk2(s[4 * 33], s[5 * 33]); o.w = pk2(s[6 * 33], s[7 * 33]);
        const int drow = ilv ? drow0 + 8 * (n >> 2) + (n & 3) + 4 * (ilv - 1) : drow0 + n;
        *(u32x4*)(WT + (size_t)drow * ldt + k0 + 8 * c) = o; }
    LDS_WAIT(); asm volatile("" ::: "memory");
}

__device__ __forceinline__ void p0_prologue(Frame& F, const Args& A) {
    const int gw = F.bx * NWAVES + F.wave, NGW = F.G * NWAVES;
    {
        LAS float* sc = (LAS float*)(F.lds + 69632);
        bool have = false;
        for (int it = F.bx; it < 192; it += F.G) {
            if (!have) { for (int i = F.tid; i < 8192; i += NTHR) { const float v = A.in[1][i]; sc[i] = v * fsigmoid(v); } __syncthreads(); have = true; }
            const int l = it / 96, cc = (it % 96) >> 3, kc = it & 7, col = cc * 512 + F.tid;
            const float* w = A.in[2] + ((size_t)l * D + kc * 128) * MODW + col;
            float a[8];
#pragma unroll
            for (int b = 0; b < 8; ++b) a[b] = 0.f;
#pragma unroll 32
            for (int k = 0; k < 128; ++k) { const float wv = w[(size_t)k * MODW];
#pragma unroll
                for (int b = 0; b < 8; ++b) a[b] += sc[b * 1024 + kc * 128 + k] * wv; }
            float* mo = (float*)(F.ws + WS_MODP) + ((size_t)(kc * 2 + l) * 8) * MODW + col;
#pragma unroll
            for (int b = 0; b < 8; ++b) mo[(size_t)b * MODW] = a[b];
        }
        __syncthreads();
    }
    LAS float* scr = (LAS float*)(F.lds + F.wave * 8448);
    constexpr int I_IN = 16 * 256, I_SQ = 16 * 32, I_L = I_IN + 3 * I_SQ;
    for (int it = gw; it < 2 * I_L; it += NGW) {
        const int l = it / I_L; int r = it % I_L;
        if (r < I_IN) { const int kb = r / 256, nb = r % 256, n0 = nb * 32; const int scol = n0 < 2048 ? n0 : n0 + 16;
            bf16* wt = (bf16*)(F.ws + WS_WIN) + (size_t)l * 8192 * 1024;
            if (nb >= 128 && nb < 192) {
                const int sh = (nb - 128) >> 5, nq = (nb - 128) & 31;
                tr_item(A.in[5] + (size_t)l * D * INCOLS, INCOLS, kb * 64, (sh ? 5136 : 4112) + 32 * nq, wt, 1024, 4096 + 64 * nq, 1 + sh, 1.0f, scr, F.lane); }
            else tr_item(A.in[5] + (size_t)l * D * INCOLS, INCOLS, kb * 64, scol, wt, 1024, n0, 0, n0 < 512 ? 0.08838834764831845f : 1.0f, scr, F.lane);
            continue; }
        r -= I_IN; const int which = r / I_SQ; r %= I_SQ; const int kb = r / 32, nb = r % 32;
        bf16* dst = (bf16*)(F.ws + WS_WO3 + (size_t)l * WO_L);
        if (which == 0) tr_item(A.in[10] + (size_t)l * D * D, D, kb * 64, nb * 32, dst + 1024, WOEP, nb * 32, 0, 1.0f, scr, F.lane);
        else if (which == 1) tr_item(A.in[11] + (size_t)l * D * D, D, kb * 64, nb * 32, dst, WOEP, nb * 32, 0, 1.0f, scr, F.lane);
        else tr_item(A.in[12] + (size_t)l * D * D, D, kb * 64, nb * 32, (bf16*)(F.ws + WS_WO3 + (size_t)l * WO_L + WO_OUT), 1024, nb * 32, 0, 1.0f, scr, F.lane);
    }
    {
        const int gt = F.bx * NTHR + F.tid, NGT = F.G * NTHR;
        bf16* wr = (bf16*)(F.ws + WS_WR);
        for (int i = gt; i < 2 * 256 * 1024; i += NGT) { const int l = i >> 18, n = (i >> 10) & 255, k = i & 1023;
            float v = 0.f; if (n < 8) v = A.in[14][((size_t)l * D + k) * 8 + n]; else if (n < 72) v = A.in[16][((size_t)l * D + k) * 64 + (n - 8)];
            wr[i] = (bf16)(pk2(v, 0.f) & 0xffffu); }
        float* wg = (float*)(F.ws + WS_WG);
        for (int i = gt; i < 2 * 16 * 1024; i += NGT) { const int l = i >> 14, c = (i >> 10) & 15, k = i & 1023;
            wg[i] = A.in[5][((size_t)l * D + k) * INCOLS + GDN_COL + c]; }
    }
}

struct TrItem { const float* wp; int ldw; bf16* wt; int ldt; int drow0, ilv, k0; };
__device__ __forceinline__ void tr_load(const TrItem& t, float (&v)[32], int lane) {
    const float* wp = t.wp + (size_t)(t.k0 + (lane >> 5)) * t.ldw + (lane & 31);
#pragma unroll
    for (int i = 0; i < 32; ++i) v[i] = __builtin_nontemporal_load(wp + (size_t)(2 * i) * t.ldw);
}
__device__ __forceinline__ void tr_store(const TrItem& t, const float (&v)[32], LAS float* scr, int lane) {
#pragma unroll
    for (int i = 0; i < 32; ++i) scr[(2 * i + (lane >> 5)) * 33 + (lane & 31)] = v[i];
    LDS_WAIT(); asm volatile("" ::: "memory");
    const int c = lane & 7;
#pragma unroll
    for (int j = 0; j < 4; ++j) { const int n = (lane >> 3) + 8 * j; const LAS float* s = scr + (8 * c) * 33 + n;
        u32x4 o; o.x = pk2(s[0 * 33], s[1 * 33]); o.y = pk2(s[2 * 33], s[3 * 33]); o.z = pk2(s[4 * 33], s[5 * 33]); o.w = pk2(s[6 * 33], s[7 * 33]);
        const int drow = t.ilv ? t.drow0 + 8 * (n >> 2) + (n & 3) + 4 * (t.ilv - 1) : t.drow0 + n;
        __builtin_nontemporal_store(o, (u32x4*)(t.wt + (size_t)drow * t.ldt + t.k0 + 8 * c)); }
    LDS_WAIT(); asm volatile("" ::: "memory");
}
__device__ __forceinline__ TrItem expert_item(Frame& F, const Args& A, int l, int it) {
    constexpr int I13 = 16 * 16, I2 = 8 * 32, IE = 2 * I13 + I2;
    const int e = it / IE; int r = it % IE; TrItem t;
    if (r < 2 * I13) { const int s = r / I13; r %= I13; const int kb = r / 16, nb = r % 16;
        t.wp = (s == 0 ? A.in[18] : A.in[19]) + ((size_t)l * NEXP + e) * D * DEXP + nb * 32; t.ldw = DEXP;
        t.wt = (bf16*)(F.ws + WS_W13) + (size_t)e * 1024 * 1024; t.ldt = 1024; t.drow0 = 2 * nb * 32; t.ilv = 1 + s; t.k0 = kb * 64; }
    else { r -= 2 * I13; const int kb = r / 32, nb = r % 32;
        t.wp = A.in[20] + ((size_t)l * NEXP + e) * DEXP * D + nb * 32; t.ldw = D;
        t.wt = (bf16*)(F.ws + WS_W2) + (size_t)e * 1024 * 512; t.ldt = 512; t.drow0 = nb * 32; t.ilv = 0; t.k0 = kb * 64; }
    return t;
}
__device__ __forceinline__ void convert_experts(Frame& F, const Args& A, int l) {
    const int gw = F.bx * NWAVES + F.wave, NGW = F.G * NWAVES;
    LAS float* scr = (LAS float*)(F.lds + F.wave * 8448);
    constexpr int NIT = NEXP * (2 * 16 * 16 + 8 * 32);
    TrItem ta, tb, tc, td; float va[32], vb[32], vc[32], vd[32];
    int it = gw;
    if (it >= NIT) return;
    ta = expert_item(F, A, l, it); tr_load(ta, va, F.lane);
    if (it + NGW < NIT) { tb = expert_item(F, A, l, it + NGW); tr_load(tb, vb, F.lane); }
    if (it + 2 * NGW < NIT) { tc = expert_item(F, A, l, it + 2 * NGW); tr_load(tc, vc, F.lane); }
#define CV_STEP(TL, VL, TS, VS) do { if (it + 3 * NGW < NIT) { TL = expert_item(F, A, l, it + 3 * NGW); tr_load(TL, VL, F.lane); } \
        tr_store(TS, VS, scr, F.lane); it += NGW; } while (0)
#pragma unroll 1
    for (;;) {
        CV_STEP(td, vd, ta, va); if (it >= NIT) break;
        CV_STEP(ta, va, tb, vb); if (it >= NIT) break;
        CV_STEP(tb, vb, tc, vc); if (it >= NIT) break;
        CV_STEP(tc, vc, td, vd); if (it >= NIT) break;
    }
#undef CV_STEP
}

__device__ __forceinline__ void moe_tables(Frame& F, int l) {
    LAS int* CNT = (LAS int*)(F.lds + L_CNT); LAS int* PRE = (LAS int*)(F.lds + L_PRE); LAS int* MBEI = (LAS int*)(F.lds + L_MBEI);
    __syncthreads();
    if (F.tid < NEXP) CNT[F.tid] = (int)__hip_atomic_load(F.ctl + CW_CNT + (l * 64 + F.tid) * 64, RLX_AGENT);
    __syncthreads();
    if (F.tid < NEXP) {
        const int nb = (CNT[F.tid] + 255) >> 8; int inc = nb;
#pragma unroll
        for (int o = 1; o < 64; o <<= 1) { const int v = __shfl_up(inc, o); if (F.tid >= o) inc += v; }
        const int pre = inc - nb; PRE[F.tid] = pre;
        for (int i = 0; i < nb; ++i) MBEI[pre + i] = (F.tid << 16) | i;
        if (F.tid == NEXP - 1) *(LAS int*)(F.lds + L_TB) = inc; }
    __syncthreads();
}
__device__ __forceinline__ void moe_toktab(Frame& F) {
    const int TB = *(const LAS int*)(F.lds + L_TB);
    const LAS int* CNT = (const LAS int*)(F.lds + L_CNT); const LAS int* MBEI = (const LAS int*)(F.lds + L_MBEI);
    LAS int* TOKT = (LAS int*)(F.lds + L_TOKT);
    const int* ltok = (const int*)(F.ws + WS_LTOK);
    int tv[8];
#pragma unroll
    for (int i = 0; i < 8; ++i) { const int mb = i * 64 + (F.bx & 7) * 8 + (F.bx >> 5); tv[i] = 0;
        if (mb < TB && F.tid < 256) { const int ei = MBEI[mb], e = ei >> 16, rank = (ei & 0xffff) * 256 + F.tid;
            if (rank < CNT[e]) tv[i] = ltok[(size_t)e * CAP + rank]; } }
#pragma unroll
    for (int i = 0; i < 8; ++i) { const int mb = i * 64 + (F.bx & 7) * 8 + (F.bx >> 5);
        if (mb < TB && F.tid < 256) TOKT[i * 256 + F.tid] = tv[i]; }
    __syncthreads();
}

__device__ __forceinline__ void moe_wtab(Frame& F) {
    const int TB = *(const LAS int*)(F.lds + L_TB);
    const LAS int* CNT = (const LAS int*)(F.lds + L_CNT); const LAS int* MBEI = (const LAS int*)(F.lds + L_MBEI);
    LAS float* WT = (LAS float*)(F.lds + L_TOKT);
    const float* lw = (const float*)(F.ws + WS_LW);
    float wv[8];
#pragma unroll
    for (int i = 0; i < 8; ++i) { const int mb = i * 64 + (F.bx & 7) * 8 + (F.bx >> 5); wv[i] = 0.f;
        if (mb < TB && F.tid < 256) { const int ei = MBEI[mb], e = ei >> 16, rank = (ei & 0xffff) * 256 + F.tid;
            if (rank < CNT[e]) wv[i] = lw[(size_t)e * CAP + rank]; } }
#pragma unroll
    for (int i = 0; i < 8; ++i) { const int mb = i * 64 + (F.bx & 7) * 8 + (F.bx >> 5);
        if (mb < TB && F.tid < 256) WT[i * 256 + F.tid] = wv[i]; }
    __syncthreads();
}
template <bool COMBINE, bool WRITE_X, bool GDN, bool FINAL, bool MODPART = false, bool XBF = true>
__device__ __forceinline__ void row_phase(Frame& F, const float* xin, float* xout, bf16* hout, const float* gain, const float* modl, int sc_off, int sh_off,
                                          const float* modprev, const float* wg, float* gdn_out, const float* modbias = nullptr) {
    LAS float* GV = (LAS float*)(F.lds); LAS float* SHV = (LAS float*)(F.lds + 4096); LAS float* G2P = (LAS float*)(F.lds + 8192); LAS float* WG = (LAS float*)(F.lds + 16384);
    const LAS int* PRE = (const LAS int*)(F.lds + L_PRE);
    if (GDN) { for (int i = F.tid; i < 16 * 1024; i += NTHR) WG[i] = wg[i]; }
    for (int ch = F.bx; ch < NTOK / 128; ch += F.G) {
        const int b = ch >> 5;
        __syncthreads();
        for (int k = F.tid; k < D; k += NTHR) {
            if (FINAL) { GV[k] = gain[k]; SHV[k] = 0.f; }
            else if (MODPART) {
                float a = modbias[sc_off + k], c2 = modbias[sh_off + k];
#pragma unroll
                for (int kc = 0; kc < 8; ++kc) { a += modl[(size_t)kc * 16 * MODW + (size_t)b * MODW + sc_off + k]; c2 += modl[(size_t)kc * 16 * MODW + (size_t)b * MODW + sh_off + k]; }
                GV[k] = gain[k] * (1.0f + a); SHV[k] = c2; }
            else { GV[k] = gain[k] * (1.0f + modl[(size_t)b * MODW + sc_off + k]); SHV[k] = modl[(size_t)b * MODW + sh_off + k]; }
            if (COMBINE) G2P[k] = modprev[(size_t)b * MODW + 5120 + k];
        }
        __syncthreads();
#pragma unroll 1
        for (int g = 0; g < 8; ++g) {
            const int r0 = ch * 128 + F.wave * 16 + g * 2;
            f32x4 v[2][4];
#pragma unroll
            for (int r = 0; r < 2; ++r)
#pragma unroll
                for (int j = 0; j < 4; ++j) {
                    if (XBF) { const u32x2 t = *(const u32x2*)((const bf16*)xin + (size_t)(r0 + r) * D + 256 * j + 4 * F.lane); v[r][j] = (f32x4){bflo(t.x), bfhi(t.x), bflo(t.y), bfhi(t.y)}; }
                    else v[r][j] = *(const f32x4*)(xin + (size_t)(r0 + r) * D + 256 * j + 4 * F.lane); }
            if (COMBINE) {
                const int* route = (const int*)(F.ws + WS_ROUTE); const bf16* yb = (const bf16*)(F.ws + WS_YB);
#pragma unroll
                for (int r = 0; r < 2; ++r) {
                    const int er0 = route[2 * (r0 + r)], er1 = route[2 * (r0 + r) + 1];
                    const int row_a = (PRE[er0 >> 16] + ((er0 & 0xffff) >> 8)) * 256 + (er0 & 255);
                    const int row_b = (PRE[er1 >> 16] + ((er1 & 0xffff) >> 8)) * 256 + (er1 & 255);
#pragma unroll
                    for (int j = 0; j < 4; ++j) {
                        const u32x2 ya = *(const u32x2*)(yb + (size_t)row_a * D + 256 * j + 4 * F.lane), yc = *(const u32x2*)(yb + (size_t)row_b * D + 256 * j + 4 * F.lane);
                        const f32x4 gg = *(const LAS f32x4*)(G2P + 256 * j + 4 * F.lane);
                        f32x4 s; s[0] = bflo(ya.x) + bflo(yc.x); s[1] = bfhi(ya.x) + bfhi(yc.x); s[2] = bflo(ya.y) + bflo(yc.y); s[3] = bfhi(ya.y) + bfhi(yc.y);
                        v[r][j] = v[r][j] + gg * s;
                    }
                }
            }
            float rstd[2];
#pragma unroll
            for (int r = 0; r < 2; ++r) { float s = 0.f;
#pragma unroll
                for (int j = 0; j < 4; ++j) s += (v[r][j][0] * v[r][j][0] + v[r][j][1] * v[r][j][1]) + (v[r][j][2] * v[r][j][2] + v[r][j][3] * v[r][j][3]);
                rstd[r] = rsqrtf(wave_sum(s) * (1.0f / D) + EPS); }
            if (WRITE_X) {
#pragma unroll
                for (int r = 0; r < 2; ++r)
#pragma unroll
                    for (int j = 0; j < 4; ++j) { u32x2 w; w.x = pk2(v[r][j][0], v[r][j][1]); w.y = pk2(v[r][j][2], v[r][j][3]); *(u32x2*)((bf16*)xout + (size_t)(r0 + r) * D + 256 * j + 4 * F.lane) = w; }
            }
#pragma unroll
            for (int j = 0; j < 4; ++j) { const f32x4 gg = *(const LAS f32x4*)(GV + 256 * j + 4 * F.lane), ss = *(const LAS f32x4*)(SHV + 256 * j + 4 * F.lane);
#pragma unroll
                for (int r = 0; r < 2; ++r) v[r][j] = v[r][j] * rstd[r] * gg + ss; }
            if (FINAL) {
#pragma unroll
                for (int r = 0; r < 2; ++r)
#pragma unroll
                    for (int j = 0; j < 4; ++j) *(f32x4*)(xout + (size_t)(r0 + r) * D + 256 * j + 4 * F.lane) = v[r][j];
            } else {
#pragma unroll
                for (int r = 0; r < 2; ++r)
#pragma unroll
                    for (int j = 0; j < 4; ++j) { u32x2 w; w.x = pk2(v[r][j][0], v[r][j][1]); w.y = pk2(v[r][j][2], v[r][j][3]);
                        *(u32x2*)(hout + (size_t)(r0 + r) * D + 256 * j + 4 * F.lane) = w; }
            }
            if (GDN) {
                float p[32];
#pragma unroll
                for (int c = 0; c < 16; ++c) {
                    f32x4 wv[4];
#pragma unroll
                    for (int j = 0; j < 4; ++j) wv[j] = *(const LAS f32x4*)(WG + c * 1024 + 256 * j + 4 * F.lane);
#pragma unroll
                    for (int r = 0; r < 2; ++r) { float s = 0.f;
#pragma unroll
                        for (int j = 0; j < 4; ++j) s += (v[r][j][0] * wv[j][0] + v[r][j][1] * wv[j][1]) + (v[r][j][2] * wv[j][2] + v[r][j][3] * wv[j][3]);
                        p[r * 16 + c] = s; }
                    asm volatile("" ::: "memory");
                }
#define SWZX(x, o) __builtin_bit_cast(float, __builtin_amdgcn_ds_swizzle(__builtin_bit_cast(int, (x)), ((o) << 10) | 0x1f))
#define BFLY(o) do { const bool up = (F.lane & (o)) != 0; _Pragma("unroll") for (int i = 0; i < (o); ++i) { const float a_ = p[i], b_ = p[i + (o)]; const float t_ = SWZX(up ? a_ : b_, (o)); p[i] = (up ? b_ : a_) + t_; } } while (0)
                BFLY(16); BFLY(8); BFLY(4); BFLY(2); BFLY(1);
#undef BFLY
#undef SWZX
                const float tot = p[0] + __shfl_xor(p[0], 32);
                if (F.lane < 32) gdn_out[(size_t)r0 * 16 + F.lane] = tot;
            }
        }
    }
    __syncthreads();
}

__device__ __forceinline__ void conv_phase(Frame& F, const Args& A, int l) {
    bf16* z = (bf16*)(F.ws + WS_Z);
    const float* cw = A.in[9] + (size_t)l * 3 * D;
    const int cg = F.tid & 127, run = F.tid >> 7;
    float w0[8], w1[8], w2[8];
#pragma unroll
    for (int j = 0; j < 8; ++j) { w0[j] = cw[cg * 8 + j]; w1[j] = cw[D + cg * 8 + j]; w2[j] = cw[2 * D + cg * 8 + j]; }
    for (int ch = F.bx; ch < NTOK / 128; ch += F.G) {
        const int t0 = ch * 128 + run * 32;
        float um2[8], um1[8];
#pragma unroll
        for (int j = 0; j < 8; ++j) { um2[j] = 0.f; um1[j] = 0.f; }
        if ((t0 & (SEQ - 1)) != 0) {
            const u32x4 c2 = *(const u32x4*)(z + (size_t)(t0 - 2) * ZLD + ZCC + cg * 8), c1 = *(const u32x4*)(z + (size_t)(t0 - 1) * ZLD + ZCC + cg * 8);
            um2[0] = bflo(c2.x); um2[1] = bfhi(c2.x); um2[2] = bflo(c2.y); um2[3] = bfhi(c2.y); um2[4] = bflo(c2.z); um2[5] = bfhi(c2.z); um2[6] = bflo(c2.w); um2[7] = bfhi(c2.w);
            um1[0] = bflo(c1.x); um1[1] = bfhi(c1.x); um1[2] = bflo(c1.y); um1[3] = bfhi(c1.y); um1[4] = bflo(c1.z); um1[5] = bfhi(c1.z); um1[6] = bflo(c1.w); um1[7] = bfhi(c1.w);
        }
        u32x4 ca[8], ba[8], cb2[8], bb2[8];
#define CV_LD(cc_, bb_, i0_) do { _Pragma("unroll") for (int r = 0; r < 8; ++r) { const size_t ro_ = (size_t)(t0 + (i0_) + r) * ZLD + cg * 8; \
            cc_[r] = __builtin_nontemporal_load((const u32x4*)(z + ro_ + ZCC)); bb_[r] = __builtin_nontemporal_load((const u32x4*)(z + ro_ + ZCB)); } } while (0)
#define CV_DO(cc_, bb_, i0_) do { _Pragma("unroll") for (int r = 0; r < 8; ++r) { const size_t ro_ = (size_t)(t0 + (i0_) + r) * ZLD + cg * 8; const u32x4 cc = cc_[r], bb = bb_[r]; \
            float u[8], bv[8], o[8]; \
            u[0] = bflo(cc.x); u[1] = bfhi(cc.x); u[2] = bflo(cc.y); u[3] = bfhi(cc.y); u[4] = bflo(cc.z); u[5] = bfhi(cc.z); u[6] = bflo(cc.w); u[7] = bfhi(cc.w); \
            bv[0] = bflo(bb.x); bv[1] = bfhi(bb.x); bv[2] = bflo(bb.y); bv[3] = bfhi(bb.y); bv[4] = bflo(bb.z); bv[5] = bfhi(bb.z); bv[6] = bflo(bb.w); bv[7] = bfhi(bb.w); \
            _Pragma("unroll") for (int j = 0; j < 8; ++j) { o[j] = bv[j] * (w0[j] * um2[j] + w1[j] * um1[j] + w2[j] * u[j]); um2[j] = um1[j]; um1[j] = u[j]; } \
            u32x4 w; w.x = pk2(o[0], o[1]); w.y = pk2(o[2], o[3]); w.z = pk2(o[4], o[5]); w.w = pk2(o[6], o[7]); \
            *(u32x4*)(z + ro_ + ZCB) = w; } } while (0)
        CV_LD(ca, ba, 0);
        CV_LD(cb2, bb2, 8);  CV_DO(ca, ba, 0);
        CV_LD(ca, ba, 16);   CV_DO(cb2, bb2, 8);
        CV_LD(cb2, bb2, 24); CV_DO(ca, ba, 16);
        CV_DO(cb2, bb2, 24);
#undef CV_LD
#undef CV_DO
    }
}

constexpr int GL_QS = 272, GL_VS = 528, GL_AS = 144, GL_OS = 528;
constexpr int GL_QT = 0, GL_KT = 17408, GL_VV = 34816, GL_ATT = 68608, GL_OB = 77824, GL_GD = 111616, GL_SEGT = 115712, GL_DEC = 119808, GL_W2 = L_TOKT;
static_assert(GL_DEC + 512 <= RING_BYTES, "GLA LDS map");
#define MFMA32(a, b, c) __builtin_amdgcn_mfma_f32_32x32x16_bf16((a), (b), (c), 0, 0, 0)
#define TR16(p) __builtin_amdgcn_ds_read_tr16_b64_v4i16((LAS s16x4*)(p))

__device__ __forceinline__ float log_sigmoid_f(float x) { return fminf(x, 0.f) - __logf(1.0f + __expf(-fabsf(x))); }

template <bool PASS2>
__device__ __forceinline__ void gla_pass(Frame& F, const Args& A, int l) {
    LAS unsigned char* lds = F.lds;
    char* qh = (char*)(F.ws + WS_QH); char* kh = (char*)(F.ws + WS_KH); char* vh = (char*)(F.ws + WS_VH); const char* rh = (const char*)(F.ws + WS_RH);
    const float* gdn = (const float*)(F.ws + WS_GDN);
    float* dseg = (float*)(F.ws + WS_DSEG);
    char* ebuf = (char*)(F.ws + WS_EB); float* cdec = (float*)(F.ws + WS_CDEC);
#pragma unroll 1
    for (int unit = F.bx; unit < 256; unit += F.G) {
        const int b = unit >> 5, head = (unit >> 3) & 3, seg = unit & 7;
        const int t0 = b * SEQ + seg * 512;
        const int hr0 = (b * 4 + head) * SEQ + seg * 512;
        const bool state = PASS2 || seg < 7;
        f32x2 gb;
        {
            const int tid = F.tid, lane = F.lane, d0 = 2 * lane;
            __syncthreads();
            if (!PASS2) {
#pragma unroll
                for (int j = 0; j < 4; ++j) { const int i = tid + 512 * j; *(LAS float*)(lds + GL_W2 + i * 4) = A.in[6][((size_t)l * 16 + (i >> 7)) * 512 + head * 128 + (i & 127)]; }
                gb = *(const f32x2*)(A.in[7] + (size_t)l * 512 + head * 128 + d0);
            }
        }
        f32x16 S[4];
#pragma unroll
        for (int db = 0; db < 4; ++db)
#pragma unroll
            for (int i = 0; i < 16; ++i) S[db][i] = 0.f;
        if (PASS2 && seg > 0) {
            const int w = F.wave, lane = F.lane, hh = lane >> 5;
            const u32x4* sb = (const u32x4*)(F.ws + WS_SLOC) + ((size_t)((unit - seg) * 8 + w) * 8) * 64 + lane;
            u32x4 b0[8], b1[8], b2[8];
            for (int i = F.tid; i < seg * 128; i += NTHR) *(LAS float*)(lds + GL_OB + i * 4) = dseg[(size_t)(unit - seg) * 128 + i];
#define PF_LD(buf, j_) do { const int jc_ = (j_) < seg ? (j_) : seg - 1; _Pragma("unroll") for (int i = 0; i < 8; ++i) buf[i] = sb[(size_t)jc_ * 4096 + i * 64]; } while (0)
#define PF_FOLD(buf, j_) do { const LAS float* dp = (const LAS float*)(lds + GL_OB) + (j_) * 128 + 4 * hh; \
                _Pragma("unroll") for (int i = 0; i < 8; ++i) _Pragma("unroll") for (int hf = 0; hf < 2; ++hf) { \
                    const int db = (2 * i + hf) >> 2, rg = (2 * i + hf) & 3; const f32x4 dv = *(const LAS f32x4*)(dp + 32 * db + 8 * rg); \
                    const unsigned lo = hf ? buf[i].z : buf[i].x, hi = hf ? buf[i].w : buf[i].y; \
                    S[db][4 * rg] = S[db][4 * rg] * dv[0] + bflo(lo); S[db][4 * rg + 1] = S[db][4 * rg + 1] * dv[1] + bfhi(lo); \
                    S[db][4 * rg + 2] = S[db][4 * rg + 2] * dv[2] + bflo(hi); S[db][4 * rg + 3] = S[db][4 * rg + 3] * dv[3] + bfhi(hi); } } while (0)
            PF_LD(b0, 0); PF_LD(b1, 1);
            __syncthreads();
#pragma unroll 1
            for (int j = 0; j < seg; j += 3) {
                PF_LD(b2, j + 2);
                PF_FOLD(b0, j);
                PF_LD(b0, j + 3);
                if (j + 1 < seg) PF_FOLD(b1, j + 1);
                PF_LD(b1, j + 4);
                if (j + 2 < seg) PF_FOLD(b2, j + 2);
            }
#undef PF_LD
#undef PF_FOLD
        }
        float dsum0 = 0.f, dsum1 = 0.f;
        unsigned kraw[8], qraw[8], eraw[8]; u32x4 vraw[4]; f32x4 gdr = (f32x4){0.f, 0.f, 0.f, 0.f}; u32x4 rraw[4]; f32x2 dcr = (f32x2){0.f, 0.f};
#define GLA_LOADS(co_) do { const size_t hr_ = (size_t)(hr0 + (co_)); const char* kb_ = kh + hr_ * 256; const char* qb_ = qh + hr_ * 256; const char* eb_ = ebuf + hr_ * 256; const char* vb_ = vh + hr_ * 512; \
            if (!PASS2) { if (tid < 256) gdr = *(const f32x4*)(gdn + (size_t)(t0 + (co_)) * 16 + tid * 4); } \
            else if (w == 0) dcr = *(const f32x2*)(cdec + (size_t)((t0 + (co_)) >> 6) * 512 + head * 128 + d0); \
            _Pragma("unroll") for (int ii = 0; ii < 8; ++ii) { \
                kraw[ii] = *(const unsigned*)(kb_ + (offk + (unsigned)(ii * 256))); \
                if (PASS2) { qraw[ii] = *(const unsigned*)(qb_ + (offk + (unsigned)(ii * 256))); eraw[ii] = *(const unsigned*)(eb_ + (offk + (unsigned)(ii * 256))); } } \
            if (state) { _Pragma("unroll") for (int j = 0; j < 4; ++j) vraw[j] = *(const u32x4*)(vb_ + (offv + (unsigned)(j * 16 * 512))); } \
        } while (0)
        {
            const int tid = F.tid, lane = F.lane, w = F.wave, d0 = 2 * lane;
            const unsigned offk = (unsigned)((8 * w) * 128 + d0) * 2u;
            const unsigned offv = (unsigned)((tid >> 5) * 256 + (tid & 31) * 8) * 2u;
            GLA_LOADS(0);
        }
#pragma unroll 1
        for (int c = 0; c < 8; ++c) {
            const int tc = t0 + 64 * c;
            int tq_ = F.tid; asm volatile("" : "+v"(tq_));
            const int tid = tq_, lane = tq_ & 63, w = __builtin_amdgcn_readfirstlane(tq_ >> 6);
            const int r31 = lane & 31, hh = lane >> 5, blk = (lane >> 4) & 1, q4 = (lane & 15) >> 2, p4 = lane & 3;
            const int erow = tid >> 3, ejj = tid & 7, d0 = 2 * lane;
            const unsigned offk = (unsigned)((8 * w) * 128 + d0) * 2u;
            const unsigned offv = (unsigned)((tid >> 5) * 256 + (tid & 31) * 8) * 2u;
            if (!PASS2) {
                if (tid < 256) *(LAS f32x4*)(lds + GL_GD + tid * 16) = gdr;
                __syncthreads();
                float bl[8][2]; float run0 = 0.f, run1 = 0.f;
#pragma unroll
                for (int ii = 0; ii < 8; ++ii) { bl[ii][0] = gb[0]; bl[ii][1] = gb[1]; }
#pragma unroll
                for (int r4 = 0; r4 < 4; ++r4) {
                    f32x2 wv[4];
#pragma unroll
                    for (int e = 0; e < 4; ++e) wv[e] = *(const LAS f32x2*)(lds + GL_W2 + ((4 * r4 + e) * 128 + d0) * 4);
#pragma unroll
                    for (int ii = 0; ii < 8; ++ii) { const f32x4 g = *(const LAS f32x4*)(lds + GL_GD + (8 * w + ii) * 64 + r4 * 16);
#pragma unroll
                        for (int e = 0; e < 4; ++e) { bl[ii][0] += g[e] * wv[e][0]; bl[ii][1] += g[e] * wv[e][1]; } }
                }
#pragma unroll
                for (int ii = 0; ii < 8; ++ii) { run0 += log_sigmoid_f(bl[ii][0]) * 0.0625f; run1 += log_sigmoid_f(bl[ii][1]) * 0.0625f; bl[ii][0] = run0; bl[ii][1] = run1; }
                *(LAS f32x2*)(lds + GL_SEGT + (w * 128 + d0) * 4) = (f32x2){run0, run1};
                __syncthreads();
                float off0 = 0.f, off1 = 0.f, tot0 = 0.f, tot1 = 0.f;
#pragma unroll
                for (int ww = 0; ww < 8; ++ww) { const f32x2 t = *(const LAS f32x2*)(lds + GL_SEGT + (ww * 128 + d0) * 4); if (ww < w) { off0 += t[0]; off1 += t[1]; } tot0 += t[0]; tot1 += t[1]; }
                if (w == 0) { const f32x2 dd = (f32x2){__expf(tot0), __expf(tot1)}; *(LAS f32x2*)(lds + GL_DEC + d0 * 4) = dd; *(f32x2*)(cdec + (size_t)(tc >> 6) * 512 + head * 128 + d0) = dd; }
                dsum0 += tot0; dsum1 += tot1;
                char* kbp = kh + (size_t)(hr0 + 64 * c) * 256; char* ebp = ebuf + (size_t)(hr0 + 64 * c) * 256;
#pragma unroll
                for (int ii = 0; ii < 8; ++ii) {
                    const float b0 = bl[ii][0] + off0, b1 = bl[ii][1] + off1;
                    const unsigned kt = pk2(bflo(kraw[ii]) * __expf(-b0), bfhi(kraw[ii]) * __expf(-b1));
                    *(LAS unsigned*)(lds + GL_KT + (8 * w + ii) * GL_QS + d0 * 2) = kt;
                    *(unsigned*)(kbp + (offk + (unsigned)(ii * 256))) = kt;
                    *(unsigned*)(ebp + (offk + (unsigned)(ii * 256))) = pk2(__expf(b0), __expf(b1));
                }
            } else {
                if (w == 0) *(LAS f32x2*)(lds + GL_DEC + d0 * 4) = dcr;
#pragma unroll
                for (int ii = 0; ii < 8; ++ii) {
                    *(LAS unsigned*)(lds + GL_KT + (8 * w + ii) * GL_QS + d0 * 2) = kraw[ii];
                    *(LAS unsigned*)(lds + GL_QT + (8 * w + ii) * GL_QS + d0 * 2) = pk2(bflo(qraw[ii]) * bflo(eraw[ii]), bfhi(qraw[ii]) * bfhi(eraw[ii]));
                }
            }
            if (state) {
#pragma unroll
                for (int j = 0; j < 4; ++j) { const int p = tid + 512 * j, row = p >> 5, c16 = p & 31; *(LAS u32x4*)(lds + GL_VV + row * GL_VS + c16 * 16) = vraw[j]; }
            }
            if (PASS2) {
#pragma unroll
                for (int m = 0; m < 4; ++m) rraw[m] = *(const u32x4*)(rh + (size_t)(hr0 + 64 * c + erow) * 512 + (32 * ejj + 8 * m) * 2);
            }
            { const int cn_ = 64 * (c < 7 ? c + 1 : c); GLA_LOADS(cn_); }
            if (!state) continue;
            __syncthreads();
            bf16x8 Vf[4];
#pragma unroll
            for (int ks = 0; ks < 4; ++ks) { const s16x4 lo = TR16(lds + GL_VV + (16 * ks + 8 * hh + q4) * GL_VS + (32 * w + 16 * blk + 4 * p4) * 2);
                const s16x4 hi = TR16(lds + GL_VV + (16 * ks + 8 * hh + 4 + q4) * GL_VS + (32 * w + 16 * blk + 4 * p4) * 2);
                Vf[ks] = __builtin_shufflevector(lo, hi, 0, 1, 2, 3, 4, 5, 6, 7); }
            __builtin_amdgcn_sched_barrier(0);
            f32x16 o[2];
            if (PASS2) {
                if (w < 3) {
                    const int ib = (w >= 1) ? 1 : 0, jb = (w == 2) ? 1 : 0;
                    f32x16 X;
#pragma unroll
                    for (int i = 0; i < 16; ++i) X[i] = 0.f;
#pragma unroll
                    for (int s = 0; s < 8; ++s) { const bf16x8 a = *(const LAS bf16x8*)(lds + GL_QT + (32 * ib + r31) * GL_QS + (16 * s + 8 * hh) * 2);
                        const bf16x8 bb = *(const LAS bf16x8*)(lds + GL_KT + (32 * jb + r31) * GL_QS + (16 * s + 8 * hh) * 2); X = MFMA32(a, bb, X); if (s & 1) __builtin_amdgcn_sched_barrier(0); }
#pragma unroll
                    for (int i = 0; i < 16; ++i) { const int il = 8 * (i >> 2) + 4 * hh + (i & 3); const float val = (ib == jb && r31 > il) ? 0.f : X[i];
                        *(LAS unsigned short*)(lds + GL_ATT + (32 * ib + il) * GL_AS + (32 * jb + r31) * 2) = (unsigned short)(pk2(val, 0.f) & 0xffffu); }
                }
                __builtin_amdgcn_sched_barrier(0);
#pragma unroll
                for (int i = 0; i < 16; ++i) { o[0][i] = 0.f; o[1][i] = 0.f; }
#pragma unroll
                for (int db = 0; db < 4; ++db)
#pragma unroll
                    for (int s = 0; s < 2; ++s) {
                        u32x4 pb; pb.x = pk2(S[db][8 * s + 0], S[db][8 * s + 1]); pb.y = pk2(S[db][8 * s + 2], S[db][8 * s + 3]); pb.z = pk2(S[db][8 * s + 4], S[db][8 * s + 5]); pb.w = pk2(S[db][8 * s + 6], S[db][8 * s + 7]);
                        const bf16x8 Bf = __builtin_bit_cast(bf16x8, pb);
#pragma unroll
                        for (int ib = 0; ib < 2; ++ib) { const LAS unsigned char* qp = lds + GL_QT + (32 * ib + r31) * GL_QS + (32 * db + 16 * s + 4 * hh) * 2;
                            const s16x4 lo = *(const LAS s16x4*)(qp), hi = *(const LAS s16x4*)(qp + 16);
                            const bf16x8 a = __builtin_shufflevector(lo, hi, 0, 1, 2, 3, 4, 5, 6, 7); o[ib] = MFMA32(a, Bf, o[ib]); }
                        __builtin_amdgcn_sched_barrier(0);
                    }
            }
#pragma unroll
            for (int ks = 0; ks < 4; ++ks)
#pragma unroll
                for (int db = 0; db < 4; ++db) { const s16x4 lo = TR16(lds + GL_KT + (16 * ks + 8 * hh + q4) * GL_QS + (32 * db + 16 * blk + 4 * p4) * 2);
                    const s16x4 hi = TR16(lds + GL_KT + (16 * ks + 8 * hh + 4 + q4) * GL_QS + (32 * db + 16 * blk + 4 * p4) * 2);
                    const bf16x8 a = __builtin_shufflevector(lo, hi, 0, 1, 2, 3, 4, 5, 6, 7); S[db] = MFMA32(a, Vf[ks], S[db]); if (db & 1) __builtin_amdgcn_sched_barrier(0); }
#pragma unroll
            for (int db = 0; db < 4; ++db)
#pragma unroll
                for (int rg = 0; rg < 4; ++rg) { const f32x4 dv = *(const LAS f32x4*)(lds + GL_DEC + (32 * db + 8 * rg + 4 * hh) * 4);
#pragma unroll
                    for (int e = 0; e < 4; ++e) S[db][4 * rg + e] *= dv[e]; }
            if (PASS2) {
                __syncthreads();
#pragma unroll
                for (int ib = 0; ib < 2; ++ib)
#pragma unroll
                    for (int ks = 0; ks < 4; ++ks) { if (ib == 0 && ks >= 2) continue;
                        const bf16x8 a = *(const LAS bf16x8*)(lds + GL_ATT + (32 * ib + r31) * GL_AS + (16 * ks + 8 * hh) * 2); o[ib] = MFMA32(a, Vf[ks], o[ib]); }
                __builtin_amdgcn_sched_barrier(0);
#pragma unroll
                for (int ib = 0; ib < 2; ++ib)
#pragma unroll
                    for (int i = 0; i < 16; ++i) { const int il = 8 * (i >> 2) + 4 * hh + (i & 3);
                        *(LAS unsigned short*)(lds + GL_OB + (32 * ib + il) * GL_OS + (32 * w + r31) * 2) = (unsigned short)(pk2(o[ib][i], 0.f) & 0xffffu); }
                __syncthreads();
                float ss = 0.f;
#pragma unroll
                for (int m = 0; m < 4; ++m) { const u32x4 t = *(const LAS u32x4*)(lds + GL_OB + erow * GL_OS + (32 * ejj + 8 * m) * 2);
                    ss += (bflo(t.x) * bflo(t.x) + bfhi(t.x) * bfhi(t.x)) + (bflo(t.y) * bflo(t.y) + bfhi(t.y) * bfhi(t.y)) + (bflo(t.z) * bflo(t.z) + bfhi(t.z) * bfhi(t.z)) + (bflo(t.w) * bflo(t.w) + bfhi(t.w) * bfhi(t.w)); }
                ss += __shfl_xor(ss, 1); ss += __shfl_xor(ss, 2); ss += __shfl_xor(ss, 4);
                const float rstd = rsqrtf(ss * (1.0f / 256.0f) + EPS);
                const float* gn = A.in[8] + (size_t)l * D + head * 256 + 32 * ejj;
                bf16* zo = (bf16*)(F.ws + WS_Z) + (size_t)(t0 + 64 * c + erow) * ZLD + ZCH + head * 256 + 32 * ejj;
#pragma unroll
                for (int m = 0; m < 4; ++m) { const f32x4 g0 = *(const f32x4*)(gn + 8 * m), g1 = *(const f32x4*)(gn + 8 * m + 4);
                    const u32x4 t = *(const LAS u32x4*)(lds + GL_OB + erow * GL_OS + (32 * ejj + 8 * m) * 2);
                    const unsigned tt[4] = {t.x, t.y, t.z, t.w};
                    const unsigned rr[4] = {rraw[m].x, rraw[m].y, rraw[m].z, rraw[m].w}; unsigned ww[4];
#pragma unroll
                    for (int e = 0; e < 4; ++e) { const float ra = bflo(rr[e]), rb = bfhi(rr[e]); const float ga = e < 2 ? g0[2 * e] : g1[2 * e - 4], gb2 = e < 2 ? g0[2 * e + 1] : g1[2 * e - 3];
                        ww[e] = pk2(bflo(tt[e]) * rstd * ga * ra, bfhi(tt[e]) * rstd * gb2 * rb); }
                    *(u32x4*)(zo + 8 * m) = (u32x4){ww[0], ww[1], ww[2], ww[3]}; }
            }
        }
#undef GLA_LOADS
        if (!PASS2 && state) {
            const int w = F.wave, lane = F.lane, d0 = 2 * lane;
            u32x4* sp = (u32x4*)(F.ws + WS_SLOC) + ((size_t)(unit * 8 + w) * 8) * 64 + lane;
#pragma unroll
            for (int i = 0; i < 8; ++i) { const int da = (2 * i) >> 2, ra = (2 * i) & 3, dc = (2 * i + 1) >> 2, rc = (2 * i + 1) & 3;
                sp[i * 64] = (u32x4){pk2(S[da][4 * ra], S[da][4 * ra + 1]), pk2(S[da][4 * ra + 2], S[da][4 * ra + 3]), pk2(S[dc][4 * rc], S[dc][4 * rc + 1]), pk2(S[dc][4 * rc + 2], S[dc][4 * rc + 3])}; }
            if (w == 0) *(f32x2*)(dseg + (size_t)unit * 128 + d0) = (f32x2){__expf(dsum0), __expf(dsum1)};
        }
    }
}

__device__ __forceinline__ void norm2_router_phase(Frame& F, const Args& A, int l, const float* modl) {
    LAS float* GV = (LAS float*)(F.lds); LAS float* SHV = (LAS float*)(F.lds + 4096); LAS float* LG = (LAS float*)(F.lds + 16384);
    LAS int* LCNT = (LAS int*)(F.lds + L_LCNT); LAS int* LBASE = (LAS int*)(F.lds + L_LBASE);
    const bf16* xb = (const bf16*)(F.ws + WS_XB); bf16* hout = (bf16*)(F.ws + WS_H);
    const bf16* wr = (const bf16*)(F.ws + WS_WR) + (size_t)l * 256 * 1024;
    const float* gain = A.in[13] + (size_t)l * D;
    const float* rgb = A.in[15] + l * 8; const float* reb = A.in[17] + l * 64;
    int* ltok = (int*)(F.ws + WS_LTOK); float* lw = (float*)(F.ws + WS_LW); int* route = (int*)(F.ws + WS_ROUTE);
    for (int ch = F.bx; ch < NTOK / 128; ch += F.G) {
        const int b = ch >> 5;
        __syncthreads();
        for (int k = F.tid; k < D; k += NTHR) { GV[k] = gain[k] * (1.0f + modl[(size_t)b * MODW + 4096 + k]); SHV[k] = modl[(size_t)b * MODW + 3072 + k]; }
        if (F.tid < 64) LCNT[F.tid] = 0;
        __syncthreads();
        u32x4 wreg[5];
#define RT_GLOAD(sl) do { _Pragma("unroll") for (int j = 0; j < 5; ++j) { const int u_ = F.tid + NTHR * j; wreg[j] = *(const u32x4*)((const char*)wr + (size_t)(u_ >> 5) * 2048 + (sl) * 512 + (u_ & 31) * 16); } } while (0)
#define RT_LSTORE(bo) do { _Pragma("unroll") for (int j = 0; j < 5; ++j) { const int u_ = F.tid + NTHR * j; *(LAS u32x4*)(F.lds + (bo) + (u_ >> 5) * 528 + (u_ & 31) * 16) = wreg[j]; } } while (0)
        RT_GLOAD(0);
#pragma unroll 1
        for (int g = 0; g < 8; ++g) {
            const int r0 = ch * 128 + F.wave * 16 + g * 2;
            f32x4 v[2][4];
#pragma unroll
            for (int r = 0; r < 2; ++r)
#pragma unroll
                for (int j = 0; j < 4; ++j) { const u32x2 t = *(const u32x2*)(xb + (size_t)(r0 + r) * D + 256 * j + 4 * F.lane); v[r][j] = (f32x4){bflo(t.x), bfhi(t.x), bflo(t.y), bfhi(t.y)}; }
            float rstd[2];
#pragma unroll
            for (int r = 0; r < 2; ++r) { float s = 0.f;
#pragma unroll
                for (int j = 0; j < 4; ++j) s += (v[r][j][0] * v[r][j][0] + v[r][j][1] * v[r][j][1]) + (v[r][j][2] * v[r][j][2] + v[r][j][3] * v[r][j][3]);
                rstd[r] = rsqrtf(wave_sum(s) * (1.0f / D) + EPS); }
#pragma unroll
            for (int j = 0; j < 4; ++j) { const f32x4 gg = *(const LAS f32x4*)(GV + 256 * j + 4 * F.lane), ss = *(const LAS f32x4*)(SHV + 256 * j + 4 * F.lane);
#pragma unroll
                for (int r = 0; r < 2; ++r) { const f32x4 y = v[r][j] * rstd[r] * gg + ss; u32x2 w; w.x = pk2(y[0], y[1]); w.y = pk2(y[2], y[3]);
                    *(u32x2*)(hout + (size_t)(r0 + r) * D + 256 * j + 4 * F.lane) = w; } }
        }
        asm volatile("s_waitcnt vmcnt(0)" ::: "memory");
        {
            const int lr = F.lane & 15, kq = F.lane >> 4;
            const bf16* ap = hout + (size_t)(ch * 128 + F.wave * 16 + lr) * D + 8 * kq;
            constexpr int RB0 = 8192, RB1 = 8192 + 80 * 528;
            f32x4 acc[5];
#pragma unroll
            for (int cb = 0; cb < 5; ++cb) acc[cb] = (f32x4){0.f, 0.f, 0.f, 0.f};
            bf16x8 af[2][8];
#define RT_ALOAD(buf, sl) do { _Pragma("unroll") for (int q = 0; q < 8; ++q) af[buf][q] = *(const bf16x8*)(ap + 256 * (sl) + 32 * q); } while (0)
#define RT_MMA(buf, bo) do { _Pragma("unroll") for (int q = 0; q < 8; ++q) _Pragma("unroll") for (int cb = 0; cb < 5; ++cb) \
                acc[cb] = __builtin_amdgcn_mfma_f32_16x16x32_bf16(af[buf][q], *(const LAS bf16x8*)(F.lds + (bo) + (16 * cb + lr) * 528 + (32 * q + 8 * kq) * 2), acc[cb], 0, 0, 0); } while (0)
            RT_ALOAD(0, 0);
            RT_LSTORE(RB0); RT_GLOAD(1); RT_ALOAD(1, 1); __syncthreads(); RT_MMA(0, RB0);
            RT_LSTORE(RB1); RT_GLOAD(2); RT_ALOAD(0, 2); __syncthreads(); RT_MMA(1, RB1);
            RT_LSTORE(RB0); RT_GLOAD(3); RT_ALOAD(1, 3); __syncthreads(); RT_MMA(0, RB0);
            RT_LSTORE(RB1); __syncthreads(); RT_MMA(1, RB1);
#undef RT_ALOAD
#undef RT_MMA
#undef RT_GLOAD
#undef RT_LSTORE
            __syncthreads();
#pragma unroll
            for (int cb = 0; cb < 5; ++cb)
#pragma unroll
                for (int r = 0; r < 4; ++r) LG[(F.wave * 16 + 4 * kq + r) * 81 + 16 * cb + lr] = acc[cb][r];
        }
        __syncthreads();
        int e0 = 0, e1 = 0, r0 = 0, r1 = 0; float wa = 0.f, wb = 0.f; const int t = ch * 128 + F.tid;
        if (F.tid < 128) {
            const LAS float* lp = LG + F.tid * 81;
            float lg[8];
#pragma unroll
            for (int j = 0; j < 8; ++j) lg[j] = lp[j] + rgb[j];
            float m = lg[0]; int gi = 0;
#pragma unroll
            for (int j = 1; j < 8; ++j) if (lg[j] > m) { m = lg[j]; gi = j; }
            float sum = 0.f;
#pragma unroll
            for (int j = 0; j < 8; ++j) sum += __expf(lg[j] - m);
            const float gw = 1.0f / sum;
            float le[8];
#pragma unroll
            for (int j = 0; j < 8; ++j) le[j] = lp[8 + gi * 8 + j] + reb[gi * 8 + j];
            float m0 = le[0]; int i0 = 0;
#pragma unroll
            for (int j = 1; j < 8; ++j) if (le[j] > m0) { m0 = le[j]; i0 = j; }
            float m1 = -3.0e38f; int i1 = 0;
#pragma unroll
            for (int j = 0; j < 8; ++j) if (j != i0 && le[j] > m1) { m1 = le[j]; i1 = j; }
            const float pr = __expf(m1 - m0);
            wa = gw / (1.0f + pr); wb = gw * pr / (1.0f + pr);
            e0 = gi * 8 + i0; e1 = gi * 8 + i1;
            r0 = __hip_atomic_fetch_add(&LCNT[e0], 1, __ATOMIC_RELAXED, __HIP_MEMORY_SCOPE_WORKGROUP); r1 = __hip_atomic_fetch_add(&LCNT[e1], 1, __ATOMIC_RELAXED, __HIP_MEMORY_SCOPE_WORKGROUP);
        }
        __syncthreads();
        if (F.tid < 64) { const int n = LCNT[F.tid]; LBASE[F.tid] = n ? (int)__hip_atomic_fetch_add(F.ctl + CW_CNT + (l * 64 + F.tid) * 64, (unsigned)n, RLX_AGENT) : 0; }
        __syncthreads();
        if (F.tid < 128) {
            r0 += LBASE[e0]; r1 += LBASE[e1];
            ltok[(size_t)e0 * CAP + r0] = t; lw[(size_t)e0 * CAP + r0] = wa;
            ltok[(size_t)e1 * CAP + r1] = t; lw[(size_t)e1 * CAP + r1] = wb;
            route[2 * t] = (e0 << 16) | r0; route[2 * t + 1] = (e1 << 16) | r1;
        }
    }
    __syncthreads();
}

__device__ __forceinline__ void topk_phase(Frame& F, const Args& A, int l) {
    LAS int* LCNT = (LAS int*)(F.lds + L_LCNT); LAS int* LBASE = (LAS int*)(F.lds + L_LBASE);
    const float* logits = (const float*)(F.ws + WS_LOGITS);
    const float* rgb = A.in[15] + l * 8; const float* reb = A.in[17] + l * 64;
    int* ltok = (int*)(F.ws + WS_LTOK); float* lw = (float*)(F.ws + WS_LW); int* route = (int*)(F.ws + WS_ROUTE);
    for (int ch = F.bx; ch < NTOK / 128; ch += F.G) {
        __syncthreads();
        if (F.tid < 64) LCNT[F.tid] = 0;
        __syncthreads();
        int e0 = 0, e1 = 0, r0 = 0, r1 = 0; float wa = 0.f, wb = 0.f; const int t = ch * 128 + F.tid;
        if (F.tid < 128) {
            const float* lp = logits + (size_t)t * 128;
            float lg[8];
#pragma unroll
            for (int j = 0; j < 8; ++j) lg[j] = lp[j] + rgb[j];
            float m = lg[0]; int gi = 0;
#pragma unroll
            for (int j = 1; j < 8; ++j) if (lg[j] > m) { m = lg[j]; gi = j; }
            float sum = 0.f;
#pragma unroll
            for (int j = 0; j < 8; ++j) sum += __expf(lg[j] - m);
            const float gw = 1.0f / sum;
            float le[8];
#pragma unroll
            for (int j = 0; j < 8; ++j) le[j] = lp[8 + gi * 8 + j] + reb[gi * 8 + j];
            float m0 = le[0]; int i0 = 0;
#pragma unroll
            for (int j = 1; j < 8; ++j) if (le[j] > m0) { m0 = le[j]; i0 = j; }
            float m1 = -3.0e38f; int i1 = 0;
#pragma unroll
            for (int j = 0; j < 8; ++j) if (j != i0 && le[j] > m1) { m1 = le[j]; i1 = j; }
            const float pr = __expf(m1 - m0);
            wa = gw / (1.0f + pr); wb = gw * pr / (1.0f + pr);
            e0 = gi * 8 + i0; e1 = gi * 8 + i1;
            r0 = __hip_atomic_fetch_add(&LCNT[e0], 1, __ATOMIC_RELAXED, __HIP_MEMORY_SCOPE_WORKGROUP); r1 = __hip_atomic_fetch_add(&LCNT[e1], 1, __ATOMIC_RELAXED, __HIP_MEMORY_SCOPE_WORKGROUP);
        }
        __syncthreads();
        if (F.tid < 64) { const int n = LCNT[F.tid]; LBASE[F.tid] = n ? (int)__hip_atomic_fetch_add(F.ctl + CW_CNT + (l * 64 + F.tid) * 64, (unsigned)n, RLX_AGENT) : 0; }
        __syncthreads();
        if (F.tid < 128) {
            r0 += LBASE[e0]; r1 += LBASE[e1];
            ltok[(size_t)e0 * CAP + r0] = t; lw[(size_t)e0 * CAP + r0] = wa;
            ltok[(size_t)e1 * CAP + r1] = t; lw[(size_t)e1 * CAP + r1] = wb;
            route[2 * t] = (e0 << 16) | r0; route[2 * t + 1] = (e1 << 16) | r1;
        }
    }
    __syncthreads();
}

constexpr int NPHASE = 20;

__global__ void __launch_bounds__(NTHR, 2) mega_fwd(Args args) {
    extern __shared__ __attribute__((aligned(16))) unsigned char lds_raw[];
    Frame F;
    F.lds = (LAS unsigned char*)lds_raw;
    F.tid = threadIdx.x; F.lane = F.tid & 63; F.wave = __builtin_amdgcn_readfirstlane(F.tid >> 6);
    F.G = gridDim.x; F.bx = blockIdx.x;
    F.ws = args.ws; F.ctl = (unsigned*)(args.ws + WS_CTL); F.out = args.out;
    for (int u = F.tid; u < (LDS_BYTES - LDSCTL_OFF) / 4; u += NTHR) ((LAS unsigned*)(F.lds + LDSCTL_OFF))[u] = 0u;
    __syncthreads();
    XcdBarrier bar = xcd_barrier_post(F.ctl + CW_BAR, (volatile LAS unsigned*)(F.lds + L_BARW));
    const int lo = args.ph_lo, hi = args.ph_hi;
#ifdef ONLY
#define PHON(k) ((k) == ONLY)
#else
#define PHON(k) true
#endif
#define PHASE_FENCE() do { F.tid = threadIdx.x; asm volatile("" : "+v"(F.tid)); F.lane = F.tid & 63; F.wave = __builtin_amdgcn_readfirstlane(F.tid >> 6); \
    unsigned long long zo_ = 0; unsigned zl_ = 0; asm volatile("" : "+s"(zo_), "+s"(zl_));        \
    F.ws = args.ws + zo_; F.out = args.out + zo_; F.lds = (LAS unsigned char*)lds_raw + zl_; F.bx = blockIdx.x; F.G = gridDim.x; \
    asm volatile("" : "+s"(F.bx), "+s"(F.G)); F.ctl = (unsigned*)(F.ws + WS_CTL); } while (0)
#define IN(k) (lo <= (k) && (k) < hi)
#define SEAM(k) do { if (IN(k) && IN((k) + 1)) xcd_barrier(bar); PHASE_FENCE(); } while (0)

#define Z ((bf16*)(F.ws + WS_Z))
#define H ((bf16*)(F.ws + WS_H))
#define MOD ((const float*)(F.ws + WS_MOD))

    if (PHON(0)) if (IN(0)) { p0_prologue(F, args); }
    SEAM(0);

    for (int l = 0; l < DEPTH; ++l) {
        const int pb = 1 + 9 * l;
#define modl (MOD + (size_t)l * 8 * MODW)
        if (PHON(1)) if (IN(pb + 0)) {
            if (l == 0) {
                {
                    const float* mp = (const float*)(F.ws + WS_MODP); float* mo = (float*)(F.ws + WS_MOD);
                    for (int i = F.bx * NTHR + F.tid; i < 2 * 8 * MODW; i += F.G * NTHR) { float a = args.in[3][(i / (8 * MODW)) * MODW + i % MODW];
#pragma unroll
                        for (int kc = 0; kc < 8; ++kc) a += mp[(size_t)kc * 16 * MODW + i];
                        mo[i] = a; }
                }
                row_phase<false, false, true, false, true, false>(F, args.in[0], nullptr, H, args.in[4], (const float*)(F.ws + WS_MODP), 1024, 0, nullptr, (const float*)(F.ws + WS_WG), (float*)(F.ws + WS_GDN), args.in[3]);
            }
            else { moe_tables(F, l - 1);
                row_phase<true, true, true, false>(F, (const float*)(F.ws + WS_XB), (float*)(F.ws + WS_XB), H, args.in[4] + (size_t)l * D, modl, 1024, 0, MOD + (size_t)(l - 1) * 8 * MODW, (const float*)(F.ws + WS_WG) + (size_t)l * 16 * 1024, (float*)(F.ws + WS_GDN)); }
        }
        SEAM(pb + 0);
        if (PHON(2)) if (IN(pb + 1)) {
            const int rsplit = 1 + 2 * (F.bx & 7);
            const char* aB = (const char*)H; const char* bB = (const char*)((bf16*)(F.ws + WS_WIN) + (size_t)l * 8192 * 1024);
            pg8::EpiZ E{F.ws};
            { pg8::StaticOrder S; S.init(NTOK, 8192, F.G, F.bx, D, D); S.i1 = rsplit;
              pg8::gemm_phase<pg8::EpiZ, pg8::StaticOrder, true>(F.lds, F.tid, aB, bB, D, S, E); }
            __syncthreads();
            convert_experts(F, args, l);
            __syncthreads();
            { asm volatile("" : "+s"(aB), "+s"(bB));
              pg8::StaticOrder S; S.init(NTOK, 8192, F.G, F.bx, D, D); S.i0 = rsplit;
              pg8::gemm_phase<pg8::EpiZ, pg8::StaticOrder, true>(F.lds, F.tid, aB, bB, D, S, E); }
        }
        SEAM(pb + 1);
        if (PHON(3)) if (IN(pb + 2)) {
            if (F.bx & 1) { conv_phase(F, args, l); __syncthreads(); gla_pass<false>(F, args, l); }
            else { gla_pass<false>(F, args, l); __syncthreads(); conv_phase(F, args, l); }
        }
        SEAM(pb + 2);
        if (PHON(4)) if (IN(pb + 3)) { gla_pass<true>(F, args, l); }
        SEAM(pb + 3);
        if (PHON(5)) if (IN(pb + 4)) {
            pg8::StaticOrder S; S.init(NTOK, D, F.G, F.bx, ZLD, WOEP); S.wgm = 8; S.kshift = 4; S.kjump = (size_t)(16 * 128 + (ZCH - ZCB - 1024) * 2);
            pg8::EpiGate2 E{Z + ZGC, Z + ZGA, Z + ZCC, ZLD};
            pg8::gemm_phase<pg8::EpiGate2, pg8::StaticOrder, true, false, true>(F.lds, F.tid, (const char*)(Z + ZCB), (const char*)(F.ws + WS_WO3 + (size_t)l * WO_L), 2048, S, E);
        }
        SEAM(pb + 4);
        if (PHON(6)) if (IN(pb + 5)) {
            pg8::StaticOrder S; S.init(NTOK, D, F.G, F.bx, ZLD, D); S.wgm = 8;
            const char* aF = (const char*)(Z + ZCC); const char* bF = (const char*)(F.ws + WS_WO3 + (size_t)l * WO_L + WO_OUT);
            if (l == 0) { pg8::EpiResid<true> E{args.in[0], nullptr, (bf16*)(F.ws + WS_XB), modl + 2048};
                pg8::gemm_phase<pg8::EpiResid<true>, pg8::StaticOrder, true>(F.lds, F.tid, aF, bF, D, S, E); }
            else { pg8::EpiResid<false> E{nullptr, (const bf16*)(F.ws + WS_XB), (bf16*)(F.ws + WS_XB), modl + 2048};
                pg8::gemm_phase<pg8::EpiResid<false>, pg8::StaticOrder, true>(F.lds, F.tid, aF, bF, D, S, E); }
        }
        SEAM(pb + 5);
        if (PHON(7)) if (IN(pb + 6)) { norm2_router_phase(F, args, l, modl); }
        SEAM(pb + 6);
        if (PHON(10)) if (IN(pb + 7)) {
            moe_tables(F, l); moe_toktab(F);
            pg8::MoeOrder<true> S{F.lds, F.G, F.bx, 2048u};
            pg8::EpiAct E{(bf16*)(F.ws + WS_H1)};
            pg8::gemm_phase<pg8::EpiAct, pg8::MoeOrder<true>, true>(F.lds, F.tid, (const char*)H, (const char*)(F.ws + WS_W13), D, S, E);
        }
        SEAM(pb + 7);
        if (PHON(11)) if (IN(pb + 8)) {
            moe_tables(F, l); moe_wtab(F);
            pg8::MoeOrder<false> S{F.lds, F.G, F.bx, 1024u};
            pg8::EpiYb E{(bf16*)(F.ws + WS_YB), (const float*)(F.ws + WS_LW), F.lds};
            pg8::gemm_phase<pg8::EpiYb, pg8::MoeOrder<false>, true>(F.lds, F.tid, (const char*)(F.ws + WS_H1), (const char*)(F.ws + WS_W2), DEXP, S, E);
        }
        SEAM(pb + 8);
    }
    if (PHON(12)) if (IN(19)) {
        moe_tables(F, DEPTH - 1);
        row_phase<true, false, false, true>(F, (const float*)(F.ws + WS_XB), F.out, nullptr, args.in[21], nullptr, 0, 0, MOD + (size_t)(DEPTH - 1) * 8 * MODW, nullptr, nullptr);
    }
#undef IN
#undef SEAM
#undef Z
#undef H
#undef MOD
#undef modl
}

extern "C" void kernel_launch(void* const* d_in, const int* in_sizes, int n_in, void* d_out, int out_size, void* d_ws, size_t ws_size, hipStream_t stream) {
    static int grid = 0;
    if (grid == 0) {
        if (n_in != 22 || out_size != NTOK * D || ws_size < WS_END) { fprintf(stderr, "kernel_launch: unexpected shapes (n_in %d out %d ws %zu)\n", n_in, out_size, ws_size); grid = -1; return; }
        int dev = 0, cus = 0, per_cu = 0;
        if (hipGetDevice(&dev) != hipSuccess || hipDeviceGetAttribute(&cus, hipDeviceAttributeMultiprocessorCount, dev) != hipSuccess) { grid = -1; return; }
        if (hipFuncSetAttribute((const void*)mega_fwd, hipFuncAttributeMaxDynamicSharedMemorySize, LDS_BYTES) != hipSuccess) { fprintf(stderr, "kernel_launch: hipFuncSetAttribute failed\n"); grid = -1; return; }
        if (hipOccupancyMaxActiveBlocksPerMultiprocessor(&per_cu, (const void*)mega_fwd, NTHR, LDS_BYTES) != hipSuccess || per_cu < 1)
            fprintf(stderr, "kernel_launch: occupancy query reports %d workgroups per CU\n", per_cu);
        (void)hipGetLastError();
        grid = cus;
        if (grid > 256) grid = 256;
    }
    if (grid < 0) return;
    if (hipMemsetAsync((char*)d_ws + WS_CTL, 0, CTL_ZERO_BYTES, stream) != hipSuccess) return;
    Args a{};
    for (int i = 0; i < 22; ++i) a.in[i] = (const float*)d_in[i];
    a.out = (float*)d_out; a.ws = (unsigned char*)d_ws;
#if MK_N_LAUNCHES == 1
    a.ph_lo = 0; a.ph_hi = NPHASE;
    hipLaunchKernelGGL(mega_fwd, dim3(grid), dim3(NTHR), LDS_BYTES, stream, a);
#else
    for (int p = 0; p < NPHASE; ++p) { a.ph_lo = p; a.ph_hi = p + 1; hipLaunchKernelGGL(mega_fwd, dim3(grid), dim3(NTHR), LDS_BYTES, stream, a); }
#endif
}
```

```cpp
#include <hip/hip_runtime.h>
#include <cstdio>
#include <cstdint>

#ifndef MK_N_LAUNCHES
#define MK_N_LAUNCHES 1
#endif

#define GAS __attribute__((address_space(1)))
#define LAS __attribute__((address_space(3)))
typedef unsigned short bf16;
typedef short bf16x8 __attribute__((ext_vector_type(8)));
typedef short s16x4 __attribute__((ext_vector_type(4)));
typedef float f32x4 __attribute__((ext_vector_type(4)));
typedef float f32x2 __attribute__((ext_vector_type(2)));
typedef float f32x16 __attribute__((ext_vector_type(16)));
typedef unsigned u32x4 __attribute__((ext_vector_type(4)));
typedef unsigned u32x2 __attribute__((ext_vector_type(2)));
typedef __bf16 bf16x2_t __attribute__((ext_vector_type(2)));

constexpr int BATCH = 8, SEQ = 4096, D = 1024, NTOK = BATCH * SEQ, DEPTH = 2;
constexpr int ZLD = 5120 + 128;
constexpr int ZCB = 0, ZCC = 1024, ZCH = 2048, ZGA = 3072, ZGC = 4096;
constexpr int INCOLS = 8208, GDN_COL = 2048;
constexpr int NEXP = 64, DEXP = 512, CAP = 32768, MAXROWS = 81920;
constexpr int MODW = 6144;
constexpr float EPS = 1e-6f;
constexpr int NWAVES = 8, NTHR = 512;

constexpr size_t MiB = 1u << 20;
constexpr size_t WS_CTL = 0, CTL_ZERO_BYTES = 1 * MiB;
constexpr size_t WS_MOD = 1 * MiB;
constexpr size_t WS_ROUTE = 2 * MiB;
constexpr size_t WS_GDN = 4 * MiB;
constexpr size_t WS_LTOK = 8 * MiB;
constexpr size_t WS_LW = 16 * MiB;
constexpr size_t WS_WR = 24 * MiB;
constexpr size_t WS_WG = 25 * MiB;
constexpr size_t WS_WIN = 26 * MiB;
constexpr int WOEP = 2048 + 64;
constexpr size_t WO_L = 7 * MiB, WO_OUT = 5 * MiB;
constexpr size_t WS_WO3 = 58 * MiB;
constexpr size_t WS_SLOC = 72 * MiB;
constexpr size_t WS_DSEG = 104 * MiB;
constexpr int AEP = 2048 + 128;
constexpr size_t WS_AE = 106 * MiB;
constexpr size_t WS_W13 = 106 * MiB;
constexpr size_t WS_W2 = 234 * MiB;
constexpr size_t WS_H = 298 * MiB;
constexpr size_t WS_Z = 362 * MiB;
constexpr size_t WS_QH = 690 * MiB, WS_KH = 722 * MiB;
constexpr size_t WS_VH = 754 * MiB, WS_RH = 818 * MiB;
constexpr size_t WS_LOGITS = WS_Z;
constexpr size_t WS_H1 = WS_Z + 16 * MiB;
constexpr size_t WS_YB = WS_Z + 96 * MiB;
constexpr size_t WS_MODP = 884 * MiB;
constexpr size_t WS_EB = 888 * MiB;
constexpr size_t WS_CDEC = 920 * MiB;
constexpr size_t WS_XB = 922 * MiB;
constexpr size_t WS_END = 986 * MiB;
constexpr int CW_BAR = 4096, CW_CNT = 16384;

constexpr int RING_BYTES = 131072;
constexpr int LDSCTL_OFF = RING_BYTES;
constexpr int L_BARW = LDSCTL_OFF + 32;
constexpr int L_TB = LDSCTL_OFF + 64;
constexpr int L_CNT = LDSCTL_OFF + 256;
constexpr int L_PRE = LDSCTL_OFF + 512;
constexpr int L_LCNT = LDSCTL_OFF + 768;
constexpr int L_LBASE = LDSCTL_OFF + 1024;
constexpr int L_MBEI = LDSCTL_OFF + 2048;
constexpr int L_TOKT = LDSCTL_OFF + 4096;
constexpr int LDS_BYTES = 147456;

#define RLX_AGENT __ATOMIC_RELAXED, __HIP_MEMORY_SCOPE_AGENT
#define LDS_WAIT() asm volatile("s_waitcnt lgkmcnt(0)" ::: "memory")
#define VM_WAIT() asm volatile("s_waitcnt vmcnt(0)" ::: "memory")

__device__ __forceinline__ unsigned pk2(float lo, float hi) { bf16x2_t v; v[0] = (__bf16)lo; v[1] = (__bf16)hi; return __builtin_bit_cast(unsigned, v); }
__device__ __forceinline__ float bflo(unsigned u) { return __builtin_bit_cast(float, u << 16); }
__device__ __forceinline__ float bfhi(unsigned u) { return __builtin_bit_cast(float, u & 0xffff0000u); }
__device__ __forceinline__ float fsigmoid(float x) { return __builtin_amdgcn_rcpf(1.0f + __expf(-x)); }
__device__ __forceinline__ float wave_sum(float v) {
#pragma unroll
    for (int o = 1; o < 64; o <<= 1) v += __shfl_xor(v, o);
    return v;
}

#define XB_TMO      128
#define XB_XCNT(j)  (256  + 64 * (j))
#define XB_XSUB(j)  (1280 + 64 * (j))
#define XB_XGEN(j)  (2304 + 64 * (j))
#define XB_TOP      3328
#define XB_TOPGEN   3392
#define XCD_BAR_WORDS 3456
#define XB_SPIN_CAP (1u << 18)

__device__ __forceinline__ unsigned xb_ld(unsigned* p)              { return __hip_atomic_load(p, __ATOMIC_RELAXED, __HIP_MEMORY_SCOPE_AGENT); }
__device__ __forceinline__ unsigned xb_add(unsigned* p, unsigned v) { return __hip_atomic_fetch_add(p, v, __ATOMIC_RELAXED, __HIP_MEMORY_SCOPE_AGENT); }
__device__ __forceinline__ unsigned xb_xcc_id() { return (unsigned)__builtin_amdgcn_s_getreg((3 << 11) | 20) & 0xFu; }
#define XB_SPIN(cond, bar) do { unsigned _sp = 0; while (cond) { __builtin_amdgcn_s_sleep(1); \
    if ((++_sp & 255u) == 0u) { if (xb_ld(&(bar)[XB_TMO])) break; if (_sp > XB_SPIN_CAP) { atomicAdd(&(bar)[XB_TMO], 1u); break; } } } } while (0)

struct XcdBarrier { unsigned* bar; unsigned x; volatile LAS unsigned* st; };

__device__ __forceinline__ XcdBarrier xcd_barrier_post(unsigned* bar, volatile LAS unsigned* st) {
    XcdBarrier b; b.bar = bar; b.x = xb_xcc_id(); b.st = st;
    if (threadIdx.x == 0) (void)xb_add(&bar[XB_XCNT(b.x)], 1u);
    return b;
}
__device__ __forceinline__ void xcd_barrier_complete(unsigned* bar, unsigned x, unsigned& nloc, unsigned& nx) {
    const unsigned G = gridDim.x * gridDim.y * gridDim.z;
    unsigned sum, cnt, mine, sp = 0u;
    for (;;) {
        sum = 0u; cnt = 0u; mine = 0u;
#pragma unroll
        for (unsigned j = 0; j < 16; ++j) { const unsigned c = xb_ld(&bar[XB_XCNT(j)]); sum += c; cnt += (c > 0u) ? 1u : 0u; mine = (j == x) ? c : mine; }
        if (sum == G) break;
        __builtin_amdgcn_s_sleep(1);
        if ((++sp & 255u) == 0u) { if (xb_ld(&bar[XB_TMO])) break; if (sp > XB_SPIN_CAP) { atomicAdd(&bar[XB_TMO], 1u); break; } }
    }
    nloc = mine > 0u ? mine : 1u; nx = cnt > 0u ? cnt : 1u;
}
__device__ __forceinline__ void xcd_barrier(const XcdBarrier& b) {
    asm volatile("s_waitcnt vmcnt(0)" ::: "memory");
    __syncthreads();
    if (threadIdx.x == 0) {
        unsigned* bar = b.bar;
        __builtin_amdgcn_s_waitcnt(0);
        unsigned nloc = b.st[0], nx = b.st[1];
        if (nloc == 0u) { xcd_barrier_complete(bar, b.x, nloc, nx); b.st[0] = nloc; b.st[1] = nx; }
        const unsigned old = xb_add(&bar[XB_XSUB(b.x)], 1u);
        const unsigned gen = old / nloc;
        if (old + 1u == (gen + 1u) * nloc) {
            __builtin_amdgcn_fence(__ATOMIC_RELEASE, "agent");
            asm volatile("s_waitcnt vmcnt(0)" ::: "memory");
            const unsigned og = xb_add(&bar[XB_TOP], 1u);
            const unsigned tg = og / nx;
            if (og + 1u == (tg + 1u) * nx) xb_add(&bar[XB_TOPGEN], 1u);
            else XB_SPIN(xb_ld(&bar[XB_TOPGEN]) == tg, bar);
            __builtin_amdgcn_fence(__ATOMIC_ACQUIRE, "agent");
            xb_add(&bar[XB_XGEN(b.x)], 1u);
            asm volatile("s_waitcnt vmcnt(0)" ::: "memory");
        } else {
            XB_SPIN(xb_ld(&bar[XB_XGEN(b.x)]) == gen, bar);
            __builtin_amdgcn_fence(__ATOMIC_ACQUIRE, "agent");
            asm volatile("s_waitcnt vmcnt(0)" ::: "memory");
        }
    }
    __syncthreads();
}

namespace pg8 {
constexpr int BM = 256, BK = 64, HALF = 128, HTB = HALF * BK * 2, STAGE_BYTES = 8 * HTB, NXCD = 8, WGM = 4;
__host__ __device__ __forceinline__ int lds_byte(int r, int c) { const int st = (r >> 4) * 2 + (c >> 5), rr = r & 15, cc = c & 31, ob = rr * 64 + cc * 2; return st * 1024 + (ob ^ (((ob >> 9) & 1) << 5)); }
__host__ __device__ __forceinline__ void stage_rc(int b, int& R, int& C) { const int st = b / 1024, sb = b % 1024, swz = sb ^ (((sb >> 9) & 1) << 5); R = (st >> 1) * 16 + swz / 64; C = (st & 1) * 32 + (swz % 64) / 2; }
__host__ __device__ __forceinline__ int perm32(int rho) { const int n = rho >> 4, i = rho & 15; return 8 * (i >> 2) + 4 * n + (i & 3); }

struct Unit { int pm, pn, e, mi, slot; };

struct StaticOrder {
    int nM, nN, nwg, G, c; unsigned lda2; unsigned ldb2;
    int wgm = WGM;
    int i0 = 0, i1 = 1 << 30;
    int kshift = 30; size_t kjump = 0; bool headA = false;
    __device__ void init(int M, int N, int G_, int c_, int lda, int ldb) { nM = M / BM; nN = N / BM; nwg = nM * nN; G = G_; c = c_; lda2 = (unsigned)lda * 2u; ldb2 = (unsigned)ldb * 2u; }
    __device__ void init_head(int M, int N, int G_, int c_, int ldb) { init(M, N, G_, c_, 256, ldb); kshift = 2; kjump = (size_t)SEQ * 512; headA = true; }
    __device__ __forceinline__ size_t kbyte(int kt) const { return (size_t)(kt & ((1 << kshift) - 1)) * 128 + (size_t)(kt >> kshift) * kjump; }
    __device__ bool next(int i, Unit& u) const {
        if (i0 + i >= i1) return false;
        const long L = (long)(i0 + i) * G + c; if (L >= nwg) return false;
        int wgid = (int)L; { const int q = nwg / NXCD, r = nwg % NXCD, xcd = wgid % NXCD, off = wgid / NXCD; wgid = (xcd < r ? xcd * (q + 1) : r * (q + 1) + (xcd - r) * q) + off; }
        const int nig = wgm * nN, gid = wgid / nig, fm = gid * wgm, gsz = (nM - fm) < wgm ? (nM - fm) : wgm;
        u.pm = fm + ((wgid % nig) % gsz); u.pn = (wgid % nig) / gsz; u.e = 0; u.mi = 0; u.slot = 0; return true;
    }
    static constexpr bool GATHER_A = false;
    __device__ __forceinline__ void a_off(const Unit& u, int ui, const int (&R)[2], const int (&C)[2], unsigned (&vo)[2][2]) const {}
    __device__ __forceinline__ size_t a_base(const Unit& u) const { return headA ? ((size_t)(u.pm >> 4) * 4 * SEQ + (size_t)(u.pm & 15) * BM) * 512 : (size_t)u.pm * BM * lda2; }
    __device__ __forceinline__ size_t b_off(const Unit& u) const { return (size_t)u.pn * BM * ldb2; }
    __device__ __forceinline__ unsigned ldb_bytes() const { return ldb2; }
    __device__ __forceinline__ unsigned lda_bytes() const { return lda2; }
};

template <bool GATHER> struct MoeOrder {
    LAS unsigned char* lds; int G, c; unsigned ldb2;
    __device__ bool next(int i, Unit& u) const {
        const int TB = *(const LAS int*)(lds + L_TB);
        const int mb = i * 64 + (c & 7) * 8 + (c >> 5);
        if (mb >= TB) return false;
        const int ei = ((const LAS int*)(lds + L_MBEI))[mb];
        u.pm = mb; u.pn = (c >> 3) & 3; u.e = ei >> 16; u.mi = ei & 0xffff; u.slot = i & 7; return true;
    }
    static constexpr bool GATHER_A = GATHER;
    __device__ __forceinline__ void a_off(const Unit& u, int ui, const int (&R)[2], const int (&C)[2], unsigned (&vo)[2][2]) const {
#pragma unroll
        for (int h = 0; h < 2; ++h)
#pragma unroll
            for (int i = 0; i < 2; ++i) { const int tok = ((const LAS int*)(lds + L_TOKT))[(ui & 7) * 256 + h * HALF + R[i]]; vo[h][i] = (unsigned)tok * 2048u + (unsigned)C[i] * 2u; }
    }
    __device__ __forceinline__ size_t a_base(const Unit& u) const { return (size_t)u.pm * BM * 1024u; }
    __device__ __forceinline__ size_t b_off(const Unit& u) const { return ((size_t)u.e * 1024 + (size_t)u.pn * BM) * ldb2; }
    __device__ __forceinline__ unsigned ldb_bytes() const { return ldb2; }
    __device__ __forceinline__ unsigned lda_bytes() const { return GATHER ? 2048u : 1024u; }
    __device__ __forceinline__ size_t kbyte(int kt) const { return (size_t)kt * 128; }
};

template <class Epi, class Sched, bool ALIGN_EPI, bool DEFER = false, bool RESC = false>
__device__ __forceinline__ void gemm_phase(LAS unsigned char* lds, int tid, const char* Abase, const char* Bbase, int K, const Sched& S, const Epi& E) {
    constexpr bool GATHER = Sched::GATHER_A;
    const int wid = __builtin_amdgcn_readfirstlane(tid >> 6), lane = tid & 63, wr = wid >> 2, wc = wid & 3, fr = lane & 15, fq = lane >> 4;
    const int nt = K / BK;
    int Rs[2], Cs[2]; unsigned voffB[2], voffA[2];
    const unsigned ldb2 = S.ldb_bytes(), lda2 = S.lda_bytes();
#pragma unroll
    for (int i = 0; i < 2; ++i) { int R, C; stage_rc(tid * 16 + i * 8192, R, C); Rs[i] = R; Cs[i] = C; const int Rb = Epi::PERM ? ((R & ~31) + perm32(R & 31)) : R;
        voffB[i] = (unsigned)Rb * ldb2 + (unsigned)C * 2u; voffA[i] = (unsigned)R * lda2 + (unsigned)C * 2u; }
    const size_t kstep = (size_t)(BK * 2);
    const size_t hstepB = (size_t)HALF * ldb2, hstepA = (size_t)HALF * lda2;
    const unsigned ldsw = (unsigned)wid * 1024u;
    const int aoff = lds_byte(wr * 64 + fr, fq * 8), boff = lds_byte(wc * 32 + fr, fq * 8);
#define PG8_SA(b, h) (((b) * 2 + (h)) * HTB)
#define PG8_SB(b, h) ((4 + (b) * 2 + (h)) * HTB)
#define PG8_STAGE(bufoff, gbase, v0, v1) do { \
        __builtin_amdgcn_global_load_lds((const unsigned*)((const char*)(gbase) + (v0)), (LAS unsigned*)(lds + (bufoff) + ldsw), 16, 0, 0); \
        __builtin_amdgcn_global_load_lds((const unsigned*)((const char*)(gbase) + (v1)), (LAS unsigned*)(lds + (bufoff) + ldsw + 8192), 16, 0, 0); } while (0)
#define PG8_STAGEB(bufoff, gbase) PG8_STAGE(bufoff, gbase, voffB[0], voffB[1])
#define PG8_STAGEA(bufoff, kb, h, nx) do { if constexpr (GATHER) { const unsigned o0_ = (nx) ? vN[h][0] : vA[h][0], o1_ = (nx) ? vN[h][1] : vA[h][1]; PG8_STAGE(bufoff, Abase + (kb), o0_, o1_); } \
        else { const char* p_ = Abase + ((nx) ? uN : uA) + (kb) + (h) * hstepA; PG8_STAGE(bufoff, p_, voffA[0], voffA[1]); } } while (0)
#define PG8_LDA(dst, b, h) do { _Pragma("unroll") for (int m = 0; m < 4; ++m) _Pragma("unroll") for (int k = 0; k < 2; ++k) dst[m][k] = *(const LAS bf16x8*)(lds + PG8_SA(b, h) + aoff + m * 2048 + k * 1024); } while (0)
#define PG8_LDB(dst, b, h) do { _Pragma("unroll") for (int n = 0; n < 2; ++n) _Pragma("unroll") for (int k = 0; k < 2; ++k) dst[n][k] = *(const LAS bf16x8*)(lds + PG8_SB(b, h) + boff + n * 2048 + k * 1024); } while (0)
#define PG8_MMA(ai, bj, At, Bt) do { __builtin_amdgcn_s_setprio(1); _Pragma("unroll") for (int m = 0; m < 4; ++m) _Pragma("unroll") for (int n = 0; n < 2; ++n) _Pragma("unroll") for (int k = 0; k < 2; ++k) \
        acc[ai][bj][m][n] = __builtin_amdgcn_mfma_f32_16x16x32_bf16(Bt[n][k], At[m][k], acc[ai][bj][m][n], 0, 0, 0); __builtin_amdgcn_s_setprio(0); } while (0)
#define PG8_WAIT_V(n) asm volatile("s_waitcnt vmcnt(" #n ")" ::: "memory")
#define PG8_WAIT_L(n) asm volatile("s_waitcnt lgkmcnt(" #n ")" ::: "memory")
#define PG8_BAR __builtin_amdgcn_s_barrier()
#define PG8_SCHED __builtin_amdgcn_sched_barrier(0)
    Unit cur, nxt, prv; int ui = 0;
    if (!S.next(0, cur)) return;
    prv = cur;
    f32x4 acc[2][2][4][2];
#pragma unroll
    for (int a = 0; a < 2; ++a)
#pragma unroll
        for (int b = 0; b < 2; ++b)
#pragma unroll
            for (int m = 0; m < 4; ++m)
#pragma unroll
                for (int n = 0; n < 2; ++n) acc[a][b][m][n] = (f32x4){0.f, 0.f, 0.f, 0.f};
    bf16x8 At[4][2], B0[2][2], B1[2][2];
    unsigned vA[2][2], vN[2][2]; size_t uA = 0, uN = 0;
    if constexpr (GATHER) S.a_off(cur, 0, Rs, Cs, vA); else uA = S.a_base(cur);
    const char* cB = Bbase + S.b_off(cur);
    PG8_STAGEB(PG8_SB(0, 0), cB); PG8_STAGEB(PG8_SB(0, 1), cB + hstepB); PG8_STAGEA(PG8_SA(0, 0), 0, 0, false); PG8_STAGEA(PG8_SA(0, 1), 0, 1, false);
    if (wr == 1) PG8_BAR;
    PG8_WAIT_V(2); PG8_BAR;
    PG8_STAGEB(PG8_SB(1, 0), cB + kstep); PG8_STAGEA(PG8_SA(1, 0), kstep, 0, false); PG8_STAGEB(PG8_SB(1, 1), cB + hstepB + kstep);
    PG8_WAIT_V(6); PG8_BAR;
    for (;;) {
        const bool has_next = S.next(ui + 1, nxt);
        if constexpr (GATHER) {
            if (has_next) S.a_off(nxt, ui + 1, Rs, Cs, vN);
            else {
#pragma unroll
                for (int h = 0; h < 2; ++h)
#pragma unroll
                    for (int i = 0; i < 2; ++i) vN[h][i] = vA[h][i];
            }
        } else uN = has_next ? S.a_base(nxt) : uA;
        const char* nB = has_next ? Bbase + S.b_off(nxt) : cB;
#define PG8_WAITX(n16, n32) do { if constexpr (Epi::NST == 16) PG8_WAIT_V(n16); else PG8_WAIT_V(n32); } while (0)
#define PG8_ZERO(ai) do { _Pragma("unroll") for (int b_ = 0; b_ < 2; ++b_) _Pragma("unroll") for (int m_ = 0; m_ < 4; ++m_) _Pragma("unroll") for (int n_ = 0; n_ < 2; ++n_) acc[ai][b_][m_][n_] = (f32x4){0.f, 0.f, 0.f, 0.f}; } while (0)
#define PG8_BODY(EPI) do { \
            asm volatile("" : "+v"(voffB[0]), "+v"(voffB[1]), "+v"(voffA[0]), "+v"(voffA[1]));     \
            const bool last = (t == nt - 2); \
            const size_t k1 = S.kbyte(t + 1), k2 = last ? 0 : S.kbyte(t + 2), k3 = last ? kstep : S.kbyte(t + 3); \
            const char* b2 = last ? nB : cB + (size_t)(t + 2) * kstep; const char* b3 = b2 + kstep; \
              \
            PG8_LDB(B0, 0, 0); PG8_LDB(B1, 0, 1); PG8_SCHED; PG8_LDA(At, 0, 0); PG8_STAGEA(PG8_SA(1, 1), k1, 1, false); \
            if constexpr (EPI) { PG8_SCHED; int fr_ = fr, fq_ = fq; asm volatile("" : "+v"(fr_), "+v"(fq_)); E.template run<0, 1>(acc, prv, wr, wc, fr_, fq_); PG8_ZERO(0); PG8_SCHED; PG8_WAITX(16, 24); } else PG8_WAIT_V(8); \
            PG8_WAIT_L(0); PG8_BAR; PG8_MMA(0, 0, At, B0); PG8_MMA(0, 1, At, B1); PG8_BAR; PG8_SCHED; \
              \
            PG8_LDA(At, 0, 1); PG8_STAGEB(PG8_SB(0, 0), b2); PG8_STAGEB(PG8_SB(0, 1), b2 + hstepB); PG8_STAGEA(PG8_SA(0, 0), k2, 0, last); \
            if constexpr (EPI) { PG8_SCHED; int fr_ = fr, fq_ = fq; asm volatile("" : "+v"(fr_), "+v"(fq_)); E.template run<1, 2>(acc, prv, wr, wc, fr_, fq_); PG8_ZERO(1); PG8_SCHED; PG8_WAITX(24, 40); } else PG8_WAIT_V(8); \
            PG8_WAIT_L(0); PG8_BAR; PG8_MMA(1, 0, At, B0); PG8_MMA(1, 1, At, B1); PG8_BAR; PG8_SCHED; \
              \
            PG8_LDB(B0, 1, 0); PG8_LDB(B1, 1, 1); PG8_SCHED; PG8_LDA(At, 1, 0); PG8_STAGEA(PG8_SA(0, 1), k2, 1, last); \
            if constexpr (EPI) PG8_WAITX(24, 40); else PG8_WAIT_V(8); \
            PG8_WAIT_L(0); PG8_BAR; PG8_MMA(0, 0, At, B0); PG8_MMA(0, 1, At, B1); PG8_BAR; PG8_SCHED; \
              \
            PG8_LDA(At, 1, 1); PG8_STAGEB(PG8_SB(1, 0), b3); PG8_STAGEB(PG8_SB(1, 1), b3 + hstepB); PG8_STAGEA(PG8_SA(1, 0), k3, 0, last); \
            if constexpr (EPI) PG8_WAITX(16, 24); else PG8_WAIT_V(8); \
            PG8_WAIT_L(0); PG8_BAR; PG8_MMA(1, 0, At, B0); PG8_MMA(1, 1, At, B1); PG8_BAR; PG8_SCHED; \
        } while (0)
        if constexpr (DEFER) {
            int t = 0;
            PG8_BODY(true);
            for (t = 2; t < nt; t += 2) PG8_BODY(false);
        } else if constexpr (RESC) {
            for (int t = 0; t < nt / 2; t += 2) PG8_BODY(false);
            { int fr_ = fr, fq_ = fq; asm volatile("" : "+v"(fr_), "+v"(fq_)); E.rescale(acc, cur, wr, wc, fr_, fq_); }
            for (int t = nt / 2; t < nt; t += 2) PG8_BODY(false);
        } else {
            for (int t = 0; t < nt; t += 2) PG8_BODY(false);
        }
        if (!DEFER || !has_next) {
            if constexpr (ALIGN_EPI) { if (wr == 0) PG8_BAR; }
            { int fr_ = fr, fq_ = fq; asm volatile("" : "+v"(fr_), "+v"(fq_)); E.template run<0, 2>(acc, cur, wr, wc, fr_, fq_); }
            if (!has_next) break;
            PG8_ZERO(0); PG8_ZERO(1);
            if constexpr (ALIGN_EPI) { if (wr == 1) PG8_BAR; }
        }
        prv = cur;
        cur = nxt; cB = nB; ++ui; uA = uN;
        if constexpr (GATHER) {
#pragma unroll
            for (int h = 0; h < 2; ++h)
#pragma unroll
                for (int i = 0; i < 2; ++i) vA[h][i] = vN[h][i];
        }
    }
    PG8_WAIT_V(0);
    if constexpr (!ALIGN_EPI) { if (wr == 0) PG8_BAR; }
    PG8_BAR;
#undef PG8_SA
#undef PG8_SB
#undef PG8_STAGE
#undef PG8_STAGEA
#undef PG8_STAGEB
#undef PG8_LDA
#undef PG8_LDB
#undef PG8_MMA
#undef PG8_WAIT_V
#undef PG8_WAITX
#undef PG8_ZERO
#undef PG8_BODY
#undef PG8_WAIT_L
#undef PG8_BAR
#undef PG8_SCHED
}

typedef const f32x4 (&AccRef)[2][2][4][2];

struct EpiZ {
    static constexpr bool PERM = true; static constexpr int NST = 16;
    unsigned char* ws;
    template <int A0, int A1> __device__ __forceinline__ void run(AccRef acc, const Unit& u, int wr, int wc, int fr, int fq) const {
        const int b = u.pm >> 4, tl = (u.pm & 15) * BM + wr * 64 + fr;
        char* base; unsigned off0, rowp, bjs;
        if (u.pn < 4) { base = (char*)ws + (u.pn < 2 ? WS_QH : WS_KH);
            off0 = ((unsigned)((b * 4 + (u.pn & 1) * 2) * SEQ + tl) * 128u + (unsigned)(wc * 32 + 8 * fq)) * 2u; rowp = 256u; bjs = (unsigned)SEQ * 256u; }
        else if (u.pn < 12) { base = (char*)ws + (u.pn < 8 ? WS_VH : WS_RH);
            off0 = ((unsigned)((b * 4 + ((u.pn - 4) & 3)) * SEQ + tl) * 256u + (unsigned)(wc * 32 + 8 * fq)) * 2u; rowp = 512u; bjs = 256u; }
        else if (u.pn >= 16 && u.pn < 24) {
            const unsigned o0 = ((unsigned)(u.pm * BM + wr * 64 + fr) * (unsigned)ZLD + (unsigned)(ZCC + (u.pn - 16) * 128 + wc * 16 + 4 * fq)) * 2u; char* zb = (char*)ws + WS_Z;
#pragma unroll
            for (int ai = A0; ai < A1; ++ai)
#pragma unroll
                for (int m = 0; m < 4; ++m)
#pragma unroll
                    for (int bj = 0; bj < 2; ++bj) { const f32x4 a = acc[ai][bj][m][0], b2 = acc[ai][bj][m][1];
                        u32x2 w; w.x = pk2(a[0] * b2[0], a[1] * b2[1]); w.y = pk2(a[2] * b2[2], a[3] * b2[3]);
                        *(u32x2*)(zb + (o0 + (unsigned)(ai * HALF + m * 16) * (unsigned)(ZLD * 2) + (unsigned)(bj * 128))) = w; }
            return; }
        else { base = (char*)ws + WS_Z;
            const int zc = u.pn < 16 ? ZCB + (u.pn - 12) * BM : ZGA + (u.pn - 24) * BM;
            off0 = ((unsigned)(u.pm * BM + wr * 64 + fr) * (unsigned)ZLD + (unsigned)(zc + wc * 32 + 8 * fq)) * 2u; rowp = (unsigned)ZLD * 2u; bjs = 256u; }
#pragma unroll
        for (int ai = A0; ai < A1; ++ai)
#pragma unroll
            for (int m = 0; m < 4; ++m) { const unsigned ro = off0 + (unsigned)(ai * HALF + m * 16) * rowp;
#pragma unroll
                for (int bj = 0; bj < 2; ++bj) { f32x4 v0 = acc[ai][bj][m][0], v1 = acc[ai][bj][m][1];
                    if (u.pn >= 24) {
#pragma unroll
                        for (int j = 0; j < 4; ++j) { v0[j] = fsigmoid(v0[j]); v1[j] = fsigmoid(v1[j]); } }
                    else if (u.pn >= 8 && u.pn < 12) {
#pragma unroll
                        for (int j = 0; j < 4; ++j) { v0[j] = v0[j] * fsigmoid(v0[j]); v1[j] = v1[j] * fsigmoid(v1[j]); } }
                    u32x4 w; w.x = pk2(v0[0], v0[1]); w.y = pk2(v0[2], v0[3]); w.z = pk2(v1[0], v1[1]); w.w = pk2(v1[2], v1[3]);
                    *(u32x4*)(base + (ro + (unsigned)bj * bjs)) = w; } }
    }
};
template <bool FIRST> struct EpiGate {
    static constexpr bool PERM = true; static constexpr int NST = 16;
    const bf16* Gt; bf16* Y; int ldc;
    template <int A0, int A1> __device__ __forceinline__ void run(AccRef acc, const Unit& u, int wr, int wc, int fr, int fq) const {
        const unsigned off0 = ((unsigned)(u.pm * BM + wr * 64 + fr) * (unsigned)ldc + (unsigned)(u.pn * BM + wc * 32 + 8 * fq)) * 2u;
        const char* gb = (const char*)Gt; char* yb = (char*)Y;
#pragma unroll
        for (int ai = A0; ai < A1; ++ai)
#pragma unroll
            for (int mp = 0; mp < 2; ++mp) {
                u32x4 g[2][2], p[2][2];
#pragma unroll
                for (int mm = 0; mm < 2; ++mm)
#pragma unroll
                    for (int bj = 0; bj < 2; ++bj) { const unsigned ro = off0 + (unsigned)(ai * HALF + (2 * mp + mm) * 16) * (unsigned)ldc * 2u + (unsigned)(bj * 256);
                        g[mm][bj] = *(const u32x4*)(gb + ro); if (!FIRST) p[mm][bj] = *(const u32x4*)(yb + ro); }
#pragma unroll
                for (int mm = 0; mm < 2; ++mm)
#pragma unroll
                    for (int bj = 0; bj < 2; ++bj) { const int m = 2 * mp + mm; const f32x4 v0 = acc[ai][bj][m][0], v1 = acc[ai][bj][m][1]; const u32x4 gg = g[mm][bj];
                        float y[8];
                        y[0] = bflo(gg.x) * v0[0]; y[1] = bfhi(gg.x) * v0[1]; y[2] = bflo(gg.y) * v0[2]; y[3] = bfhi(gg.y) * v0[3];
                        y[4] = bflo(gg.z) * v1[0]; y[5] = bfhi(gg.z) * v1[1]; y[6] = bflo(gg.w) * v1[2]; y[7] = bfhi(gg.w) * v1[3];
                        if (!FIRST) { const u32x4 pp = p[mm][bj];
                            y[0] += bflo(pp.x); y[1] += bfhi(pp.x); y[2] += bflo(pp.y); y[3] += bfhi(pp.y); y[4] += bflo(pp.z); y[5] += bfhi(pp.z); y[6] += bflo(pp.w); y[7] += bfhi(pp.w); }
                        u32x4 w; w.x = pk2(y[0], y[1]); w.y = pk2(y[2], y[3]); w.z = pk2(y[4], y[5]); w.w = pk2(y[6], y[7]);
                        const unsigned ro = off0 + (unsigned)(ai * HALF + m * 16) * (unsigned)ldc * 2u + (unsigned)(bj * 256);
                        *(u32x4*)(yb + ro) = w; }
                asm volatile("" ::: "memory");
            }
    }
};
struct EpiGate2 {
    static constexpr bool PERM = true; static constexpr int NST = 16;
    const bf16* SA; const bf16* SC; bf16* Y; int ldc;
    typedef f32x4 (&AccMut)[2][2][4][2];
    __device__ __forceinline__ void rescale(AccMut acc, const Unit& u, int wr, int wc, int fr, int fq) const {
        const unsigned off0 = ((unsigned)(u.pm * BM + wr * 64 + fr) * (unsigned)ldc + (unsigned)(u.pn * BM + wc * 32 + 8 * fq)) * 2u;
        const char* ab = (const char*)SA; const char* cb = (const char*)SC;
#pragma unroll
        for (int ai = 0; ai < 2; ++ai)
#pragma unroll
            for (int mp = 0; mp < 2; ++mp) {
                u32x4 ga[2][2], gc[2][2];
#pragma unroll
                for (int mm = 0; mm < 2; ++mm)
#pragma unroll
                    for (int bj = 0; bj < 2; ++bj) { const unsigned ro = off0 + (unsigned)(ai * HALF + (2 * mp + mm) * 16) * (unsigned)ldc * 2u + (unsigned)(bj * 256);
                        ga[mm][bj] = *(const u32x4*)(ab + ro); gc[mm][bj] = *(const u32x4*)(cb + ro); }
#pragma unroll
                for (int mm = 0; mm < 2; ++mm)
#pragma unroll
                    for (int bj = 0; bj < 2; ++bj) { const int m = 2 * mp + mm; const u32x4 a = ga[mm][bj], c = gc[mm][bj];
                        f32x4 r0, r1;
#define RC_(x) __builtin_amdgcn_rcpf(fmaxf((x), 1e-30f))
                        r0[0] = bflo(a.x) * RC_(bflo(c.x)); r0[1] = bfhi(a.x) * RC_(bfhi(c.x)); r0[2] = bflo(a.y) * RC_(bflo(c.y)); r0[3] = bfhi(a.y) * RC_(bfhi(c.y));
                        r1[0] = bflo(a.z) * RC_(bflo(c.z)); r1[1] = bfhi(a.z) * RC_(bfhi(c.z)); r1[2] = bflo(a.w) * RC_(bflo(c.w)); r1[3] = bfhi(a.w) * RC_(bfhi(c.w));
#undef RC_
                        acc[ai][bj][m][0] = acc[ai][bj][m][0] * r0; acc[ai][bj][m][1] = acc[ai][bj][m][1] * r1; }
                asm volatile("" ::: "memory");
            }
    }
    template <int A0, int A1> __device__ __forceinline__ void run(AccRef acc, const Unit& u, int wr, int wc, int fr, int fq) const {
        const unsigned off0 = ((unsigned)(u.pm * BM + wr * 64 + fr) * (unsigned)ldc + (unsigned)(u.pn * BM + wc * 32 + 8 * fq)) * 2u;
        const char* cb = (const char*)SC; char* yb = (char*)Y;
#pragma unroll
        for (int ai = A0; ai < A1; ++ai) {
            u32x4 gc[4][2];
#pragma unroll
            for (int m = 0; m < 4; ++m)
#pragma unroll
                for (int bj = 0; bj < 2; ++bj) gc[m][bj] = *(const u32x4*)(cb + (off0 + (unsigned)(ai * HALF + m * 16) * (unsigned)ldc * 2u + (unsigned)(bj * 256)));
#pragma unroll
            for (int m = 0; m < 4; ++m)
#pragma unroll
                for (int bj = 0; bj < 2; ++bj) { const f32x4 v0 = acc[ai][bj][m][0], v1 = acc[ai][bj][m][1]; const u32x4 c = gc[m][bj];
                    u32x4 w; w.x = pk2(bflo(c.x) * v0[0], bfhi(c.x) * v0[1]); w.y = pk2(bflo(c.y) * v0[2], bfhi(c.y) * v0[3]); w.z = pk2(bflo(c.z) * v1[0], bfhi(c.z) * v1[1]); w.w = pk2(bflo(c.w) * v1[2], bfhi(c.w) * v1[3]);
                    *(u32x4*)(yb + (off0 + (unsigned)(ai * HALF + m * 16) * (unsigned)ldc * 2u + (unsigned)(bj * 256))) = w; }
            asm volatile("" ::: "memory");
        }
    }
};
template <bool XF32> struct EpiResid {
    static constexpr bool PERM = true; static constexpr int NST = 16;
    const float* xin32; const bf16* xin16; bf16* xout; const float* g1;
    template <int A0, int A1> __device__ __forceinline__ void run(AccRef acc, const Unit& u, int wr, int wc, int fr, int fq) const {
        const unsigned e0 = (unsigned)(u.pm * BM + wr * 64 + fr) * (unsigned)D + (unsigned)(u.pn * BM + wc * 32 + 8 * fq);
        const float* gp = g1 + (size_t)(u.pm >> 4) * MODW + (u.pn * BM + wc * 32 + 8 * fq);
        f32x4 gv[2][2];
#pragma unroll
        for (int bj = 0; bj < 2; ++bj)
#pragma unroll
            for (int n = 0; n < 2; ++n) gv[bj][n] = *(const f32x4*)(gp + bj * HALF + n * 4);
        if constexpr (!XF32) {
            constexpr int NB = (A1 - A0) * 2;
            u32x4 xr[2][2][2];
#define ER_LD(buf, q) do { _Pragma("unroll") for (int mm = 0; mm < 2; ++mm) _Pragma("unroll") for (int bj = 0; bj < 2; ++bj) \
                xr[buf][mm][bj] = *(const u32x4*)((const char*)xin16 + (e0 + (unsigned)((A0 + ((q) >> 1)) * HALF + (2 * ((q) & 1) + mm) * 16) * (unsigned)D + (unsigned)(bj * HALF)) * 2u); } while (0)
            ER_LD(0, 0);
#pragma unroll
            for (int q = 0; q < NB; ++q) {
                if (q + 1 < NB) { if ((q & 1) == 0) ER_LD(1, q + 1); else ER_LD(0, q + 1); }
                const int ai = A0 + (q >> 1), mp = q & 1;
#pragma unroll
                for (int mm = 0; mm < 2; ++mm)
#pragma unroll
                    for (int bj = 0; bj < 2; ++bj) { const int m = 2 * mp + mm; const unsigned eo = e0 + (unsigned)(ai * HALF + m * 16) * (unsigned)D + (unsigned)(bj * HALF); const u32x4 t = xr[q & 1][mm][bj];
                        const f32x4 x0 = (f32x4){bflo(t.x), bfhi(t.x), bflo(t.y), bfhi(t.y)}, x1 = (f32x4){bflo(t.z), bfhi(t.z), bflo(t.w), bfhi(t.w)};
                        const f32x4 y0 = x0 + gv[bj][0] * acc[ai][bj][m][0], y1 = x1 + gv[bj][1] * acc[ai][bj][m][1];
                        u32x4 w; w.x = pk2(y0[0], y0[1]); w.y = pk2(y0[2], y0[3]); w.z = pk2(y1[0], y1[1]); w.w = pk2(y1[2], y1[3]);
                        *(u32x4*)((char*)xout + eo * 2u) = w; }
                asm volatile("" ::: "memory");
            }
#undef ER_LD
            return;
        }
#pragma unroll
        for (int ai = A0; ai < A1; ++ai)
#pragma unroll
            for (int mp = 0; mp < 2; ++mp) {
                f32x4 xv[2][2][2];
#pragma unroll
                for (int mm = 0; mm < 2; ++mm)
#pragma unroll
                    for (int bj = 0; bj < 2; ++bj) { const unsigned eo = e0 + (unsigned)(ai * HALF + (2 * mp + mm) * 16) * (unsigned)D + (unsigned)(bj * HALF);
                        if (XF32) { xv[mm][bj][0] = *(const f32x4*)((const char*)xin32 + eo * 4u); xv[mm][bj][1] = *(const f32x4*)((const char*)xin32 + (eo * 4u + 16u)); }
                        else { const u32x4 t = *(const u32x4*)((const char*)xin16 + eo * 2u);
                            xv[mm][bj][0] = (f32x4){bflo(t.x), bfhi(t.x), bflo(t.y), bfhi(t.y)}; xv[mm][bj][1] = (f32x4){bflo(t.z), bfhi(t.z), bflo(t.w), bfhi(t.w)}; } }
#pragma unroll
                for (int mm = 0; mm < 2; ++mm)
#pragma unroll
                    for (int bj = 0; bj < 2; ++bj) { const int m = 2 * mp + mm; const unsigned eo = e0 + (unsigned)(ai * HALF + m * 16) * (unsigned)D + (unsigned)(bj * HALF);
                        const f32x4 y0 = xv[mm][bj][0] + gv[bj][0] * acc[ai][bj][m][0], y1 = xv[mm][bj][1] + gv[bj][1] * acc[ai][bj][m][1];
                        u32x4 w; w.x = pk2(y0[0], y0[1]); w.y = pk2(y0[2], y0[3]); w.z = pk2(y1[0], y1[1]); w.w = pk2(y1[2], y1[3]);
                        *(u32x4*)((char*)xout + eo * 2u) = w; }
                asm volatile("" ::: "memory");
            }
    }
};
struct EpiLogits {
    static constexpr bool PERM = false; static constexpr int NST = 16;
    float* L;
    template <int A0, int A1> __device__ __forceinline__ void run(AccRef acc, const Unit& u, int wr, int wc, int fr, int fq) const {
        const int row0 = u.pm * BM + wr * 64 + fr, col0 = wc * 32 + 4 * fq;
#pragma unroll
        for (int ai = A0; ai < A1; ++ai)
#pragma unroll
            for (int m = 0; m < 4; ++m) { float* rowp = L + (size_t)(row0 + ai * HALF + m * 16) * 128 + col0;
#pragma unroll
                for (int n = 0; n < 2; ++n) *(f32x4*)(rowp + n * 16) = acc[ai][0][m][n]; }
    }
};
struct EpiAct {
    static constexpr bool PERM = true; static constexpr int NST = 16;
    bf16* H1;
    template <int A0, int A1> __device__ __forceinline__ void run(AccRef acc, const Unit& u, int wr, int wc, int fr, int fq) const {
        const int row0 = u.pm * BM + wr * 64 + fr, col0 = u.pn * 128 + wc * 16 + 4 * fq;
#pragma unroll
        for (int ai = A0; ai < A1; ++ai)
#pragma unroll
            for (int m = 0; m < 4; ++m) { bf16* rowp = H1 + (size_t)(row0 + ai * HALF + m * 16) * DEXP + col0;
#pragma unroll
                for (int bj = 0; bj < 2; ++bj) { const f32x4 a = acc[ai][bj][m][0], b = acc[ai][bj][m][1];
                    float y[4];
#pragma unroll
                    for (int j = 0; j < 4; ++j) y[j] = a[j] * fsigmoid(a[j]) * b[j];
                    u32x2 w; w.x = pk2(y[0], y[1]); w.y = pk2(y[2], y[3]);
                    *(u32x2*)(rowp + bj * 64) = w; } }
    }
};
struct EpiYb {
    static constexpr bool PERM = true; static constexpr int NST = 16;
    bf16* YB; const float* lw; LAS unsigned char* lds;
    template <int A0, int A1> __device__ __forceinline__ void run(AccRef acc, const Unit& u, int wr, int wc, int fr, int fq) const {
        const int rl0 = wr * 64 + fr;
        const unsigned off0 = ((unsigned)(u.pm * BM + rl0) * (unsigned)D + (unsigned)(u.pn * BM + wc * 32 + 8 * fq)) * 2u;
        char* base = (char*)YB; const LAS float* wt = (const LAS float*)(lds + L_TOKT) + u.slot * 256 + rl0;
        float wgt[2][4];
#pragma unroll
        for (int ai = A0; ai < A1; ++ai)
#pragma unroll
            for (int m = 0; m < 4; ++m) wgt[ai][m] = wt[ai * HALF + m * 16];
#pragma unroll
        for (int ai = A0; ai < A1; ++ai)
#pragma unroll
            for (int m = 0; m < 4; ++m) { const unsigned ro = off0 + (unsigned)(ai * HALF + m * 16) * (unsigned)(D * 2);
#pragma unroll
                for (int bj = 0; bj < 2; ++bj) { const f32x4 v0 = acc[ai][bj][m][0] * wgt[ai][m], v1 = acc[ai][bj][m][1] * wgt[ai][m];
                    u32x4 w; w.x = pk2(v0[0], v0[1]); w.y = pk2(v0[2], v0[3]); w.z = pk2(v1[0], v1[1]); w.w = pk2(v1[2], v1[3]);
                    *(u32x4*)(base + (ro + (unsigned)(bj * 256))) = w; } }
    }
};
}

struct Args { const float* in[22]; float* out; unsigned char* ws; int ph_lo, ph_hi; };
struct Frame {
    LAS unsigned char* lds;
    unsigned* ctl;
    unsigned char* ws;
    int tid, lane, wave, G, bx;
    float* out;
};

__device__ __forceinline__ void tr_item(const float* W, int ldw, int k0, int scol0, bf16* WT, int ldt, int drow0, int ilv, float scale, LAS float* scr, int lane) {
#pragma unroll 8
    for (int i = 0; i < 32; ++i) { const int kk = 2 * i + (lane >> 5); scr[kk * 33 + (lane & 31)] = W[(size_t)(k0 + kk) * ldw + scol0 + (lane & 31)] * scale; }
    LDS_WAIT(); asm volatile("" ::: "memory");
    const int c = lane & 7;
#pragma unroll
    for (int j = 0; j < 4; ++j) { const int n = (lane >> 3) + 8 * j; const LAS float* s = scr + (8 * c) * 33 + n;
        u32x4 o; o.x = pk2(s[0 * 33], s[1 * 33]); o.y = pk2(s[2 * 33], s[3 * 33]); o.z = pk2(s[4 * 33], s[5 * 33]); o.w = pk2(s[6 * 33], s[7 * 33]);
        const int drow = ilv ? drow0 + 8 * (n >> 2) + (n & 3) + 4 * (ilv - 1) : drow0 + n;
        *(u32x4*)(WT + (size_t)drow * ldt + k0 + 8 * c) = o; }
    LDS_WAIT(); asm volatile("" ::: "memory");
}

__device__ __forceinline__ void p0_prologue(Frame& F, const Args& A) {
    const int gw = F.bx * NWAVES + F.wave, NGW = F.G * NWAVES;
    {
        LAS float* sc = (LAS float*)(F.lds + 69632);
        bool have = false;
        for (int it = F.bx; it < 192; it += F.G) {
            if (!have) { for (int i = F.tid; i < 8192; i += NTHR) { const float v = A.in[1][i]; sc[i] = v * fsigmoid(v); } __syncthreads(); have = true; }
            const int l = it / 96, cc = (it % 96) >> 3, kc = it & 7, col = cc * 512 + F.tid;
            const float* w = A.in[2] + ((size_t)l * D + kc * 128) * MODW + col;
            float a[8];
#pragma unroll
            for (int b = 0; b < 8; ++b) a[b] = 0.f;
#pragma unroll 32
            for (int k = 0; k < 128; ++k) { const float wv = w[(size_t)k * MODW];
#pragma unroll
                for (int b = 0; b < 8; ++b) a[b] += sc[b * 1024 + kc * 128 + k] * wv; }
            float* mo = (float*)(F.ws + WS_MODP) + ((size_t)(kc * 2 + l) * 8) * MODW + col;
#pragma unroll
            for (int b = 0; b < 8; ++b) mo[(size_t)b * MODW] = a[b];
        }
        __syncthreads();
    }
    LAS float* scr = (LAS float*)(F.lds + F.wave * 8448);
    constexpr int I_IN = 16 * 256, I_SQ = 16 * 32, I_L = I_IN + 3 * I_SQ;
    for (int it = gw; it < 2 * I_L; it += NGW) {
        const int l = it / I_L; int r = it % I_L;
        if (r < I_IN) { const int kb = r / 256, nb = r % 256, n0 = nb * 32; const int scol = n0 < 2048 ? n0 : n0 + 16;
            bf16* wt = (bf16*)(F.ws + WS_WIN) + (size_t)l * 8192 * 1024;
            if (nb >= 128 && nb < 192) {
                const int sh = (nb - 128) >> 5, nq = (nb - 128) & 31;
                tr_item(A.in[5] + (size_t)l * D * INCOLS, INCOLS, kb * 64, (sh ? 5136 : 4112) + 32 * nq, wt, 1024, 4096 + 64 * nq, 1 + sh, 1.0f, scr, F.lane); }
            else tr_item(A.in[5] + (size_t)l * D * INCOLS, INCOLS, kb * 64, scol, wt, 1024, n0, 0, n0 < 512 ? 0.08838834764831845f : 1.0f, scr, F.lane);
            continue; }
        r -= I_IN; const int which = r / I_SQ; r %= I_SQ; const int kb = r / 32, nb = r % 32;
        bf16* dst = (bf16*)(F.ws + WS_WO3 + (size_t)l * WO_L);
        if (which == 0) tr_item(A.in[10] + (size_t)l * D * D, D, kb * 64, nb * 32, dst + 1024, WOEP, nb * 32, 0, 1.0f, scr, F.lane);
        else if (which == 1) tr_item(A.in[11] + (size_t)l * D * D, D, kb * 64, nb * 32, dst, WOEP, nb * 32, 0, 1.0f, scr, F.lane);
        else tr_item(A.in[12] + (size_t)l * D * D, D, kb * 64, nb * 32, (bf16*)(F.ws + WS_WO3 + (size_t)l * WO_L + WO_OUT), 1024, nb * 32, 0, 1.0f, scr, F.lane);
    }
    {
        const int gt = F.bx * NTHR + F.tid, NGT = F.G * NTHR;
        bf16* wr = (bf16*)(F.ws + WS_WR);
        for (int i = gt; i < 2 * 256 * 1024; i += NGT) { const int l = i >> 18, n = (i >> 10) & 255, k = i & 1023;
            float v = 0.f; if (n < 8) v = A.in[14][((size_t)l * D + k) * 8 + n]; else if (n < 72) v = A.in[16][((size_t)l * D + k) * 64 + (n - 8)];
            wr[i] = (bf16)(pk2(v, 0.f) & 0xffffu); }
        float* wg = (float*)(F.ws + WS_WG);
        for (int i = gt; i < 2 * 16 * 1024; i += NGT) { const int l = i >> 14, c = (i >> 10) & 15, k = i & 1023;
            wg[i] = A.in[5][((size_t)l * D + k) * INCOLS + GDN_COL + c]; }
    }
}

struct TrItem { const float* wp; int ldw; bf16* wt; int ldt; int drow0, ilv, k0; };
__device__ __forceinline__ void tr_load(const TrItem& t, float (&v)[32], int lane) {
    const float* wp = t.wp + (size_t)(t.k0 + (lane >> 5)) * t.ldw + (lane & 31);
#pragma unroll
    for (int i = 0; i < 32; ++i) v[i] = __builtin_nontemporal_load(wp + (size_t)(2 * i) * t.ldw);
}
__device__ __forceinline__ void tr_store(const TrItem& t, const float (&v)[32], LAS float* scr, int lane) {
#pragma unroll
    for (int i = 0; i < 32; ++i) scr[(2 * i + (lane >> 5)) * 33 + (lane & 31)] = v[i];
    LDS_WAIT(); asm volatile("" ::: "memory");
    const int c = lane & 7;
#pragma unroll
    for (int j = 0; j < 4; ++j) { const int n = (lane >> 3) + 8 * j; const LAS float* s = scr + (8 * c) * 33 + n;
        u32x4 o; o.x = pk2(s[0 * 33], s[1 * 33]); o.y = pk2(s[2 * 33], s[3 * 33]); o.z = pk2(s[4 * 33], s[5 * 33]); o.w = pk2(s[6 * 33], s[7 * 33]);
        const int drow = t.ilv ? t.drow0 + 8 * (n >> 2) + (n & 3) + 4 * (t.ilv - 1) : t.drow0 + n;
        __builtin_nontemporal_store(o, (u32x4*)(t.wt + (size_t)drow * t.ldt + t.k0 + 8 * c)); }
    LDS_WAIT(); asm volatile("" ::: "memory");
}
__device__ __forceinline__ TrItem expert_item(Frame& F, const Args& A, int l, int it) {
    constexpr int I13 = 16 * 16, I2 = 8 * 32, IE = 2 * I13 + I2;
    const int e = it / IE; int r = it % IE; TrItem t;
    if (r < 2 * I13) { const int s = r / I13; r %= I13; const int kb = r / 16, nb = r % 16;
        t.wp = (s == 0 ? A.in[18] : A.in[19]) + ((size_t)l * NEXP + e) * D * DEXP + nb * 32; t.ldw = DEXP;
        t.wt = (bf16*)(F.ws + WS_W13) + (size_t)e * 1024 * 1024; t.ldt = 1024; t.drow0 = 2 * nb * 32; t.ilv = 1 + s; t.k0 = kb * 64; }
    else { r -= 2 * I13; const int kb = r / 32, nb = r % 32;
        t.wp = A.in[20] + ((size_t)l * NEXP + e) * DEXP * D + nb * 32; t.ldw = D;
        t.wt = (bf16*)(F.ws + WS_W2) + (size_t)e * 1024 * 512; t.ldt = 512; t.drow0 = nb * 32; t.ilv = 0; t.k0 = kb * 64; }
    return t;
}
__device__ __forceinline__ void convert_experts(Frame& F, const Args& A, int l) {
    const int gw = F.bx * NWAVES + F.wave, NGW = F.G * NWAVES;
    LAS float* scr = (LAS float*)(F.lds + F.wave * 8448);
    constexpr int NIT = NEXP * (2 * 16 * 16 + 8 * 32);
    TrItem ta, tb, tc, td; float va[32], vb[32], vc[32], vd[32];
    int it = gw;
    if (it >= NIT) return;
    ta = expert_item(F, A, l, it); tr_load(ta, va, F.lane);
    if (it + NGW < NIT) { tb = expert_item(F, A, l, it + NGW); tr_load(tb, vb, F.lane); }
    if (it + 2 * NGW < NIT) { tc = expert_item(F, A, l, it + 2 * NGW); tr_load(tc, vc, F.lane); }
#define CV_STEP(TL, VL, TS, VS) do { if (it + 3 * NGW < NIT) { TL = expert_item(F, A, l, it + 3 * NGW); tr_load(TL, VL, F.lane); } \
        tr_store(TS, VS, scr, F.lane); it += NGW; } while (0)
#pragma unroll 1
    for (;;) {
        CV_STEP(td, vd, ta, va); if (it >= NIT) break;
        CV_STEP(ta, va, tb, vb); if (it >= NIT) break;
        CV_STEP(tb, vb, tc, vc); if (it >= NIT) break;
        CV_STEP(tc, vc, td, vd); if (it >= NIT) break;
    }
#undef CV_STEP
}

__device__ __forceinline__ void moe_tables(Frame& F, int l) {
    LAS int* CNT = (LAS int*)(F.lds + L_CNT); LAS int* PRE = (LAS int*)(F.lds + L_PRE); LAS int* MBEI = (LAS int*)(F.lds + L_MBEI);
    __syncthreads();
    if (F.tid < NEXP) CNT[F.tid] = (int)__hip_atomic_load(F.ctl + CW_CNT + (l * 64 + F.tid) * 64, RLX_AGENT);
    __syncthreads();
    if (F.tid < NEXP) {
        const int nb = (CNT[F.tid] + 255) >> 8; int inc = nb;
#pragma unroll
        for (int o = 1; o < 64; o <<= 1) { const int v = __shfl_up(inc, o); if (F.tid >= o) inc += v; }
        const int pre = inc - nb; PRE[F.tid] = pre;
        for (int i = 0; i < nb; ++i) MBEI[pre + i] = (F.tid << 16) | i;
        if (F.tid == NEXP - 1) *(LAS int*)(F.lds + L_TB) = inc; }
    __syncthreads();
}
__device__ __forceinline__ void moe_toktab(Frame& F) {
    const int TB = *(const LAS int*)(F.lds + L_TB);
    const LAS int* CNT = (const LAS int*)(F.lds + L_CNT); const LAS int* MBEI = (const LAS int*)(F.lds + L_MBEI);
    LAS int* TOKT = (LAS int*)(F.lds + L_TOKT);
    const int* ltok = (const int*)(F.ws + WS_LTOK);
    int tv[8];
#pragma unroll
    for (int i = 0; i < 8; ++i) { const int mb = i * 64 + (F.bx & 7) * 8 + (F.bx >> 5); tv[i] = 0;
        if (mb < TB && F.tid < 256) { const int ei = MBEI[mb], e = ei >> 16, rank = (ei & 0xffff) * 256 + F.tid;
            if (rank < CNT[e]) tv[i] = ltok[(size_t)e * CAP + rank]; } }
#pragma unroll
    for (int i = 0; i < 8; ++i) { const int mb = i * 64 + (F.bx & 7) * 8 + (F.bx >> 5);
        if (mb < TB && F.tid < 256) TOKT[i * 256 + F.tid] = tv[i]; }
    __syncthreads();
}

__device__ __forceinline__ void moe_wtab(Frame& F) {
    const int TB = *(const LAS int*)(F.lds + L_TB);
    const LAS int* CNT = (const LAS int*)(F.lds + L_CNT); const LAS int* MBEI = (const LAS int*)(F.lds + L_MBEI);
    LAS float* WT = (LAS float*)(F.lds + L_TOKT);
    const float* lw = (const float*)(F.ws + WS_LW);
    float wv[8];
#pragma unroll
    for (int i = 0; i < 8; ++i) { const int mb = i * 64 + (F.bx & 7) * 8 + (F.bx >> 5); wv[i] = 0.f;
        if (mb < TB && F.tid < 256) { const int ei = MBEI[mb], e = ei >> 16, rank = (ei & 0xffff) * 256 + F.tid;
            if (rank < CNT[e]) wv[i] = lw[(size_t)e * CAP + rank]; } }
#pragma unroll
    for (int i = 0; i < 8; ++i) { const int mb = i * 64 + (F.bx & 7) * 8 + (F.bx >> 5);
        if (mb < TB && F.tid < 256) WT[i * 256 + F.tid] = wv[i]; }
    __syncthreads();
}
template <bool COMBINE, bool WRITE_X, bool GDN, bool FINAL, bool MODPART = false, bool XBF = true>
__device__ __forceinline__ void row_phase(Frame& F, const float* xin, float* xout, bf16* hout, const float* gain, const float* modl, int sc_off, int sh_off,
                                          const float* modprev, const float* wg, float* gdn_out, const float* modbias = nullptr) {
    LAS float* GV = (LAS float*)(F.lds); LAS float* SHV = (LAS float*)(F.lds + 4096); LAS float* G2P = (LAS float*)(F.lds + 8192); LAS float* WG = (LAS float*)(F.lds + 16384);
    const LAS int* PRE = (const LAS int*)(F.lds + L_PRE);
    if (GDN) { for (int i = F.tid; i < 16 * 1024; i += NTHR) WG[i] = wg[i]; }
    for (int ch = F.bx; ch < NTOK / 128; ch += F.G) {
        const int b = ch >> 5;
        __syncthreads();
        for (int k = F.tid; k < D; k += NTHR) {
            if (FINAL) { GV[k] = gain[k]; SHV[k] = 0.f; }
            else if (MODPART) {
                float a = modbias[sc_off + k], c2 = modbias[sh_off + k];
#pragma unroll
                for (int kc = 0; kc < 8; ++kc) { a += modl[(size_t)kc * 16 * MODW + (size_t)b * MODW + sc_off + k]; c2 += modl[(size_t)kc * 16 * MODW + (size_t)b * MODW + sh_off + k]; }
                GV[k] = gain[k] * (1.0f + a); SHV[k] = c2; }
            else { GV[k] = gain[k] * (1.0f + modl[(size_t)b * MODW + sc_off + k]); SHV[k] = modl[(size_t)b * MODW + sh_off + k]; }
            if (COMBINE) G2P[k] = modprev[(size_t)b * MODW + 5120 + k];
        }
        __syncthreads();
#pragma unroll 1
        for (int g = 0; g < 8; ++g) {
            const int r0 = ch * 128 + F.wave * 16 + g * 2;
            f32x4 v[2][4];
#pragma unroll
            for (int r = 0; r < 2; ++r)
#pragma unroll
                for (int j = 0; j < 4; ++j) {
                    if (XBF) { const u32x2 t = *(const u32x2*)((const bf16*)xin + (size_t)(r0 + r) * D + 256 * j + 4 * F.lane); v[r][j] = (f32x4){bflo(t.x), bfhi(t.x), bflo(t.y), bfhi(t.y)}; }
                    else v[r][j] = *(const f32x4*)(xin + (size_t)(r0 + r) * D + 256 * j + 4 * F.lane); }
            if (COMBINE) {
                const int* route = (const int*)(F.ws + WS_ROUTE); const bf16* yb = (const bf16*)(F.ws + WS_YB);
#pragma unroll
                for (int r = 0; r < 2; ++r) {
                    const int er0 = route[2 * (r0 + r)], er1 = route[2 * (r0 + r) + 1];
                    const int row_a = (PRE[er0 >> 16] + ((er0 & 0xffff) >> 8)) * 256 + (er0 & 255);
                    const int row_b = (PRE[er1 >> 16] + ((er1 & 0xffff) >> 8)) * 256 + (er1 & 255);
#pragma unroll
                    for (int j = 0; j < 4; ++j) {
                        const u32x2 ya = *(const u32x2*)(yb + (size_t)row_a * D + 256 * j + 4 * F.lane), yc = *(const u32x2*)(yb + (size_t)row_b * D + 256 * j + 4 * F.lane);
                        const f32x4 gg = *(const LAS f32x4*)(G2P + 256 * j + 4 * F.lane);
                        f32x4 s; s[0] = bflo(ya.x) + bflo(yc.x); s[1] = bfhi(ya.x) + bfhi(yc.x); s[2] = bflo(ya.y) + bflo(yc.y); s[3] = bfhi(ya.y) + bfhi(yc.y);
                        v[r][j] = v[r][j] + gg * s;
                    }
                }
            }
            float rstd[2];
#pragma unroll
            for (int r = 0; r < 2; ++r) { float s = 0.f;
#pragma unroll
                for (int j = 0; j < 4; ++j) s += (v[r][j][0] * v[r][j][0] + v[r][j][1] * v[r][j][1]) + (v[r][j][2] * v[r][j][2] + v[r][j][3] * v[r][j][3]);
                rstd[r] = rsqrtf(wave_sum(s) * (1.0f / D) + EPS); }
            if (WRITE_X) {
#pragma unroll
                for (int r = 0; r < 2; ++r)
#pragma unroll
                    for (int j = 0; j < 4; ++j) { u32x2 w; w.x = pk2(v[r][j][0], v[r][j][1]); w.y = pk2(v[r][j][2], v[r][j][3]); *(u32x2*)((bf16*)xout + (size_t)(r0 + r) * D + 256 * j + 4 * F.lane) = w; }
            }
#pragma unroll
            for (int j = 0; j < 4; ++j) { const f32x4 gg = *(const LAS f32x4*)(GV + 256 * j + 4 * F.lane), ss = *(const LAS f32x4*)(SHV + 256 * j + 4 * F.lane);
#pragma unroll
                for (int r = 0; r < 2; ++r) v[r][j] = v[r][j] * rstd[r] * gg + ss; }
            if (FINAL) {
#pragma unroll
                for (int r = 0; r < 2; ++r)
#pragma unroll
                    for (int j = 0; j < 4; ++j) *(f32x4*)(xout + (size_t)(r0 + r) * D + 256 * j + 4 * F.lane) = v[r][j];
            } else {
#pragma unroll
                for (int r = 0; r < 2; ++r)
#pragma unroll
                    for (int j = 0; j < 4; ++j) { u32x2 w; w.x = pk2(v[r][j][0], v[r][j][1]); w.y = pk2(v[r][j][2], v[r][j][3]);
                        *(u32x2*)(hout + (size_t)(r0 + r) * D + 256 * j + 4 * F.lane) = w; }
            }
            if (GDN) {
                float p[32];
#pragma unroll
                for (int c = 0; c < 16; ++c) {
                    f32x4 wv[4];
#pragma unroll
                    for (int j = 0; j < 4; ++j) wv[j] = *(const LAS f32x4*)(WG + c * 1024 + 256 * j + 4 * F.lane);
#pragma unroll
                    for (int r = 0; r < 2; ++r) { float s = 0.f;
#pragma unroll
                        for (int j = 0; j < 4; ++j) s += (v[r][j][0] * wv[j][0] + v[r][j][1] * wv[j][1]) + (v[r][j][2] * wv[j][2] + v[r][j][3] * wv[j][3]);
                        p[r * 16 + c] = s; }
                    asm volatile("" ::: "memory");
                }
#define SWZX(x, o) __builtin_bit_cast(float, __builtin_amdgcn_ds_swizzle(__builtin_bit_cast(int, (x)), ((o) << 10) | 0x1f))
#define BFLY(o) do { const bool up = (F.lane & (o)) != 0; _Pragma("unroll") for (int i = 0; i < (o); ++i) { const float a_ = p[i], b_ = p[i + (o)]; const float t_ = SWZX(up ? a_ : b_, (o)); p[i] = (up ? b_ : a_) + t_; } } while (0)
                BFLY(16); BFLY(8); BFLY(4); BFLY(2); BFLY(1);
#undef BFLY
#undef SWZX
                const float tot = p[0] + __shfl_xor(p[0], 32);
                if (F.lane < 32) gdn_out[(size_t)r0 * 16 + F.lane] = tot;
            }
        }
    }
    __syncthreads();
}

__device__ __forceinline__ void conv_phase(Frame& F, const Args& A, int l) {
    bf16* z = (bf16*)(F.ws + WS_Z);
    const float* cw = A.in[9] + (size_t)l * 3 * D;
    const int cg = F.tid & 127, run = F.tid >> 7;
    float w0[8], w1[8], w2[8];
#pragma unroll
    for (int j = 0; j < 8; ++j) { w0[j] = cw[cg * 8 + j]; w1[j] = cw[D + cg * 8 + j]; w2[j] = cw[2 * D + cg * 8 + j]; }
    for (int ch = F.bx; ch < NTOK / 128; ch += F.G) {
        const int t0 = ch * 128 + run * 32;
        float um2[8], um1[8];
#pragma unroll
        for (int j = 0; j < 8; ++j) { um2[j] = 0.f; um1[j] = 0.f; }
        if ((t0 & (SEQ - 1)) != 0) {
            const u32x4 c2 = *(const u32x4*)(z + (size_t)(t0 - 2) * ZLD + ZCC + cg * 8), c1 = *(const u32x4*)(z + (size_t)(t0 - 1) * ZLD + ZCC + cg * 8);
            um2[0] = bflo(c2.x); um2[1] = bfhi(c2.x); um2[2] = bflo(c2.y); um2[3] = bfhi(c2.y); um2[4] = bflo(c2.z); um2[5] = bfhi(c2.z); um2[6] = bflo(c2.w); um2[7] = bfhi(c2.w);
            um1[0] = bflo(c1.x); um1[1] = bfhi(c1.x); um1[2] = bflo(c1.y); um1[3] = bfhi(c1.y); um1[4] = bflo(c1.z); um1[5] = bfhi(c1.z); um1[6] = bflo(c1.w); um1[7] = bfhi(c1.w);
        }
        u32x4 ca[8], ba[8], cb2[8], bb2[8];
#define CV_LD(cc_, bb_, i0_) do { _Pragma("unroll") for (int r = 0; r < 8; ++r) { const size_t ro_ = (size_t)(t0 + (i0_) + r) * ZLD + cg * 8; \
            cc_[r] = __builtin_nontemporal_load((const u32x4*)(z + ro_ + ZCC)); bb_[r] = __builtin_nontemporal_load((const u32x4*)(z + ro_ + ZCB)); } } while (0)
#define CV_DO(cc_, bb_, i0_) do { _Pragma("unroll") for (int r = 0; r < 8; ++r) { const size_t ro_ = (size_t)(t0 + (i0_) + r) * ZLD + cg * 8; const u32x4 cc = cc_[r], bb = bb_[r]; \
            float u[8], bv[8], o[8]; \
            u[0] = bflo(cc.x); u[1] = bfhi(cc.x); u[2] = bflo(cc.y); u[3] = bfhi(cc.y); u[4] = bflo(cc.z); u[5] = bfhi(cc.z); u[6] = bflo(cc.w); u[7] = bfhi(cc.w); \
            bv[0] = bflo(bb.x); bv[1] = bfhi(bb.x); bv[2] = bflo(bb.y); bv[3] = bfhi(bb.y); bv[4] = bflo(bb.z); bv[5] = bfhi(bb.z); bv[6] = bflo(bb.w); bv[7] = bfhi(bb.w); \
            _Pragma("unroll") for (int j = 0; j < 8; ++j) { o[j] = bv[j] * (w0[j] * um2[j] + w1[j] * um1[j] + w2[j] * u[j]); um2[j] = um1[j]; um1[j] = u[j]; } \
            u32x4 w; w.x = pk2(o[0], o[1]); w.y = pk2(o[2], o[3]); w.z = pk2(o[4], o[5]); w.w = pk2(o[6], o[7]); \
            *(u32x4*)(z + ro_ + ZCB) = w; } } while (0)
        CV_LD(ca, ba, 0);
        CV_LD(cb2, bb2, 8);  CV_DO(ca, ba, 0);
        CV_LD(ca, ba, 16);   CV_DO(cb2, bb2, 8);
        CV_LD(cb2, bb2, 24); CV_DO(ca, ba, 16);
        CV_DO(cb2, bb2, 24);
#undef CV_LD
#undef CV_DO
    }
}

constexpr int GL_QS = 272, GL_VS = 528, GL_AS = 144, GL_OS = 528;
constexpr int GL_QT = 0, GL_KT = 17408, GL_VV = 34816, GL_ATT = 68608, GL_OB = 77824, GL_GD = 111616, GL_SEGT = 115712, GL_DEC = 119808, GL_W2 = L_TOKT;
static_assert(GL_DEC + 512 <= RING_BYTES, "GLA LDS map");
#define MFMA32(a, b, c) __builtin_amdgcn_mfma_f32_32x32x16_bf16((a), (b), (c), 0, 0, 0)
#define TR16(p) __builtin_amdgcn_ds_read_tr16_b64_v4i16((LAS s16x4*)(p))

__device__ __forceinline__ float log_sigmoid_f(float x) { return fminf(x, 0.f) - __logf(1.0f + __expf(-fabsf(x))); }

template <bool PASS2>
__device__ __forceinline__ void gla_pass(Frame& F, const Args& A, int l) {
    LAS unsigned char* lds = F.lds;
    char* qh = (char*)(F.ws + WS_QH); char* kh = (char*)(F.ws + WS_KH); char* vh = (char*)(F.ws + WS_VH); const char* rh = (const char*)(F.ws + WS_RH);
    const float* gdn = (const float*)(F.ws + WS_GDN);
    float* dseg = (float*)(F.ws + WS_DSEG);
    char* ebuf = (char*)(F.ws + WS_EB); float* cdec = (float*)(F.ws + WS_CDEC);
#pragma unroll 1
    for (int unit = F.bx; unit < 256; unit += F.G) {
        const int b = unit >> 5, head = (unit >> 3) & 3, seg = unit & 7;
        const int t0 = b * SEQ + seg * 512;
        const int hr0 = (b * 4 + head) * SEQ + seg * 512;
        const bool state = PASS2 || seg < 7;
        f32x2 gb;
        {
            const int tid = F.tid, lane = F.lane, d0 = 2 * lane;
            __syncthreads();
            if (!PASS2) {
#pragma unroll
                for (int j = 0; j < 4; ++j) { const int i = tid + 512 * j; *(LAS float*)(lds + GL_W2 + i * 4) = A.in[6][((size_t)l * 16 + (i >> 7)) * 512 + head * 128 + (i & 127)]; }
                gb = *(const f32x2*)(A.in[7] + (size_t)l * 512 + head * 128 + d0);
            }
        }
        f32x16 S[4];
#pragma unroll
        for (int db = 0; db < 4; ++db)
#pragma unroll
            for (int i = 0; i < 16; ++i) S[db][i] = 0.f;
        if (PASS2 && seg > 0) {
            const int w = F.wave, lane = F.lane, hh = lane >> 5;
            const u32x4* sb = (const u32x4*)(F.ws + WS_SLOC) + ((size_t)((unit - seg) * 8 + w) * 8) * 64 + lane;
            u32x4 b0[8], b1[8], b2[8];
            for (int i = F.tid; i < seg * 128; i += NTHR) *(LAS float*)(lds + GL_OB + i * 4) = dseg[(size_t)(unit - seg) * 128 + i];
#define PF_LD(buf, j_) do { const int jc_ = (j_) < seg ? (j_) : seg - 1; _Pragma("unroll") for (int i = 0; i < 8; ++i) buf[i] = sb[(size_t)jc_ * 4096 + i * 64]; } while (0)
#define PF_FOLD(buf, j_) do { const LAS float* dp = (const LAS float*)(lds + GL_OB) + (j_) * 128 + 4 * hh; \
                _Pragma("unroll") for (int i = 0; i < 8; ++i) _Pragma("unroll") for (int hf = 0; hf < 2; ++hf) { \
                    const int db = (2 * i + hf) >> 2, rg = (2 * i + hf) & 3; const f32x4 dv = *(const LAS f32x4*)(dp + 32 * db + 8 * rg); \
                    const unsigned lo = hf ? buf[i].z : buf[i].x, hi = hf ? buf[i].w : buf[i].y; \
                    S[db][4 * rg] = S[db][4 * rg] * dv[0] + bflo(lo); S[db][4 * rg + 1] = S[db][4 * rg + 1] * dv[1] + bfhi(lo); \
                    S[db][4 * rg + 2] = S[db][4 * rg + 2] * dv[2] + bflo(hi); S[db][4 * rg + 3] = S[db][4 * rg + 3] * dv[3] + bfhi(hi); } } while (0)
            PF_LD(b0, 0); PF_LD(b1, 1);
            __syncthreads();
#pragma unroll 1
            for (int j = 0; j < seg; j += 3) {
                PF_LD(b2, j + 2);
                PF_FOLD(b0, j);
                PF_LD(b0, j + 3);
                if (j + 1 < seg) PF_FOLD(b1, j + 1);
                PF_LD(b1, j + 4);
                if (j + 2 < seg) PF_FOLD(b2, j + 2);
            }
#undef PF_LD
#undef PF_FOLD
        }
        float dsum0 = 0.f, dsum1 = 0.f;
        unsigned kraw[8], qraw[8], eraw[8]; u32x4 vraw[4]; f32x4 gdr = (f32x4){0.f, 0.f, 0.f, 0.f}; u32x4 rraw[4]; f32x2 dcr = (f32x2){0.f, 0.f};
#define GLA_LOADS(co_) do { const size_t hr_ = (size_t)(hr0 + (co_)); const char* kb_ = kh + hr_ * 256; const char* qb_ = qh + hr_ * 256; const char* eb_ = ebuf + hr_ * 256; const char* vb_ = vh + hr_ * 512; \
            if (!PASS2) { if (tid < 256) gdr = *(const f32x4*)(gdn + (size_t)(t0 + (co_)) * 16 + tid * 4); } \
            else if (w == 0) dcr = *(const f32x2*)(cdec + (size_t)((t0 + (co_)) >> 6) * 512 + head * 128 + d0); \
            _Pragma("unroll") for (int ii = 0; ii < 8; ++ii) { \
                kraw[ii] = *(const unsigned*)(kb_ + (offk + (unsigned)(ii * 256))); \
                if (PASS2) { qraw[ii] = *(const unsigned*)(qb_ + (offk + (unsigned)(ii * 256))); eraw[ii] = *(const unsigned*)(eb_ + (offk + (unsigned)(ii * 256))); } } \
            if (state) { _Pragma("unroll") for (int j = 0; j < 4; ++j) vraw[j] = *(const u32x4*)(vb_ + (offv + (unsigned)(j * 16 * 512))); } \
        } while (0)
        {
            const int tid = F.tid, lane = F.lane, w = F.wave, d0 = 2 * lane;
            const unsigned offk = (unsigned)((8 * w) * 128 + d0) * 2u;
            const unsigned offv = (unsigned)((tid >> 5) * 256 + (tid & 31) * 8) * 2u;
            GLA_LOADS(0);
        }
#pragma unroll 1
        for (int c = 0; c < 8; ++c) {
            const int tc = t0 + 64 * c;
            int tq_ = F.tid; asm volatile("" : "+v"(tq_));
            const int tid = tq_, lane = tq_ & 63, w = __builtin_amdgcn_readfirstlane(tq_ >> 6);
            const int r31 = lane & 31, hh = lane >> 5, blk = (lane >> 4) & 1, q4 = (lane & 15) >> 2, p4 = lane & 3;
            const int erow = tid >> 3, ejj = tid & 7, d0 = 2 * lane;
            const unsigned offk = (unsigned)((8 * w) * 128 + d0) * 2u;
            const unsigned offv = (unsigned)((tid >> 5) * 256 + (tid & 31) * 8) * 2u;
            if (!PASS2) {
                if (tid < 256) *(LAS f32x4*)(lds + GL_GD + tid * 16) = gdr;
                __syncthreads();
                float bl[8][2]; float run0 = 0.f, run1 = 0.f;
#pragma unroll
                for (int ii = 0; ii < 8; ++ii) { bl[ii][0] = gb[0]; bl[ii][1] = gb[1]; }
#pragma unroll
                for (int r4 = 0; r4 < 4; ++r4) {
                    f32x2 wv[4];
#pragma unroll
                    for (int e = 0; e < 4; ++e) wv[e] = *(const LAS f32x2*)(lds + GL_W2 + ((4 * r4 + e) * 128 + d0) * 4);
#pragma unroll
                    for (int ii = 0; ii < 8; ++ii) { const f32x4 g = *(const LAS f32x4*)(lds + GL_GD + (8 * w + ii) * 64 + r4 * 16);
#pragma unroll
                        for (int e = 0; e < 4; ++e) { bl[ii][0] += g[e] * wv[e][0]; bl[ii][1] += g[e] * wv[e][1]; } }
                }
#pragma unroll
                for (int ii = 0; ii < 8; ++ii) { run0 += log_sigmoid_f(bl[ii][0]) * 0.0625f; run1 += log_sigmoid_f(bl[ii][1]) * 0.0625f; bl[ii][0] = run0; bl[ii][1] = run1; }
                *(LAS f32x2*)(lds + GL_SEGT + (w * 128 + d0) * 4) = (f32x2){run0, run1};
                __syncthreads();
                float off0 = 0.f, off1 = 0.f, tot0 = 0.f, tot1 = 0.f;
#pragma unroll
                for (int ww = 0; ww < 8; ++ww) { const f32x2 t = *(const LAS f32x2*)(lds + GL_SEGT + (ww * 128 + d0) * 4); if (ww < w) { off0 += t[0]; off1 += t[1]; } tot0 += t[0]; tot1 += t[1]; }
                if (w == 0) { const f32x2 dd = (f32x2){__expf(tot0), __expf(tot1)}; *(LAS f32x2*)(lds + GL_DEC + d0 * 4) = dd; *(f32x2*)(cdec + (size_t)(tc >> 6) * 512 + head * 128 + d0) = dd; }
                dsum0 += tot0; dsum1 += tot1;
                char* kbp = kh + (size_t)(hr0 + 64 * c) * 256; char* ebp = ebuf + (size_t)(hr0 + 64 * c) * 256;
#pragma unroll
                for (int ii = 0; ii < 8; ++ii) {
                    const float b0 = bl[ii][0] + off0, b1 = bl[ii][1] + off1;
                    const unsigned kt = pk2(bflo(kraw[ii]) * __expf(-b0), bfhi(kraw[ii]) * __expf(-b1));
                    *(LAS unsigned*)(lds + GL_KT + (8 * w + ii) * GL_QS + d0 * 2) = kt;
                    *(unsigned*)(kbp + (offk + (unsigned)(ii * 256))) = kt;
                    *(unsigned*)(ebp + (offk + (unsigned)(ii * 256))) = pk2(__expf(b0), __expf(b1));
                }
            } else {
                if (w == 0) *(LAS f32x2*)(lds + GL_DEC + d0 * 4) = dcr;
#pragma unroll
                for (int ii = 0; ii < 8; ++ii) {
                    *(LAS unsigned*)(lds + GL_KT + (8 * w + ii) * GL_QS + d0 * 2) = kraw[ii];
                    *(LAS unsigned*)(lds + GL_QT + (8 * w + ii) * GL_QS + d0 * 2) = pk2(bflo(qraw[ii]) * bflo(eraw[ii]), bfhi(qraw[ii]) * bfhi(eraw[ii]));
                }
            }
            if (state) {
#pragma unroll
                for (int j = 0; j < 4; ++j) { const int p = tid + 512 * j, row = p >> 5, c16 = p & 31; *(LAS u32x4*)(lds + GL_VV + row * GL_VS + c16 * 16) = vraw[j]; }
            }
            if (PASS2) {
#pragma unroll
                for (int m = 0; m < 4; ++m) rraw[m] = *(const u32x4*)(rh + (size_t)(hr0 + 64 * c + erow) * 512 + (32 * ejj + 8 * m) * 2);
            }
            { const int cn_ = 64 * (c < 7 ? c + 1 : c); GLA_LOADS(cn_); }
            if (!state) continue;
            __syncthreads();
            bf16x8 Vf[4];
#pragma unroll
            for (int ks = 0; ks < 4; ++ks) { const s16x4 lo = TR16(lds + GL_VV + (16 * ks + 8 * hh + q4) * GL_VS + (32 * w + 16 * blk + 4 * p4) * 2);
                const s16x4 hi = TR16(lds + GL_VV + (16 * ks + 8 * hh + 4 + q4) * GL_VS + (32 * w + 16 * blk + 4 * p4) * 2);
                Vf[ks] = __builtin_shufflevector(lo, hi, 0, 1, 2, 3, 4, 5, 6, 7); }
            __builtin_amdgcn_sched_barrier(0);
            f32x16 o[2];
            if (PASS2) {
                if (w < 3) {
                    const int ib = (w >= 1) ? 1 : 0, jb = (w == 2) ? 1 : 0;
                    f32x16 X;
#pragma unroll
                    for (int i = 0; i < 16; ++i) X[i] = 0.f;
#pragma unroll
                    for (int s = 0; s < 8; ++s) { const bf16x8 a = *(const LAS bf16x8*)(lds + GL_QT + (32 * ib + r31) * GL_QS + (16 * s + 8 * hh) * 2);
                        const bf16x8 bb = *(const LAS bf16x8*)(lds + GL_KT + (32 * jb + r31) * GL_QS + (16 * s + 8 * hh) * 2); X = MFMA32(a, bb, X); if (s & 1) __builtin_amdgcn_sched_barrier(0); }
#pragma unroll
                    for (int i = 0; i < 16; ++i) { const int il = 8 * (i >> 2) + 4 * hh + (i & 3); const float val = (ib == jb && r31 > il) ? 0.f : X[i];
                        *(LAS unsigned short*)(lds + GL_ATT + (32 * ib + il) * GL_AS + (32 * jb + r31) * 2) = (unsigned short)(pk2(val, 0.f) & 0xffffu); }
                }
                __builtin_amdgcn_sched_barrier(0);
#pragma unroll
                for (int i = 0; i < 16; ++i) { o[0][i] = 0.f; o[1][i] = 0.f; }
#pragma unroll
                for (int db = 0; db < 4; ++db)
#pragma unroll
                    for (int s = 0; s < 2; ++s) {
                        u32x4 pb; pb.x = pk2(S[db][8 * s + 0], S[db][8 * s + 1]); pb.y = pk2(S[db][8 * s + 2], S[db][8 * s + 3]); pb.z = pk2(S[db][8 * s + 4], S[db][8 * s + 5]); pb.w = pk2(S[db][8 * s + 6], S[db][8 * s + 7]);
                        const bf16x8 Bf = __builtin_bit_cast(bf16x8, pb);
#pragma unroll
                        for (int ib = 0; ib < 2; ++ib) { const LAS unsigned char* qp = lds + GL_QT + (32 * ib + r31) * GL_QS + (32 * db + 16 * s + 4 * hh) * 2;
                            const s16x4 lo = *(const LAS s16x4*)(qp), hi = *(const LAS s16x4*)(qp + 16);
                            const bf16x8 a = __builtin_shufflevector(lo, hi, 0, 1, 2, 3, 4, 5, 6, 7); o[ib] = MFMA32(a, Bf, o[ib]); }
                        __builtin_amdgcn_sched_barrier(0);
                    }
            }
#pragma unroll
            for (int ks = 0; ks < 4; ++ks)
#pragma unroll
                for (int db = 0; db < 4; ++db) { const s16x4 lo = TR16(lds + GL_KT + (16 * ks + 8 * hh + q4) * GL_QS + (32 * db + 16 * blk + 4 * p4) * 2);
                    const s16x4 hi = TR16(lds + GL_KT + (16 * ks + 8 * hh + 4 + q4) * GL_QS + (32 * db + 16 * blk + 4 * p4) * 2);
                    const bf16x8 a = __builtin_shufflevector(lo, hi, 0, 1, 2, 3, 4, 5, 6, 7); S[db] = MFMA32(a, Vf[ks], S[db]); if (db & 1) __builtin_amdgcn_sched_barrier(0); }
#pragma unroll
            for (int db = 0; db < 4; ++db)
#pragma unroll
                for (int rg = 0; rg < 4; ++rg) { const f32x4 dv = *(const LAS f32x4*)(lds + GL_DEC + (32 * db + 8 * rg + 4 * hh) * 4);
#pragma unroll
                    for (int e = 0; e < 4; ++e) S[db][4 * rg + e] *= dv[e]; }
            if (PASS2) {
                __syncthreads();
#pragma unroll
                for (int ib = 0; ib < 2; ++ib)
#pragma unroll
                    for (int ks = 0; ks < 4; ++ks) { if (ib == 0 && ks >= 2) continue;
                        const bf16x8 a = *(const LAS bf16x8*)(lds + GL_ATT + (32 * ib + r31) * GL_AS + (16 * ks + 8 * hh) * 2); o[ib] = MFMA32(a, Vf[ks], o[ib]); }
                __builtin_amdgcn_sched_barrier(0);
#pragma unroll
                for (int ib = 0; ib < 2; ++ib)
#pragma unroll
                    for (int i = 0; i < 16; ++i) { const int il = 8 * (i >> 2) + 4 * hh + (i & 3);
                        *(LAS unsigned short*)(lds + GL_OB + (32 * ib + il) * GL_OS + (32 * w + r31) * 2) = (unsigned short)(pk2(o[ib][i], 0.f) & 0xffffu); }
                __syncthreads();
                float ss = 0.f;
#pragma unroll
                for (int m = 0; m < 4; ++m) { const u32x4 t = *(const LAS u32x4*)(lds + GL_OB + erow * GL_OS + (32 * ejj + 8 * m) * 2);
                    ss += (bflo(t.x) * bflo(t.x) + bfhi(t.x) * bfhi(t.x)) + (bflo(t.y) * bflo(t.y) + bfhi(t.y) * bfhi(t.y)) + (bflo(t.z) * bflo(t.z) + bfhi(t.z) * bfhi(t.z)) + (bflo(t.w) * bflo(t.w) + bfhi(t.w) * bfhi(t.w)); }
                ss += __shfl_xor(ss, 1); ss += __shfl_xor(ss, 2); ss += __shfl_xor(ss, 4);
                const float rstd = rsqrtf(ss * (1.0f / 256.0f) + EPS);
                const float* gn = A.in[8] + (size_t)l * D + head * 256 + 32 * ejj;
                bf16* zo = (bf16*)(F.ws + WS_Z) + (size_t)(t0 + 64 * c + erow) * ZLD + ZCH + head * 256 + 32 * ejj;
#pragma unroll
                for (int m = 0; m < 4; ++m) { const f32x4 g0 = *(const f32x4*)(gn + 8 * m), g1 = *(const f32x4*)(gn + 8 * m + 4);
                    const u32x4 t = *(const LAS u32x4*)(lds + GL_OB + erow * GL_OS + (32 * ejj + 8 * m) * 2);
                    const unsigned tt[4] = {t.x, t.y, t.z, t.w};
                    const unsigned rr[4] = {rraw[m].x, rraw[m].y, rraw[m].z, rraw[m].w}; unsigned ww[4];
#pragma unroll
                    for (int e = 0; e < 4; ++e) { const float ra = bflo(rr[e]), rb = bfhi(rr[e]); const float ga = e < 2 ? g0[2 * e] : g1[2 * e - 4], gb2 = e < 2 ? g0[2 * e + 1] : g1[2 * e - 3];
                        ww[e] = pk2(bflo(tt[e]) * rstd * ga * ra, bfhi(tt[e]) * rstd * gb2 * rb); }
                    *(u32x4*)(zo + 8 * m) = (u32x4){ww[0], ww[1], ww[2], ww[3]}; }
            }
        }
#undef GLA_LOADS
        if (!PASS2 && state) {
            const int w = F.wave, lane = F.lane, d0 = 2 * lane;
            u32x4* sp = (u32x4*)(F.ws + WS_SLOC) + ((size_t)(unit * 8 + w) * 8) * 64 + lane;
#pragma unroll
            for (int i = 0; i < 8; ++i) { const int da = (2 * i) >> 2, ra = (2 * i) & 3, dc = (2 * i + 1) >> 2, rc = (2 * i + 1) & 3;
                sp[i * 64] = (u32x4){pk2(S[da][4 * ra], S[da][4 * ra + 1]), pk2(S[da][4 * ra + 2], S[da][4 * ra + 3]), pk2(S[dc][4 * rc], S[dc][4 * rc + 1]), pk2(S[dc][4 * rc + 2], S[dc][4 * rc + 3])}; }
            if (w == 0) *(f32x2*)(dseg + (size_t)unit * 128 + d0) = (f32x2){__expf(dsum0), __expf(dsum1)};
        }
    }
}

__device__ __forceinline__ void norm2_router_phase(Frame& F, const Args& A, int l, const float* modl) {
    LAS float* GV = (LAS float*)(F.lds); LAS float* SHV = (LAS float*)(F.lds + 4096); LAS float* LG = (LAS float*)(F.lds + 16384);
    LAS int* LCNT = (LAS int*)(F.lds + L_LCNT); LAS int* LBASE = (LAS int*)(F.lds + L_LBASE);
    const bf16* xb = (const bf16*)(F.ws + WS_XB); bf16* hout = (bf16*)(F.ws + WS_H);
    const bf16* wr = (const bf16*)(F.ws + WS_WR) + (size_t)l * 256 * 1024;
    const float* gain = A.in[13] + (size_t)l * D;
    const float* rgb = A.in[15] + l * 8; const float* reb = A.in[17] + l * 64;
    int* ltok = (int*)(F.ws + WS_LTOK); float* lw = (float*)(F.ws + WS_LW); int* route = (int*)(F.ws + WS_ROUTE);
    for (int ch = F.bx; ch < NTOK / 128; ch += F.G) {
        const int b = ch >> 5;
        __syncthreads();
        for (int k = F.tid; k < D; k += NTHR) { GV[k] = gain[k] * (1.0f + modl[(size_t)b * MODW + 4096 + k]); SHV[k] = modl[(size_t)b * MODW + 3072 + k]; }
        if (F.tid < 64) LCNT[F.tid] = 0;
        __syncthreads();
        u32x4 wreg[5];
#define RT_GLOAD(sl) do { _Pragma("unroll") for (int j = 0; j < 5; ++j) { const int u_ = F.tid + NTHR * j; wreg[j] = *(const u32x4*)((const char*)wr + (size_t)(u_ >> 5) * 2048 + (sl) * 512 + (u_ & 31) * 16); } } while (0)
#define RT_LSTORE(bo) do { _Pragma("unroll") for (int j = 0; j < 5; ++j) { const int u_ = F.tid + NTHR * j; *(LAS u32x4*)(F.lds + (bo) + (u_ >> 5) * 528 + (u_ & 31) * 16) = wreg[j]; } } while (0)
        RT_GLOAD(0);
        u32x2 ta[2][4], tb[2][4];
#define N2_LOAD(dst, g_) do { _Pragma("unroll") for (int r = 0; r < 2; ++r) _Pragma("unroll") for (int j = 0; j < 4; ++j) \
            dst[r][j] = *(const u32x2*)(xb + (size_t)(ch * 128 + F.wave * 16 + ((g_) < 8 ? (g_) : 7) * 2 + r) * D + 256 * j + 4 * F.lane); } while (0)
#define N2_BODY(buf, g_) do { const int r0 = ch * 128 + F.wave * 16 + (g_) * 2; f32x4 v[2][4]; \
            _Pragma("unroll") for (int r = 0; r < 2; ++r) _Pragma("unroll") for (int j = 0; j < 4; ++j) { const u32x2 t = buf[r][j]; v[r][j] = (f32x4){bflo(t.x), bfhi(t.x), bflo(t.y), bfhi(t.y)}; } \
            N2_LOAD(buf, (g_) + 2); \
            float rstd[2]; \
            _Pragma("unroll") for (int r = 0; r < 2; ++r) { float s = 0.f; \
                _Pragma("unroll") for (int j = 0; j < 4; ++j) s += (v[r][j][0] * v[r][j][0] + v[r][j][1] * v[r][j][1]) + (v[r][j][2] * v[r][j][2] + v[r][j][3] * v[r][j][3]); \
                rstd[r] = rsqrtf(wave_sum(s) * (1.0f / D) + EPS); } \
            _Pragma("unroll") for (int j = 0; j < 4; ++j) { const f32x4 gg = *(const LAS f32x4*)(GV + 256 * j + 4 * F.lane), ss = *(const LAS f32x4*)(SHV + 256 * j + 4 * F.lane); \
                _Pragma("unroll") for (int r = 0; r < 2; ++r) { const f32x4 y = v[r][j] * rstd[r] * gg + ss; u32x2 w; w.x = pk2(y[0], y[1]); w.y = pk2(y[2], y[3]); \
                    *(u32x2*)(hout + (size_t)(r0 + r) * D + 256 * j + 4 * F.lane) = w; } } } while (0)
        N2_LOAD(ta, 0); N2_LOAD(tb, 1);
#pragma unroll 1
        for (int g = 0; g < 8; g += 2) { N2_BODY(ta, g); N2_BODY(tb, g + 1); }
#undef N2_LOAD
#undef N2_BODY
        asm volatile("s_waitcnt vmcnt(0)" ::: "memory");
        {
            const int lr = F.lane & 15, kq = F.lane >> 4;
            const bf16* ap = hout + (size_t)(ch * 128 + F.wave * 16 + lr) * D + 8 * kq;
            constexpr int RB0 = 8192, RB1 = 8192 + 80 * 528;
            f32x4 acc[5];
#pragma unroll
            for (int cb = 0; cb < 5; ++cb) acc[cb] = (f32x4){0.f, 0.f, 0.f, 0.f};
            bf16x8 af[2][8];
#define RT_ALOAD(buf, sl) do { _Pragma("unroll") for (int q = 0; q < 8; ++q) af[buf][q] = *(const bf16x8*)(ap + 256 * (sl) + 32 * q); } while (0)
#define RT_MMA(buf, bo) do { _Pragma("unroll") for (int q = 0; q < 8; ++q) _Pragma("unroll") for (int cb = 0; cb < 5; ++cb) \
                acc[cb] = __builtin_amdgcn_mfma_f32_16x16x32_bf16(af[buf][q], *(const LAS bf16x8*)(F.lds + (bo) + (16 * cb + lr) * 528 + (32 * q + 8 * kq) * 2), acc[cb], 0, 0, 0); } while (0)
            RT_ALOAD(0, 0);
            RT_LSTORE(RB0); RT_GLOAD(1); RT_ALOAD(1, 1); __syncthreads(); RT_MMA(0, RB0);
            RT_LSTORE(RB1); RT_GLOAD(2); RT_ALOAD(0, 2); __syncthreads(); RT_MMA(1, RB1);
            RT_LSTORE(RB0); RT_GLOAD(3); RT_ALOAD(1, 3); __syncthreads(); RT_MMA(0, RB0);
            RT_LSTORE(RB1); __syncthreads(); RT_MMA(1, RB1);
#undef RT_ALOAD
#undef RT_MMA
#undef RT_GLOAD
#undef RT_LSTORE
            __syncthreads();
#pragma unroll
            for (int cb = 0; cb < 5; ++cb)
#pragma unroll
                for (int r = 0; r < 4; ++r) LG[(F.wave * 16 + 4 * kq + r) * 81 + 16 * cb + lr] = acc[cb][r];
        }
        __syncthreads();
        int e0 = 0, e1 = 0, r0 = 0, r1 = 0; float wa = 0.f, wb = 0.f; const int t = ch * 128 + F.tid;
        if (F.tid < 128) {
            const LAS float* lp = LG + F.tid * 81;
            float lg[8];
#pragma unroll
            for (int j = 0; j < 8; ++j) lg[j] = lp[j] + rgb[j];
            float m = lg[0]; int gi = 0;
#pragma unroll
            for (int j = 1; j < 8; ++j) if (lg[j] > m) { m = lg[j]; gi = j; }
            float sum = 0.f;
#pragma unroll
            for (int j = 0; j < 8; ++j) sum += __expf(lg[j] - m);
            const float gw = 1.0f / sum;
            float le[8];
#pragma unroll
            for (int j = 0; j < 8; ++j) le[j] = lp[8 + gi * 8 + j] + reb[gi * 8 + j];
            float m0 = le[0]; int i0 = 0;
#pragma unroll
            for (int j = 1; j < 8; ++j) if (le[j] > m0) { m0 = le[j]; i0 = j; }
            float m1 = -3.0e38f; int i1 = 0;
#pragma unroll
            for (int j = 0; j < 8; ++j) if (j != i0 && le[j] > m1) { m1 = le[j]; i1 = j; }
            const float pr = __expf(m1 - m0);
            wa = gw / (1.0f + pr); wb = gw * pr / (1.0f + pr);
            e0 = gi * 8 + i0; e1 = gi * 8 + i1;
            r0 = __hip_atomic_fetch_add(&LCNT[e0], 1, __ATOMIC_RELAXED, __HIP_MEMORY_SCOPE_WORKGROUP); r1 = __hip_atomic_fetch_add(&LCNT[e1], 1, __ATOMIC_RELAXED, __HIP_MEMORY_SCOPE_WORKGROUP);
        }
        __syncthreads();
        if (F.tid < 64) { const int n = LCNT[F.tid]; LBASE[F.tid] = n ? (int)__hip_atomic_fetch_add(F.ctl + CW_CNT + (l * 64 + F.tid) * 64, (unsigned)n, RLX_AGENT) : 0; }
        __syncthreads();
        if (F.tid < 128) {
            r0 += LBASE[e0]; r1 += LBASE[e1];
            ltok[(size_t)e0 * CAP + r0] = t; lw[(size_t)e0 * CAP + r0] = wa;
            ltok[(size_t)e1 * CAP + r1] = t; lw[(size_t)e1 * CAP + r1] = wb;
            route[2 * t] = (e0 << 16) | r0; route[2 * t + 1] = (e1 << 16) | r1;
        }
    }
    __syncthreads();
}

__device__ __forceinline__ void topk_phase(Frame& F, const Args& A, int l) {
    LAS int* LCNT = (LAS int*)(F.lds + L_LCNT); LAS int* LBASE = (LAS int*)(F.lds + L_LBASE);
    const float* logits = (const float*)(F.ws + WS_LOGITS);
    const float* rgb = A.in[15] + l * 8; const float* reb = A.in[17] + l * 64;
    int* ltok = (int*)(F.ws + WS_LTOK); float* lw = (float*)(F.ws + WS_LW); int* route = (int*)(F.ws + WS_ROUTE);
    for (int ch = F.bx; ch < NTOK / 128; ch += F.G) {
        __syncthreads();
        if (F.tid < 64) LCNT[F.tid] = 0;
        __syncthreads();
        int e0 = 0, e1 = 0, r0 = 0, r1 = 0; float wa = 0.f, wb = 0.f; const int t = ch * 128 + F.tid;
        if (F.tid < 128) {
            const float* lp = logits + (size_t)t * 128;
            float lg[8];
#pragma unroll
            for (int j = 0; j < 8; ++j) lg[j] = lp[j] + rgb[j];
            float m = lg[0]; int gi = 0;
#pragma unroll
            for (int j = 1; j < 8; ++j) if (lg[j] > m) { m = lg[j]; gi = j; }
            float sum = 0.f;
#pragma unroll
            for (int j = 0; j < 8; ++j) sum += __expf(lg[j] - m);
            const float gw = 1.0f / sum;
            float le[8];
#pragma unroll
            for (int j = 0; j < 8; ++j) le[j] = lp[8 + gi * 8 + j] + reb[gi * 8 + j];
            float m0 = le[0]; int i0 = 0;
#pragma unroll
            for (int j = 1; j < 8; ++j) if (le[j] > m0) { m0 = le[j]; i0 = j; }
            float m1 = -3.0e38f; int i1 = 0;
#pragma unroll
            for (int j = 0; j < 8; ++j) if (j != i0 && le[j] > m1) { m1 = le[j]; i1 = j; }
            const float pr = __expf(m1 - m0);
            wa = gw / (1.0f + pr); wb = gw * pr / (1.0f + pr);
            e0 = gi * 8 + i0; e1 = gi * 8 + i1;
            r0 = __hip_atomic_fetch_add(&LCNT[e0], 1, __ATOMIC_RELAXED, __HIP_MEMORY_SCOPE_WORKGROUP); r1 = __hip_atomic_fetch_add(&LCNT[e1], 1, __ATOMIC_RELAXED, __HIP_MEMORY_SCOPE_WORKGROUP);
        }
        __syncthreads();
        if (F.tid < 64) { const int n = LCNT[F.tid]; LBASE[F.tid] = n ? (int)__hip_atomic_fetch_add(F.ctl + CW_CNT + (l * 64 + F.tid) * 64, (unsigned)n, RLX_AGENT) : 0; }
        __syncthreads();
        if (F.tid < 128) {
            r0 += LBASE[e0]; r1 += LBASE[e1];
            ltok[(size_t)e0 * CAP + r0] = t; lw[(size_t)e0 * CAP + r0] = wa;
            ltok[(size_t)e1 * CAP + r1] = t; lw[(size_t)e1 * CAP + r1] = wb;
            route[2 * t] = (e0 << 16) | r0; route[2 * t + 1] = (e1 << 16) | r1;
        }
    }
    __syncthreads();
}

constexpr int NPHASE = 20;

__global__ void __launch_bounds__(NTHR, 2) mega_fwd(Args args) {
    extern __shared__ __attribute__((aligned(16))) unsigned char lds_raw[];
    Frame F;
    F.lds = (LAS unsigned char*)lds_raw;
    F.tid = threadIdx.x; F.lane = F.tid & 63; F.wave = __builtin_amdgcn_readfirstlane(F.tid >> 6);
    F.G = gridDim.x; F.bx = blockIdx.x;
    F.ws = args.ws; F.ctl = (unsigned*)(args.ws + WS_CTL); F.out = args.out;
    for (int u = F.tid; u < (LDS_BYTES - LDSCTL_OFF) / 4; u += NTHR) ((LAS unsigned*)(F.lds + LDSCTL_OFF))[u] = 0u;
    __syncthreads();
    XcdBarrier bar = xcd_barrier_post(F.ctl + CW_BAR, (volatile LAS unsigned*)(F.lds + L_BARW));
    const int lo = args.ph_lo, hi = args.ph_hi;
#ifdef ONLY
#define PHON(k) ((k) == ONLY)
#else
#define PHON(k) true
#endif
#define PHASE_FENCE() do { F.tid = threadIdx.x; asm volatile("" : "+v"(F.tid)); F.lane = F.tid & 63; F.wave = __builtin_amdgcn_readfirstlane(F.tid >> 6); \
    unsigned long long zo_ = 0; unsigned zl_ = 0; asm volatile("" : "+s"(zo_), "+s"(zl_));        \
    F.ws = args.ws + zo_; F.out = args.out + zo_; F.lds = (LAS unsigned char*)lds_raw + zl_; F.bx = blockIdx.x; F.G = gridDim.x; \
    asm volatile("" : "+s"(F.bx), "+s"(F.G)); F.ctl = (unsigned*)(F.ws + WS_CTL); } while (0)
#define IN(k) (lo <= (k) && (k) < hi)
#define SEAM(k) do { if (IN(k) && IN((k) + 1)) xcd_barrier(bar); PHASE_FENCE(); } while (0)

#define Z ((bf16*)(F.ws + WS_Z))
#define H ((bf16*)(F.ws + WS_H))
#define MOD ((const float*)(F.ws + WS_MOD))

    if (PHON(0)) if (IN(0)) { p0_prologue(F, args); }
    SEAM(0);

    for (int l = 0; l < DEPTH; ++l) {
        const int pb = 1 + 9 * l;
#define modl (MOD + (size_t)l * 8 * MODW)
        if (PHON(1)) if (IN(pb + 0)) {
            if (l == 0) {
                {
                    const float* mp = (const float*)(F.ws + WS_MODP); float* mo = (float*)(F.ws + WS_MOD);
                    for (int i = F.bx * NTHR + F.tid; i < 2 * 8 * MODW; i += F.G * NTHR) { float a = args.in[3][(i / (8 * MODW)) * MODW + i % MODW];
#pragma unroll
                        for (int kc = 0; kc < 8; ++kc) a += mp[(size_t)kc * 16 * MODW + i];
                        mo[i] = a; }
                }
                row_phase<false, false, true, false, true, false>(F, args.in[0], nullptr, H, args.in[4], (const float*)(F.ws + WS_MODP), 1024, 0, nullptr, (const float*)(F.ws + WS_WG), (float*)(F.ws + WS_GDN), args.in[3]);
            }
            else { moe_tables(F, l - 1);
                row_phase<true, true, true, false>(F, (const float*)(F.ws + WS_XB), (float*)(F.ws + WS_XB), H, args.in[4] + (size_t)l * D, modl, 1024, 0, MOD + (size_t)(l - 1) * 8 * MODW, (const float*)(F.ws + WS_WG) + (size_t)l * 16 * 1024, (float*)(F.ws + WS_GDN)); }
        }
        SEAM(pb + 0);
        if (PHON(2)) if (IN(pb + 1)) {
            const int rsplit = 1 + 2 * (F.bx & 7);
            const char* aB = (const char*)H; const char* bB = (const char*)((bf16*)(F.ws + WS_WIN) + (size_t)l * 8192 * 1024);
            pg8::EpiZ E{F.ws};
            { pg8::StaticOrder S; S.init(NTOK, 8192, F.G, F.bx, D, D); S.i1 = rsplit;
              pg8::gemm_phase<pg8::EpiZ, pg8::StaticOrder, true>(F.lds, F.tid, aB, bB, D, S, E); }
            __syncthreads();
            convert_experts(F, args, l);
            __syncthreads();
            { asm volatile("" : "+s"(aB), "+s"(bB));
              pg8::StaticOrder S; S.init(NTOK, 8192, F.G, F.bx, D, D); S.i0 = rsplit;
              pg8::gemm_phase<pg8::EpiZ, pg8::StaticOrder, true>(F.lds, F.tid, aB, bB, D, S, E); }
        }
        SEAM(pb + 1);
        if (PHON(3)) if (IN(pb + 2)) {
            if (F.bx & 1) { conv_phase(F, args, l); __syncthreads(); gla_pass<false>(F, args, l); }
            else { gla_pass<false>(F, args, l); __syncthreads(); conv_phase(F, args, l); }
        }
        SEAM(pb + 2);
        if (PHON(4)) if (IN(pb + 3)) { gla_pass<true>(F, args, l); }
        SEAM(pb + 3);
        if (PHON(5)) if (IN(pb + 4)) {
            pg8::StaticOrder S; S.init(NTOK, D, F.G, F.bx, ZLD, WOEP); S.wgm = 8; S.kshift = 4; S.kjump = (size_t)(16 * 128 + (ZCH - ZCB - 1024) * 2);
            pg8::EpiGate2 E{Z + ZGC, Z + ZGA, Z + ZCC, ZLD};
            pg8::gemm_phase<pg8::EpiGate2, pg8::StaticOrder, true, false, true>(F.lds, F.tid, (const char*)(Z + ZCB), (const char*)(F.ws + WS_WO3 + (size_t)l * WO_L), 2048, S, E);
        }
        SEAM(pb + 4);
        if (PHON(6)) if (IN(pb + 5)) {
            pg8::StaticOrder S; S.init(NTOK, D, F.G, F.bx, ZLD, D); S.wgm = 8;
            const char* aF = (const char*)(Z + ZCC); const char* bF = (const char*)(F.ws + WS_WO3 + (size_t)l * WO_L + WO_OUT);
            if (l == 0) { pg8::EpiResid<true> E{args.in[0], nullptr, (bf16*)(F.ws + WS_XB), modl + 2048};
                pg8::gemm_phase<pg8::EpiResid<true>, pg8::StaticOrder, true>(F.lds, F.tid, aF, bF, D, S, E); }
            else { pg8::EpiResid<false> E{nullptr, (const bf16*)(F.ws + WS_XB), (bf16*)(F.ws + WS_XB), modl + 2048};
                pg8::gemm_phase<pg8::EpiResid<false>, pg8::StaticOrder, true>(F.lds, F.tid, aF, bF, D, S, E); }
        }
        SEAM(pb + 5);
        if (PHON(7)) if (IN(pb + 6)) { norm2_router_phase(F, args, l, modl); }
        SEAM(pb + 6);
        if (PHON(10)) if (IN(pb + 7)) {
            moe_tables(F, l); moe_toktab(F);
            pg8::MoeOrder<true> S{F.lds, F.G, F.bx, 2048u};
            pg8::EpiAct E{(bf16*)(F.ws + WS_H1)};
            pg8::gemm_phase<pg8::EpiAct, pg8::MoeOrder<true>, true>(F.lds, F.tid, (const char*)H, (const char*)(F.ws + WS_W13), D, S, E);
        }
        SEAM(pb + 7);
        if (PHON(11)) if (IN(pb + 8)) {
            moe_tables(F, l); moe_wtab(F);
            pg8::MoeOrder<false> S{F.lds, F.G, F.bx, 1024u};
            pg8::EpiYb E{(bf16*)(F.ws + WS_YB), (const float*)(F.ws + WS_LW), F.lds};
            pg8::gemm_phase<pg8::EpiYb, pg8::MoeOrder<false>, true>(F.lds, F.tid, (const char*)(F.ws + WS_H1), (const char*)(F.ws + WS_W2), DEXP, S, E);
        }
        SEAM(pb + 8);
    }
    if (PHON(12)) if (IN(19)) {
        moe_tables(F, DEPTH - 1);
        row_phase<true, false, false, true>(F, (const float*)(F.ws + WS_XB), F.out, nullptr, args.in[21], nullptr, 0, 0, MOD + (size_t)(DEPTH - 1) * 8 * MODW, nullptr, nullptr);
    }
#undef IN
#undef SEAM
#undef Z
#undef H
#undef MOD
#undef modl
}

extern "C" void kernel_launch(void* const* d_in, const int* in_sizes, int n_in, void* d_out, int out_size, void* d_ws, size_t ws_size, hipStream_t stream) {
    static int grid = 0;
    if (grid == 0) {
        if (n_in != 22 || out_size != NTOK * D || ws_size < WS_END) { fprintf(stderr, "kernel_launch: unexpected shapes (n_in %d out %d ws %zu)\n", n_in, out_size, ws_size); grid = -1; return; }
        int dev = 0, cus = 0, per_cu = 0;
        if (hipGetDevice(&dev) != hipSuccess || hipDeviceGetAttribute(&cus, hipDeviceAttributeMultiprocessorCount, dev) != hipSuccess) { grid = -1; return; }
        if (hipFuncSetAttribute((const void*)mega_fwd, hipFuncAttributeMaxDynamicSharedMemorySize, LDS_BYTES) != hipSuccess) { fprintf(stderr, "kernel_launch: hipFuncSetAttribute failed\n"); grid = -1; return; }
        if (hipOccupancyMaxActiveBlocksPerMultiprocessor(&per_cu, (const void*)mega_fwd, NTHR, LDS_BYTES) != hipSuccess || per_cu < 1)
            fprintf(stderr, "kernel_launch: occupancy query reports %d workgroups per CU\n", per_cu);
        (void)hipGetLastError();
        grid = cus;
        if (grid > 256) grid = 256;
    }
    if (grid < 0) return;
    if (hipMemsetAsync((char*)d_ws + WS_CTL, 0, CTL_ZERO_BYTES, stream) != hipSuccess) return;
    Args a{};
    for (int i = 0; i < 22; ++i) a.in[i] = (const float*)d_in[i];
    a.out = (float*)d_out; a.ws = (unsigned char*)d_ws;
#if MK_N_LAUNCHES == 1
    a.ph_lo = 0; a.ph_hi = NPHASE;
    hipLaunchKernelGGL(mega_fwd, dim3(grid), dim3(NTHR), LDS_BYTES, stream, a);
#else
    for (int p = 0; p < NPHASE; ++p) { a.ph_lo = p; a.ph_hi = p + 1; hipLaunchKernelGGL(mega_fwd, dim3(grid), dim3(NTHR), LDS_BYTES, stream, a); }
#endif
}
```
